# Optimizing an MI355X kernel written in HIP

```python
import math
import jax, jax.numpy as jnp
from jax import lax
import numpy as np

D_MODEL = 4096
BATCH = 1
SEQ = 8192
DEPTH = 1

MLA_HEADS = 16
Q_LORA_RANK = 1024
KV_LORA_RANK = 512
QK_NOPE_DIM = 128
QK_ROPE_DIM = 64
QK_HEAD_DIM = QK_NOPE_DIM + QK_ROPE_DIM
V_HEAD_DIM = 128
MLA_WIDTH = MLA_HEADS * V_HEAD_DIM
ROPE_THETA = 10000.0
Q_BLOCK = 128

DIL_GROUPS = ((128, 1), (512, 4), (2048, 16))
N_DIL_GROUPS = 3
DSWA_HEADS_PER_GROUP = 8
DSWA_HEADS = N_DIL_GROUPS * DSWA_HEADS_PER_GROUP
DSWA_HEAD_DIM = 128
DSWA_QKV_WIDTH = DSWA_HEADS * DSWA_HEAD_DIM
DSWA_WIDTH = DSWA_HEADS_PER_GROUP * DSWA_HEAD_DIM

REL_BUCKETS = 32
REL_MAX_DISTANCE = 1024

DEEPNORM_ALPHA = (2.0 * DEPTH) ** 0.25
DEEPNORM_BETA = (8.0 * DEPTH) ** -0.25
LN_EPS = 1e-5
RMS_EPS = 1e-6
NEG_INF = -1e30

IN_SPLITS = (
    Q_LORA_RANK,
    KV_LORA_RANK + QK_ROPE_DIM,
    DSWA_QKV_WIDTH,
    DSWA_QKV_WIDTH,
    DSWA_QKV_WIDTH,
    MLA_WIDTH,
    DSWA_WIDTH,
    D_MODEL,
    D_MODEL,
)
IN_WIDTH = sum(IN_SPLITS)
IN_OFFSETS = tuple(int(v) for v in np.cumsum(IN_SPLITS)[:-1])
DSWA_V_START = IN_OFFSETS[3]
DSWA_V_END = IN_OFFSETS[4]

kernel_name = "hybrid_mla_dilated_window_encoder_layer"


def layer_norm(x, g, b):
    xf = x.astype(jnp.float32)
    mu = jnp.mean(xf, axis=-1, keepdims=True)
    xc = xf - mu
    var = jnp.mean(xc * xc, axis=-1, keepdims=True)
    return (xc * lax.rsqrt(var + LN_EPS) * g.astype(jnp.float32) + b.astype(jnp.float32)).astype(x.dtype)


def rms_norm(x, g):
    xf = x.astype(jnp.float32)
    y = xf * lax.rsqrt(jnp.mean(xf * xf, axis=-1, keepdims=True) + RMS_EPS)
    return (y * g.astype(jnp.float32)).astype(x.dtype)


def rope(t, cos, sin):
    half = t.shape[-1] // 2
    t1 = t[..., :half].astype(jnp.float32)
    t2 = t[..., half:].astype(jnp.float32)
    return jnp.concatenate([t1 * cos - t2 * sin, t2 * cos + t1 * sin], axis=-1).astype(t.dtype)


def t5_bucket(rel):
    nb = REL_BUCKETS // 2
    max_exact = nb // 2
    n = jnp.abs(rel)
    nf = jnp.maximum(n, 1).astype(jnp.float32)
    large = max_exact + (jnp.log(nf / max_exact) / math.log(REL_MAX_DISTANCE / max_exact)
                         * (nb - max_exact)).astype(jnp.int32)
    large = jnp.minimum(large, nb - 1)
    return jnp.where(rel > 0, nb, 0) + jnp.where(n < max_exact, n, large)


def mla_attention(q_a, kv_a, q_a_norm_g, w_q_b, kv_a_norm_g, w_kv_b):
    B, S, _ = q_a.shape
    q = (rms_norm(q_a, q_a_norm_g) @ w_q_b).reshape(B, S, MLA_HEADS, QK_HEAD_DIM)
    q_nope, q_pe = q[..., :QK_NOPE_DIM], q[..., QK_NOPE_DIM:]
    c_kv, k_pe = kv_a[..., :KV_LORA_RANK], kv_a[..., KV_LORA_RANK:]
    kv = (rms_norm(c_kv, kv_a_norm_g) @ w_kv_b).reshape(B, S, MLA_HEADS, QK_NOPE_DIM + V_HEAD_DIM)
    k_nope, v = kv[..., :QK_NOPE_DIM], kv[..., QK_NOPE_DIM:]

    pos = jnp.arange(S, dtype=jnp.float32)
    inv_freq = 1.0 / (ROPE_THETA ** (jnp.arange(0, QK_ROPE_DIM, 2, dtype=jnp.float32) / QK_ROPE_DIM))
    ang = pos[:, None] * inv_freq[None, :]
    cos, sin = jnp.cos(ang), jnp.sin(ang)
    q_pe = rope(q_pe, cos[None, :, None, :], sin[None, :, None, :])
    k_pe = rope(k_pe, cos[None], sin[None])

    scale = QK_HEAD_DIM ** -0.5
    n_blk = S // Q_BLOCK

    def to_blocks(t):
        return jnp.moveaxis(t.reshape(B, n_blk, Q_BLOCK, t.shape[2], t.shape[3]), 1, 0)

    def attend(blk):
        qn_b, qp_b = blk
        s = (jnp.einsum('bqhd,bkhd->bhqk', qn_b, k_nope)
             + jnp.einsum('bqhd,bkd->bhqk', qp_b, k_pe)).astype(jnp.float32) * scale
        p = jax.nn.softmax(s, axis=-1)
        return jnp.einsum('bhqk,bkhd->bqhd', p.astype(v.dtype), v)

    o = lax.map(attend, (to_blocks(q_nope), to_blocks(q_pe)))
    return jnp.moveaxis(o, 0, 1).reshape(B, S, MLA_WIDTH)


def dilated_band_attention(q, k, v, bias_tab, window, dil):
    B, S, H, Dh = q.shape
    half = window // (2 * dil)
    L = -(-S // (half * dil)) * half
    nb = L // half
    Sp = L * dil
    pad = ((0, 0), (0, Sp - S), (0, 0), (0, 0))

    def to_res(t):
        return jnp.pad(t, pad).reshape(B, L, dil, H, Dh).transpose(0, 2, 1, 3, 4)

    def band(t):
        widths = [(0, 0), (0, 0), (half, half)] + [(0, 0)] * (t.ndim - 3)
        tb = jnp.pad(t, widths).reshape(t.shape[:2] + (nb + 2, half) + t.shape[3:])
        return jnp.concatenate([tb[:, :, :-2], tb[:, :, 1:-1], tb[:, :, 2:]], axis=3)

    qr = to_res(q).reshape(B, dil, nb, half, H, Dh)
    kb = band(to_res(k))
    vb = band(to_res(v))
    valid = (jnp.arange(Sp) < S).reshape(L, dil).T[None]
    kvalid = band(valid)

    steps = jnp.arange(3 * half)[None, :] - half - jnp.arange(half)[:, None]
    in_band = jnp.abs(steps) <= half
    bias = jnp.transpose(bias_tab[t5_bucket(steps * dil)], (2, 0, 1)).astype(jnp.float32)

    s = jnp.einsum('brnqhd,brnkhd->brnhqk', qr, kb).astype(jnp.float32) * (Dh ** -0.5) + bias
    mask = in_band & kvalid[:, :, :, None, None, :]
    s = jnp.where(mask, s, NEG_INF)
    m = jnp.max(s, axis=-1, keepdims=True)
    p = jnp.exp(s - m)
    den = jnp.sum(p, axis=-1, keepdims=True)
    o = jnp.einsum('brnhqk,brnkhd->brnqhd', (p / den).astype(v.dtype), vb)
    lse = (m + jnp.log(den))[..., 0]

    o = o.reshape(B, dil, L, H, Dh).transpose(0, 2, 1, 3, 4).reshape(B, Sp, H, Dh)[:, :S]
    lse = lse.transpose(0, 1, 2, 4, 3).reshape(B, dil, L, H).transpose(0, 2, 1, 3).reshape(B, Sp, H)[:, :S]
    return o, lse


def dilated_mixture(dq, dk, dv, rel_bias):
    B, S, _ = dq.shape
    q = dq.reshape(B, S, DSWA_HEADS, DSWA_HEAD_DIM)
    k = dk.reshape(B, S, DSWA_HEADS, DSWA_HEAD_DIM)
    v = dv.reshape(B, S, DSWA_HEADS, DSWA_HEAD_DIM)
    outs, lses = [], []
    for g, (window, dil) in enumerate(DIL_GROUPS):
        hs = slice(g * DSWA_HEADS_PER_GROUP, (g + 1) * DSWA_HEADS_PER_GROUP)
        o, lse = dilated_band_attention(q[:, :, hs], k[:, :, hs], v[:, :, hs], rel_bias[:, hs], window, dil)
        outs.append(o)
        lses.append(lse)
    w = jax.nn.softmax(jnp.stack(lses, axis=0), axis=0)
    mix = jnp.sum(w[..., None] * jnp.stack(outs, axis=0).astype(jnp.float32), axis=0)
    return mix.astype(dq.dtype).reshape(B, S, DSWA_WIDTH)


def setup_inputs(seed: int = 0) -> dict:
    key = jax.random.key(seed)
    ks = jax.random.split(key, 16)
    f32 = jnp.float32
    x = jax.random.normal(ks[0], (BATCH, SEQ, D_MODEL), f32)
    emb_ln_g = 1.0 + 0.02 * jax.random.normal(ks[1], (D_MODEL,), f32)
    emb_ln_b = 0.02 * jax.random.normal(ks[2], (D_MODEL,), f32)
    rel_bias = 0.5 * jax.random.normal(ks[3], (REL_BUCKETS, DSWA_HEADS), f32)
    col_scale = jnp.ones((IN_WIDTH,), f32).at[DSWA_V_START:DSWA_V_END].set(DEEPNORM_BETA)
    w_in = jax.random.normal(ks[4], (DEPTH, D_MODEL, IN_WIDTH), f32) * (D_MODEL ** -0.5) * col_scale
    q_a_norm_g = 1.0 + 0.02 * jax.random.normal(ks[5], (DEPTH, Q_LORA_RANK), f32)
    w_q_b = jax.random.normal(ks[6], (DEPTH, Q_LORA_RANK, MLA_HEADS * QK_HEAD_DIM), f32) * (Q_LORA_RANK ** -0.5)
    kv_a_norm_g = 1.0 + 0.02 * jax.random.normal(ks[7], (DEPTH, KV_LORA_RANK), f32)
    kv_col_scale = jnp.tile(jnp.concatenate([jnp.ones((QK_NOPE_DIM,), f32),
                                             jnp.full((V_HEAD_DIM,), DEEPNORM_BETA, f32)]), MLA_HEADS)
    w_kv_b = (jax.random.normal(ks[8], (DEPTH, KV_LORA_RANK, MLA_HEADS * (QK_NOPE_DIM + V_HEAD_DIM)), f32)
              * (KV_LORA_RANK ** -0.5) * kv_col_scale)
    w_o_mla = jax.random.normal(ks[9], (DEPTH, MLA_WIDTH, D_MODEL), f32) * (MLA_WIDTH ** -0.5) * DEEPNORM_BETA
    w_o_dswa = jax.random.normal(ks[10], (DEPTH, DSWA_WIDTH, D_MODEL), f32) * (DSWA_WIDTH ** -0.5) * DEEPNORM_BETA
    w_out = jax.random.normal(ks[11], (DEPTH, D_MODEL, D_MODEL), f32) * (D_MODEL ** -0.5) * DEEPNORM_BETA
    ln_g = 1.0 + 0.02 * jax.random.normal(ks[12], (DEPTH, D_MODEL), f32)
    ln_b = 0.02 * jax.random.normal(ks[13], (DEPTH, D_MODEL), f32)
    return {"x": x, "emb_ln_g": emb_ln_g, "emb_ln_b": emb_ln_b, "rel_bias": rel_bias,
            "w_in": w_in, "q_a_norm_g": q_a_norm_g, "w_q_b": w_q_b, "kv_a_norm_g": kv_a_norm_g,
            "w_kv_b": w_kv_b, "w_o_mla": w_o_mla, "w_o_dswa": w_o_dswa, "w_out": w_out,
            "ln_g": ln_g, "ln_b": ln_b}


def reference(x, emb_ln_g, emb_ln_b, rel_bias, w_in, q_a_norm_g, w_q_b, kv_a_norm_g,
              w_kv_b, w_o_mla, w_o_dswa, w_out, ln_g, ln_b):
    h = layer_norm(x, emb_ln_g, emb_ln_b)
    for l in range(DEPTH):
        proj = h @ w_in[l]
        q_a, kv_a, dq, dk, dv, g_mla, g_dswa, r_mla, r_dswa = jnp.split(proj, IN_OFFSETS, axis=-1)
        a = mla_attention(q_a, kv_a, q_a_norm_g[l], w_q_b[l], kv_a_norm_g[l], w_kv_b[l])
        y_mla = (a * jax.nn.silu(g_mla)) @ w_o_mla[l]
        b = dilated_mixture(dq, dk, dv, rel_bias)
        y_dswa = (b * jax.nn.silu(g_dswa)) @ w_o_dswa[l]
        merged = jax.nn.sigmoid(r_mla) * y_mla + jax.nn.sigmoid(r_dswa) * y_dswa
        out = merged @ w_out[l]
        h = layer_norm(DEEPNORM_ALPHA * h + out, ln_g[l], ln_b[l])
    return h
```

```cpp
#include <hip/hip_runtime.h>
#include <hip/hip_cooperative_groups.h>
#include <cstdio>
#include <cstdint>
#include <cmath>
namespace cg = cooperative_groups;

constexpr int SEQ = 8192, DM = 4096;
constexpr int LDP = 22272;
constexpr int C_QA = 0, C_CKV = 1024, C_DQ = 1536, C_DK = 4608, C_DV = 7680, C_GMLA = 10752, C_GDSWA = 12800, C_RMLA = 13824, C_RDSWA = 17920, C_KPE = 22016;
constexpr int IN_W = 22080;
constexpr float LOG2E = 1.4426950408889634f;
constexpr float QS_D = 0.08838834764831845f * LOG2E;
constexpr float QS_M = 0.07216878364870323f * LOG2E;
constexpr float ALPHA = 1.189207115002721f;
constexpr float LN_EPS = 1e-5f, RMS_EPS = 1e-6f;

__device__ __forceinline__ int opaque_tid() { int t = threadIdx.x; asm volatile("" : "+v"(t)); return t; }

namespace pg8 {
#define PG8_LAS __attribute__((address_space(3)))
typedef unsigned short bf16_t;
typedef short bf16x8 __attribute__((ext_vector_type(8)));
typedef float f32x4 __attribute__((ext_vector_type(4)));
typedef unsigned u32x4 __attribute__((ext_vector_type(4)));
constexpr int BM = 256, BK = 64, HALF = 128, HTB = HALF * BK * 2  , STAGE_BYTES = 8 * HTB, NXCD = 8, WGM = 8;

__host__ __device__ __forceinline__ int lds_byte(int r, int c) { const int st = (r >> 4) * 2 + (c >> 5), rr = r & 15, cc = c & 31, ob = rr * 64 + cc * 2; return st * 1024 + (ob ^ (((ob >> 9) & 1) << 5)); }
__host__ __device__ __forceinline__ void stage_rc(int b, int& R, int& C) { const int st = b / 1024, sb = b % 1024, swz = sb ^ (((sb >> 9) & 1) << 5); R = (st >> 1) * 16 + swz / 64; C = (st & 1) * 32 + (swz % 64) / 2; }
__host__ __device__ __forceinline__ int perm32(int rho) { const int n = rho >> 4, i = rho & 15; return 8 * (i >> 2) + 4 * n + (i & 3); }

struct Unit { int pm, pn; };
struct Gemm { const bf16_t* A; const bf16_t* Bt; int M, N, K, lda, ldb; };

struct StaticOrder {
    int nM, nN, nwg, G, c;
    __host__ __device__ void init(int M, int N, int G_, int c_) { nM = M / BM; nN = N / BM; nwg = nM * nN; G = G_; c = c_; }
    __host__ __device__ bool next(int i, Unit& u) const {
        const long L = (long)i * G + c; if (L >= nwg) return false;
        int wgid = (int)L; { const int q = nwg / NXCD, r = nwg % NXCD, xcd = wgid % NXCD, off = wgid / NXCD; wgid = (xcd < r ? xcd * (q + 1) : r * (q + 1) + (xcd - r) * q) + off; }
        const int nig = WGM * nN, gid = wgid / nig, fm = gid * WGM, gsz = (nM - fm) < WGM ? (nM - fm) : WGM;
        u.pm = fm + ((wgid % nig) % gsz); u.pn = (wgid % nig) / gsz; return true;
    }
    __device__ __forceinline__ void a_ready(const Unit&) const {}
    __device__ __forceinline__ void done(const Unit&) const {}
};


typedef float f32x2 __attribute__((ext_vector_type(2))); typedef __bf16 bf16x2_t __attribute__((ext_vector_type(2)));
__device__ __forceinline__ unsigned cvt_pk_bf16(float lo, float hi) { f32x2 v = {lo, hi}; bf16x2_t b = __builtin_convertvector(v, bf16x2_t); return __builtin_bit_cast(unsigned, b); }
__device__ __forceinline__ float bflo(unsigned w) { return __uint_as_float(w << 16); }
__device__ __forceinline__ float bfhi(unsigned w) { return __uint_as_float(w & 0xffff0000u); }
__device__ __forceinline__ float sigm(float x) { return __builtin_amdgcn_rcpf(1.f + __builtin_amdgcn_exp2f(-x * 1.4426950408889634f)); }
__device__ __forceinline__ u32x4 pack8(const f32x4 v0, const f32x4 v1) { u32x4 w; w.x = cvt_pk_bf16(v0[0], v0[1]); w.y = cvt_pk_bf16(v0[2], v0[3]); w.z = cvt_pk_bf16(v1[0], v1[1]); w.w = cvt_pk_bf16(v1[2], v1[3]); return w; }
__device__ __forceinline__ void rope8(f32x4& v0, f32x4& v1, const f32x4 cs0, const f32x4 cs1) {
    const float a0 = v0[0] * cs0[0] - v0[1] * cs0[1], b0 = v0[1] * cs0[0] + v0[0] * cs0[1];
    const float a1 = v0[2] * cs0[2] - v0[3] * cs0[3], b1 = v0[3] * cs0[2] + v0[2] * cs0[3];
    const float a2 = v1[0] * cs1[0] - v1[1] * cs1[1], b2 = v1[1] * cs1[0] + v1[0] * cs1[1];
    const float a3 = v1[2] * cs1[2] - v1[3] * cs1[3], b3 = v1[3] * cs1[2] + v1[2] * cs1[3];
    v0 = (f32x4){a0, b0, a1, b1}; v1 = (f32x4){a2, b2, a3, b3};
}

struct EpiProj {
    static constexpr bool PERM = true, AFTER_DRAIN = false;
    bf16_t* proj; bf16_t* kpe; float* rss_q; float* rss_kv; const float* rope;
    template <int ACT> __device__ __forceinline__ void body(const f32x4 (&acc)[2][2][4][2], const Unit& u, int wr, int wc, int fr, int fq, float sc, float* rss) const {
        const int row0 = u.pm * BM + wr * 64 + fr, col0 = u.pn * BM + wc * 32 + 8 * fq;
#pragma unroll
        for (int ai = 0; ai < 2; ++ai)
#pragma unroll
            for (int m = 0; m < 4; ++m) { const int row = row0 + ai * HALF + m * 16; bf16_t* rowp = proj + (size_t)row * LDP + col0; float ss = 0.f;
#pragma unroll
                for (int bj = 0; bj < 2; ++bj) { f32x4 v0 = acc[ai][bj][m][0], v1 = acc[ai][bj][m][1];
                    if (ACT == 0) { v0 = v0 * sc; v1 = v1 * sc; }
                    if (ACT == 1) {
#pragma unroll
                        for (int e = 0; e < 4; ++e) { v0[e] = v0[e] * sigm(v0[e]); v1[e] = v1[e] * sigm(v1[e]); } }
                    if (ACT == 2) {
#pragma unroll
                        for (int e = 0; e < 4; ++e) { v0[e] = sigm(v0[e]); v1[e] = sigm(v1[e]); } }
                    if (ACT == 3) { ss += (v0[0] * v0[0] + v0[1] * v0[1]) + (v0[2] * v0[2] + v0[3] * v0[3]) + (v1[0] * v1[0] + v1[1] * v1[1]) + (v1[2] * v1[2] + v1[3] * v1[3]); }
                    *(u32x4*)(rowp + bj * HALF) = pack8(v0, v1); }
                if (ACT == 3) { ss += __shfl_xor(ss, 16); ss += __shfl_xor(ss, 32); if (fq == 0) atomicAdd(rss + row, ss); } }
    }
    __device__ __forceinline__ void operator()(const f32x4 (&acc)[2][2][4][2], const Unit& u, int wr, int wc, int fr, int fq) const {
        const int pn = u.pn;
        if (pn < 4) body<3>(acc, u, wr, wc, fr, fq, 1.f, rss_q);
        else if (pn < 6) body<3>(acc, u, wr, wc, fr, fq, 1.f, rss_kv);
        else if (pn < 42) body<0>(acc, u, wr, wc, fr, fq, pn < 18 ? QS_D : 1.f, nullptr);
        else if (pn < 54) body<1>(acc, u, wr, wc, fr, fq, 1.f, nullptr);
        else if (pn < 86) body<2>(acc, u, wr, wc, fr, fq, 1.f, nullptr);
        else if (wc < 2) {
            const int row0 = u.pm * BM + wr * 64 + fr, c0 = wc * 32 + 8 * fq;
#pragma unroll
            for (int ai = 0; ai < 2; ++ai)
#pragma unroll
                for (int m = 0; m < 4; ++m) { const int row = row0 + ai * HALF + m * 16; f32x4 v0 = acc[ai][0][m][0], v1 = acc[ai][0][m][1];
                    const f32x4* cs = (const f32x4*)(rope + (size_t)row * 64 + c0); rope8(v0, v1, cs[0], cs[1]);
                    *(u32x4*)(kpe + (size_t)row * 64 + c0) = pack8(v0, v1); }
        }
    }
};
struct EpiQ {
    static constexpr bool PERM = true, AFTER_DRAIN = false;
    bf16_t* q; const float* rss; const float* rope;
    __device__ __forceinline__ void operator()(const f32x4 (&acc)[2][2][4][2], const Unit& u, int wr, int wc, int fr, int fq) const {
        const int row0 = u.pm * BM + wr * 64 + fr, col0 = u.pn * BM + wc * 32 + 8 * fq;
        const int cw0 = col0 % 192, cw1 = (col0 + HALF) % 192;
#pragma unroll
        for (int ai = 0; ai < 2; ++ai)
#pragma unroll
            for (int m = 0; m < 4; ++m) { const int row = row0 + ai * HALF + m * 16; const float sc = QS_M / sqrtf(rss[row] * (1.f / 1024.f) + RMS_EPS);
#pragma unroll
                for (int bj = 0; bj < 2; ++bj) { f32x4 v0 = acc[ai][bj][m][0] * sc, v1 = acc[ai][bj][m][1] * sc; const int cw = bj ? cw1 : cw0;
                    if (cw >= 128) { const f32x4* cs = (const f32x4*)(rope + (size_t)row * 64 + (cw - 128)); rope8(v0, v1, cs[0], cs[1]); }
                    *(u32x4*)(q + (size_t)row * 3072 + col0 + bj * HALF) = pack8(v0, v1); } }
    }
};
struct EpiKV {
    static constexpr bool PERM = true, AFTER_DRAIN = false;
    bf16_t* kv; const float* rss;
    __device__ __forceinline__ void operator()(const f32x4 (&acc)[2][2][4][2], const Unit& u, int wr, int wc, int fr, int fq) const {
        const int row0 = u.pm * BM + wr * 64 + fr, col0 = u.pn * BM + wc * 32 + 8 * fq;
#pragma unroll
        for (int ai = 0; ai < 2; ++ai)
#pragma unroll
            for (int m = 0; m < 4; ++m) { const int row = row0 + ai * HALF + m * 16; const float sc = 1.f / sqrtf(rss[row] * (1.f / 512.f) + RMS_EPS);
#pragma unroll
                for (int bj = 0; bj < 2; ++bj) *(u32x4*)(kv + (size_t)row * 4096 + col0 + bj * HALF) = pack8(acc[ai][bj][m][0] * sc, acc[ai][bj][m][1] * sc); }
    }
};
template <int PASS> struct EpiY {
    static constexpr bool PERM = true, AFTER_DRAIN = false;
    bf16_t* T; const bf16_t* gate;
    __device__ __forceinline__ void operator()(const f32x4 (&acc)[2][2][4][2], const Unit& u, int wr, int wc, int fr, int fq) const {
        const int row0 = u.pm * BM + wr * 64 + fr, col0 = u.pn * BM + wc * 32 + 8 * fq;
#pragma unroll
        for (int ai = 0; ai < 2; ++ai)
#pragma unroll
            for (int m = 0; m < 4; ++m) { const int row = row0 + ai * HALF + m * 16;
#pragma unroll
                for (int bj = 0; bj < 2; ++bj) { const u32x4 gw = *(const u32x4*)(gate + (size_t)row * LDP + col0 + bj * HALF); bf16_t* tp = T + (size_t)row * 4096 + col0 + bj * HALF;
                    f32x4 v0 = acc[ai][bj][m][0], v1 = acc[ai][bj][m][1];
                    v0 = v0 * (f32x4){bflo(gw.x), bfhi(gw.x), bflo(gw.y), bfhi(gw.y)}; v1 = v1 * (f32x4){bflo(gw.z), bfhi(gw.z), bflo(gw.w), bfhi(gw.w)};
                    if (PASS == 1) { const u32x4 tw = *(const u32x4*)tp; v0 = v0 + (f32x4){bflo(tw.x), bfhi(tw.x), bflo(tw.y), bfhi(tw.y)}; v1 = v1 + (f32x4){bflo(tw.z), bfhi(tw.z), bflo(tw.w), bfhi(tw.w)}; }
                    *(u32x4*)tp = pack8(v0, v1); } }
    }
};
struct EpiOut {
    static constexpr bool PERM = false, AFTER_DRAIN = false;
    const float* x; const float* stats; const float* g; const float* b; float* out;
    __device__ __forceinline__ void operator()(const f32x4 (&acc)[2][2][4][2], const Unit& u, int wr, int wc, int fr, int fq) const {
        const int row0 = u.pm * BM + wr * 64 + fr, col0 = u.pn * BM + wc * 32 + 4 * fq;
#pragma unroll
        for (int bj = 0; bj < 2; ++bj)
#pragma unroll
            for (int n = 0; n < 2; ++n) { const int col = col0 + bj * HALF + n * 16; const f32x4 gv = *(const f32x4*)(g + col) * ALPHA, bv = *(const f32x4*)(b + col) * ALPHA;
#pragma unroll
                for (int ai = 0; ai < 2; ++ai)
#pragma unroll
                    for (int m = 0; m < 4; ++m) { const int row = row0 + ai * HALF + m * 16; const f32x2 st = *(const f32x2*)(stats + 2 * row);
                        const size_t off = (size_t)row * 4096 + col; const f32x4 xv = *(const f32x4*)(x + off);
                        *(f32x4*)(out + off) = ((xv - st.x) * st.y) * gv + bv + acc[ai][bj][m][n]; } }
    }
};

template <class Epi, class Sched, bool ALIGN_EPI = false, bool SP2 = false>
__device__ __forceinline__ void gemm_phase(PG8_LAS unsigned char* lds, const Gemm g, const Sched& S, const Epi& E) {
    const int tid = opaque_tid(), wid = __builtin_amdgcn_readfirstlane(tid >> 6), lane = tid & 63, wr = wid >> 2, wc = wid & 3, fr = lane & 15, fq = lane >> 4;
    const int K = g.K, nt = K / BK;
    unsigned voffA[2], voffB[2];
#pragma unroll
    for (int i = 0; i < 2; ++i) { int R, C; stage_rc(tid * 16 + i * 8192, R, C); const int Rb = Epi::PERM ? ((R & ~31) + perm32(R & 31)) : R;
        voffA[i] = (unsigned)(R * g.lda + C) * 2u; voffB[i] = (unsigned)(Rb * g.ldb + C) * 2u; }
    const size_t kstep = (size_t)(BK * 2);
    const size_t hstepA = (size_t)HALF * g.lda * 2, hstepB = (size_t)HALF * g.ldb * 2;
    const size_t tstepA = 2 * hstepA, tstepB = 2 * hstepB;
    const unsigned ldsw = (unsigned)wid * 1024u;
    const int aoff = lds_byte(wr * 64 + fr, fq * 8), boff = lds_byte(wc * 32 + fr, fq * 8);
#define PG8_SA(b, h) (((b) * 2 + (h)) * HTB)
#define PG8_SB(b, h) ((4 + (b) * 2 + (h)) * HTB)
#define PG8_STAGE(bufoff, gbase, voff) do { _Pragma("unroll") for (int _i = 0; _i < 2; ++_i) \
        __builtin_amdgcn_global_load_lds((const unsigned*)((const char*)(gbase) + (voff)[_i]), (PG8_LAS unsigned*)(lds + (bufoff) + ldsw + _i * 8192), 16, 0, 0); } while (0)
#define PG8_LDA(dst, b, h) do { _Pragma("unroll") for (int m = 0; m < 4; ++m) _Pragma("unroll") for (int k = 0; k < 2; ++k) dst[m][k] = *(const PG8_LAS bf16x8*)(lds + PG8_SA(b, h) + aoff + m * 2048 + k * 1024); } while (0)
#define PG8_LDB(dst, b, h) do { _Pragma("unroll") for (int n = 0; n < 2; ++n) _Pragma("unroll") for (int k = 0; k < 2; ++k) dst[n][k] = *(const PG8_LAS bf16x8*)(lds + PG8_SB(b, h) + boff + n * 2048 + k * 1024); } while (0)
#define PG8_MMA(ai, bj, At, Bt) do { __builtin_amdgcn_s_setprio(1); _Pragma("unroll") for (int m = 0; m < 4; ++m) _Pragma("unroll") for (int n = 0; n < 2; ++n) _Pragma("unroll") for (int k = 0; k < 2; ++k) \
        acc[ai][bj][m][n] = __builtin_amdgcn_mfma_f32_16x16x32_bf16(Bt[n][k], At[m][k], acc[ai][bj][m][n], 0, 0, 0); __builtin_amdgcn_s_setprio(0); } while (0)
#define PG8_WAIT_V(n) asm volatile("s_waitcnt vmcnt(" #n ")" ::: "memory")
#define PG8_WAIT_L(n) asm volatile("s_waitcnt lgkmcnt(" #n ")" ::: "memory")
#define PG8_BAR __builtin_amdgcn_s_barrier()
#define PG8_SCHED __builtin_amdgcn_sched_barrier(0)
    Unit cur, nxt; int ui = 0;
    if (!S.next(0, cur)) return;
    f32x4 acc[2][2][4][2];
#pragma unroll
    for (int a = 0; a < 2; ++a)
#pragma unroll
        for (int b = 0; b < 2; ++b)
#pragma unroll
            for (int m = 0; m < 4; ++m)
#pragma unroll
                for (int n = 0; n < 2; ++n) acc[a][b][m][n] = (f32x4){0.f, 0.f, 0.f, 0.f};
    bf16x8 At[4][2], B0[2][2], B1[2][2];
    const char* cA = (const char*)g.A + (size_t)cur.pm * tstepA; const char* cB = (const char*)g.Bt + (size_t)cur.pn * tstepB;
    S.a_ready(cur);
    if constexpr (SP2) {
        PG8_STAGE(PG8_SB(0, 0), cB, voffB); PG8_STAGE(PG8_SB(0, 1), cB + hstepB, voffB); PG8_STAGE(PG8_SA(0, 0), cA, voffA); PG8_STAGE(PG8_SA(0, 1), cA + hstepA, voffA);
        if (wr == 1) PG8_BAR;
        PG8_WAIT_V(2); PG8_BAR;
        PG8_STAGE(PG8_SB(1, 0), cB + kstep, voffB); PG8_STAGE(PG8_SA(1, 0), cA + kstep, voffA); PG8_STAGE(PG8_SB(1, 1), cB + hstepB + kstep, voffB);
        PG8_WAIT_V(6); PG8_BAR;
    } else {
        PG8_STAGE(PG8_SB(0, 0), cB, voffB); PG8_STAGE(PG8_SA(0, 0), cA, voffA); PG8_STAGE(PG8_SB(0, 1), cB + hstepB, voffB); PG8_STAGE(PG8_SA(0, 1), cA + hstepA, voffA);
        if (wr == 1) PG8_BAR;
        PG8_WAIT_V(4); PG8_BAR;
        PG8_STAGE(PG8_SB(1, 0), cB + kstep, voffB); PG8_STAGE(PG8_SA(1, 0), cA + kstep, voffA); PG8_STAGE(PG8_SB(1, 1), cB + hstepB + kstep, voffB);
        PG8_WAIT_V(6); PG8_BAR;
    }
    for (;;) {
        const bool has_next = S.next(ui + 1, nxt);
        const char* nA = has_next ? (const char*)g.A + (size_t)nxt.pm * tstepA : cA; const char* nB = has_next ? (const char*)g.Bt + (size_t)nxt.pn * tstepB : cB;
        for (int t = 0; t < nt; t += 2) {
            const bool last = (t == nt - 2);
            const char* a1 = cA + (size_t)(t + 1) * kstep;
            const char* a2 = last ? nA : cA + (size_t)(t + 2) * kstep; const char* b2 = last ? nB : cB + (size_t)(t + 2) * kstep;
            const char* a3 = a2 + kstep; const char* b3 = b2 + kstep;
            if (last && has_next) S.a_ready(nxt);
            if constexpr (SP2) {
            PG8_LDB(B0, 0, 0); PG8_LDB(B1, 0, 1); PG8_SCHED; PG8_LDA(At, 0, 0); PG8_STAGE(PG8_SA(1, 1), a1 + hstepA, voffA);
            PG8_WAIT_V(8); PG8_WAIT_L(0); PG8_BAR; PG8_MMA(0, 0, At, B0); PG8_MMA(0, 1, At, B1); PG8_BAR; PG8_SCHED;
            PG8_LDA(At, 0, 1); PG8_STAGE(PG8_SB(0, 0), b2, voffB); PG8_STAGE(PG8_SB(0, 1), b2 + hstepB, voffB); PG8_STAGE(PG8_SA(0, 0), a2, voffA);
            PG8_WAIT_V(8); PG8_WAIT_L(0); PG8_BAR; PG8_MMA(1, 0, At, B0); PG8_MMA(1, 1, At, B1); PG8_BAR; PG8_SCHED;
            PG8_LDB(B0, 1, 0); PG8_LDB(B1, 1, 1); PG8_SCHED; PG8_LDA(At, 1, 0); PG8_STAGE(PG8_SA(0, 1), a2 + hstepA, voffA);
            PG8_WAIT_V(8); PG8_WAIT_L(0); PG8_BAR; PG8_MMA(0, 0, At, B0); PG8_MMA(0, 1, At, B1); PG8_BAR; PG8_SCHED;
            PG8_LDA(At, 1, 1); PG8_STAGE(PG8_SB(1, 0), b3, voffB); PG8_STAGE(PG8_SB(1, 1), b3 + hstepB, voffB); PG8_STAGE(PG8_SA(1, 0), a3, voffA);
            PG8_WAIT_V(8); PG8_WAIT_L(0); PG8_BAR; PG8_MMA(1, 0, At, B0); PG8_MMA(1, 1, At, B1); PG8_BAR; PG8_SCHED;
            } else {
            PG8_LDB(B0, 0, 0); PG8_SCHED; PG8_LDA(At, 0, 0); PG8_STAGE(PG8_SA(1, 1), a1 + hstepA, voffA);
            PG8_WAIT_L(8); PG8_BAR; PG8_WAIT_L(0); PG8_MMA(0, 0, At, B0); PG8_BAR; PG8_SCHED;
            PG8_LDB(B1, 0, 1); PG8_STAGE(PG8_SB(0, 0), b2, voffB);
            PG8_BAR; PG8_WAIT_L(0); PG8_MMA(0, 1, At, B1); PG8_BAR;
            PG8_LDA(At, 0, 1); PG8_STAGE(PG8_SA(0, 0), a2, voffA);
            PG8_BAR; PG8_WAIT_L(0); PG8_MMA(1, 0, At, B0); PG8_BAR; PG8_SCHED;
            PG8_STAGE(PG8_SB(0, 1), b2 + hstepB, voffB);
            PG8_WAIT_V(6); PG8_BAR; PG8_MMA(1, 1, At, B1); PG8_BAR;
            PG8_LDB(B0, 1, 0); PG8_SCHED; PG8_LDA(At, 1, 0); PG8_STAGE(PG8_SA(0, 1), a2 + hstepA, voffA);
            PG8_WAIT_L(8); PG8_BAR; PG8_WAIT_L(0); PG8_MMA(0, 0, At, B0); PG8_BAR; PG8_SCHED;
            PG8_LDB(B1, 1, 1); PG8_STAGE(PG8_SB(1, 0), b3, voffB);
            PG8_BAR; PG8_WAIT_L(0); PG8_MMA(0, 1, At, B1); PG8_BAR;
            PG8_LDA(At, 1, 1); PG8_STAGE(PG8_SA(1, 0), a3, voffA);
            PG8_BAR; PG8_WAIT_L(0); PG8_MMA(1, 0, At, B0); PG8_BAR; PG8_SCHED;
            PG8_STAGE(PG8_SB(1, 1), b3 + hstepB, voffB);
            PG8_WAIT_V(6); PG8_BAR; PG8_MMA(1, 1, At, B1); PG8_BAR;
            }
        }
        if constexpr (ALIGN_EPI) { if (wr == 0) PG8_BAR; }
        if constexpr (!Epi::AFTER_DRAIN) { E(acc, cur, wr, wc, fr, fq); S.done(cur); }
        if (!has_next) break;
#pragma unroll
        for (int a = 0; a < 2; ++a)
#pragma unroll
            for (int b = 0; b < 2; ++b)
#pragma unroll
                for (int m = 0; m < 4; ++m)
#pragma unroll
                    for (int n = 0; n < 2; ++n) acc[a][b][m][n] = (f32x4){0.f, 0.f, 0.f, 0.f};
        cur = nxt; cA = nA; cB = nB; ++ui;
        if constexpr (ALIGN_EPI) { if (wr == 1) PG8_BAR; }
    }
    PG8_WAIT_V(0);
    if constexpr (!ALIGN_EPI) { if (wr == 0) PG8_BAR; }
    PG8_BAR;
    if constexpr (Epi::AFTER_DRAIN) { E.fused(acc, cur, wr, wc, fr, fq, lds, wid, lane); S.done(cur); }
#undef PG8_SA
#undef PG8_SB
#undef PG8_STAGE
#undef PG8_LDA
#undef PG8_LDB
#undef PG8_MMA
#undef PG8_WAIT_V
#undef PG8_WAIT_L
#undef PG8_BAR
#undef PG8_SCHED
}
}

namespace att {
typedef unsigned short bf16_t;
using bf16x8 = __attribute__((ext_vector_type(8))) short;
using s16x4  = __attribute__((ext_vector_type(4))) short;
using f32x16 = __attribute__((ext_vector_type(16))) float;
using u32x4  = __attribute__((ext_vector_type(4))) unsigned;
constexpr int NW = 8, QBLK = 32, KVBLK = 64;
constexpr int SHM_V = 16384, SHM_KN = 16384, SHM_KP = 8192;
constexpr int OFF_V = 0, OFF_KN = 2 * SHM_V, OFF_KP = OFF_KN + 2 * SHM_KN, OFF_WS = OFF_KP + 2 * SHM_KP, OFF_BIAS = OFF_WS + NW * 64 * 4, OFF_QPE = OFF_BIAS + 1024, ATT_LDS = OFF_QPE + NW * 4096;
#define KSWZ(row, colB) ((row) * 256 + ((colB) ^ (((row) & 7) << 4)))
#define KPSWZ(row, colB) ((row) * 128 + ((colB) ^ ((((row) >> 1) & 7) << 4)))
#define SBAR() __builtin_amdgcn_sched_barrier(0)
__device__ __forceinline__ int crow(int r, int hi) { return (r & 3) + 8 * (r >> 2) + 4 * hi; }
typedef float f32x2_t __attribute__((ext_vector_type(2))); typedef __bf16 bf16x2_t __attribute__((ext_vector_type(2)));
__device__ __forceinline__ unsigned cvtpk(float lo, float hi) { f32x2_t v = {lo, hi}; bf16x2_t b = __builtin_convertvector(v, bf16x2_t); return __builtin_bit_cast(unsigned, b); }
__device__ __forceinline__ bf16x8 ld8(const bf16_t* p) { return *reinterpret_cast<const bf16x8*>(p); }

template <int THR2>
__device__ __forceinline__ void partialSM(f32x16& p0, f32x16& p1, float& m_reg, float& alpha) {
  float pmax = p0[0];
#pragma unroll
  for (int r = 1; r < 16; ++r) pmax = fmaxf(pmax, p0[r]);
#pragma unroll
  for (int r = 0; r < 16; ++r) pmax = fmaxf(pmax, p1[r]);
  { auto rr = __builtin_amdgcn_permlane32_swap(__float_as_uint(pmax), __float_as_uint(pmax), false, false);
    pmax = fmaxf(__uint_as_float(rr[0]), __uint_as_float(rr[1])); }
  float mn;
  if (THR2 > 0 && __builtin_expect(__all(pmax - m_reg <= (float)THR2), 1)) { mn = m_reg; alpha = 1.f; }
  else { mn = fmaxf(m_reg, pmax); alpha = __builtin_amdgcn_exp2f(m_reg - mn); m_reg = mn; }
#pragma unroll
  for (int r = 0; r < 16; ++r) p0[r] = p0[r] - mn;
#pragma unroll
  for (int r = 0; r < 16; ++r) p1[r] = p1[r] - mn;
#pragma unroll
  for (int r = 0; r < 16; ++r) p0[r] = __builtin_amdgcn_exp2f(p0[r]);
}
__device__ __forceinline__ void finishSM(f32x16& p0, f32x16& p1, float alpha, float& l_reg, bf16x8& pa0, bf16x8& pa1, bf16x8& pa2, bf16x8& pa3) {
#pragma unroll
  for (int r = 0; r < 16; ++r) p1[r] = __builtin_amdgcn_exp2f(p1[r]);
  float ps = 0;
#pragma unroll
  for (int r = 0; r < 16; ++r) ps += p0[r];
#pragma unroll
  for (int r = 0; r < 16; ++r) ps += p1[r];
  { auto rr = __builtin_amdgcn_permlane32_swap(__float_as_uint(ps), __float_as_uint(ps), false, false);
    ps = __uint_as_float(rr[0]) + __uint_as_float(rr[1]); }
  l_reg = l_reg * alpha + ps;
#define PK4(P, BASE, OUT) do { unsigned a0 = cvtpk(P[BASE + 0], P[BASE + 1]), a1 = cvtpk(P[BASE + 2], P[BASE + 3]);   \
    unsigned b0 = cvtpk(P[BASE + 4], P[BASE + 5]), b1 = cvtpk(P[BASE + 6], P[BASE + 7]);                              \
    auto r0 = __builtin_amdgcn_permlane32_swap(a0, b0, false, false); auto r1 = __builtin_amdgcn_permlane32_swap(a1, b1, false, false); \
    u32x4 w = {r0[0], r1[0], r0[1], r1[1]}; OUT = *reinterpret_cast<bf16x8*>(&w); } while (0)
  PK4(p0, 0, pa0); PK4(p0, 8, pa1); PK4(p1, 0, pa2); PK4(p1, 8, pa3);
#undef PK4
}
template <int NPE>
__device__ __forceinline__ void qkt(f32x16& p0, f32x16& p1, const char* Kn, const char* Kp, const bf16x8* qr, const char* qpe, int r32, int hi) {
  p0 = f32x16{}; p1 = f32x16{};
#pragma unroll
  for (int d0 = 0; d0 < 8; ++d0) { const int cb = (d0 * 16 + hi * 8) * 2;
    bf16x8 b0 = *reinterpret_cast<const bf16x8*>(Kn + KSWZ(r32, cb));
    bf16x8 b1 = *reinterpret_cast<const bf16x8*>(Kn + KSWZ(32 + r32, cb));
    p0 = __builtin_amdgcn_mfma_f32_32x32x16_bf16(b0, qr[d0], p0, 0, 0, 0);
    p1 = __builtin_amdgcn_mfma_f32_32x32x16_bf16(b1, qr[d0], p1, 0, 0, 0); }
#pragma unroll
  for (int d0 = 0; d0 < NPE; ++d0) { const int cb = (d0 * 16 + hi * 8) * 2;
    bf16x8 b0 = *reinterpret_cast<const bf16x8*>(Kp + KPSWZ(r32, cb));
    bf16x8 b1 = *reinterpret_cast<const bf16x8*>(Kp + KPSWZ(32 + r32, cb));
    const bf16x8 qf = *reinterpret_cast<const bf16x8*>(qpe + d0 * 1024);
    p0 = __builtin_amdgcn_mfma_f32_32x32x16_bf16(b0, qf, p0, 0, 0, 0);
    p1 = __builtin_amdgcn_mfma_f32_32x32x16_bf16(b1, qf, p1, 0, 0, 0); }
}
__device__ __forceinline__ int v_st(int k, int c) { const int kk = (k & ~0xC) | ((k & 4) << 1) | ((k & 8) >> 1); return ((kk >> 3) * 4 + (c >> 5)) * 512 + ((kk & 7) * 32 + (c & 31)) * 2; }
__device__ __forceinline__ int v_rd_base(int lane) { return ((lane & 3) << 3) | (((lane >> 2) & 3) << 6) | (((lane >> 4) & 1) << 5) | (((lane >> 5) & 1) << 8); }
constexpr int v_rd_off(int d0, int ks, int half) { return d0 * 512 + ks * 4096 + half * 2048; }
template <int OFF> __device__ __forceinline__ s16x4 tr_read(int vb) {
  s16x4 r; asm volatile("ds_read_b64_tr_b16 %0, %1 offset:%2" : "=&v"(r) : "v"(vb), "i"(OFF) : "memory"); return r;
}
template <int D0> __device__ __forceinline__ void pv_one(f32x16& od, int vb, bf16x8 pa0, bf16x8 pa1, bf16x8 pa2, bf16x8 pa3) {
  const s16x4 l0 = tr_read<v_rd_off(D0, 0, 0)>(vb), h0 = tr_read<v_rd_off(D0, 0, 1)>(vb), l1 = tr_read<v_rd_off(D0, 1, 0)>(vb), h1 = tr_read<v_rd_off(D0, 1, 1)>(vb);
  const s16x4 l2 = tr_read<v_rd_off(D0, 2, 0)>(vb), h2 = tr_read<v_rd_off(D0, 2, 1)>(vb), l3 = tr_read<v_rd_off(D0, 3, 0)>(vb), h3 = tr_read<v_rd_off(D0, 3, 1)>(vb);
  asm volatile("s_waitcnt lgkmcnt(0)" ::: "memory"); SBAR();
#define PK(L, H) (bf16x8){L[0], L[1], L[2], L[3], H[0], H[1], H[2], H[3]}
  od = __builtin_amdgcn_mfma_f32_32x32x16_bf16(pa0, PK(l0, h0), od, 0, 0, 0);
  od = __builtin_amdgcn_mfma_f32_32x32x16_bf16(pa1, PK(l1, h1), od, 0, 0, 0);
  od = __builtin_amdgcn_mfma_f32_32x32x16_bf16(pa2, PK(l2, h2), od, 0, 0, 0);
  od = __builtin_amdgcn_mfma_f32_32x32x16_bf16(pa3, PK(l3, h3), od, 0, 0, 0);
#undef PK
}
__device__ __forceinline__ void pv_d0(f32x16* o, int vb, bf16x8 pa0, bf16x8 pa1, bf16x8 pa2, bf16x8 pa3) {
  pv_one<0>(o[0], vb, pa0, pa1, pa2, pa3); pv_one<1>(o[1], vb, pa0, pa1, pa2, pa3); pv_one<2>(o[2], vb, pa0, pa1, pa2, pa3); pv_one<3>(o[3], vb, pa0, pa1, pa2, pa3);
}
#define RESC(a) do { if (__any((a) < 1.f)) { if (hi == 0) al_l[r32] = (a); asm volatile("s_waitcnt lgkmcnt(0)" ::: "memory"); \
    _Pragma("unroll") for (int d = 0; d < 4; ++d) _Pragma("unroll") for (int r = 0; r < 16; ++r) o[d][r] *= al_l[crow(r, hi)]; } } while (0)

__device__ __forceinline__ void mla_unit(const bf16_t* __restrict__ Qb, const bf16_t* __restrict__ Kh, const bf16_t* __restrict__ Vh, const bf16_t* __restrict__ Kpe,
                                         const bf16_t* __restrict__ Gb, bf16_t* __restrict__ Ob, char* lds) {
  constexpr int LDQ = 3072, LDK = 4096, LDO = 2048, NT = SEQ / KVBLK;
  const int tid = opaque_tid(), wid = tid >> 6, lane = tid & 63, r32 = lane & 31, hi = lane >> 5;
  char* V_lds = lds + OFF_V; char* Kn_lds = lds + OFF_KN; char* Kp_lds = lds + OFF_KP;
  float* ws = (float*)(lds + OFF_WS) + wid * 64; float* li_l = ws; float* al_l = ws + 32;
  float m_reg = -1e30f, l_reg = 0; f32x16 o[4] = {}; bf16x8 qr[8];
  const bf16_t* Qw = Qb + (long)(wid * QBLK + r32) * LDQ + hi * 8;
#pragma unroll
  for (int d0 = 0; d0 < 8; ++d0) qr[d0] = ld8(Qw + d0 * 16);
  char* qpe = lds + OFF_QPE + wid * 4096 + lane * 16;
#pragma unroll
  for (int d0 = 0; d0 < 4; ++d0) *reinterpret_cast<bf16x8*>(qpe + d0 * 1024) = ld8(Qw + 128 + d0 * 16);
  const int sr = tid >> 4, sc = (tid & 15) * 8, vst0 = v_st(sr, sc), vst1 = v_st(32 + sr, sc);
  const int pr = tid >> 3, pc = (tid & 7) * 8;
  const int vb0 = (int)(uintptr_t)V_lds + v_rd_base(lane);
  bf16x8 vs0, vs1, ks0, ks1, kp0;
#define SLOAD(k0) do { vs0 = ld8(&Vh[(long)((k0) + sr) * LDK + sc]); vs1 = ld8(&Vh[(long)((k0) + 32 + sr) * LDK + sc]); \
    ks0 = ld8(&Kh[(long)((k0) + sr) * LDK + sc]); ks1 = ld8(&Kh[(long)((k0) + 32 + sr) * LDK + sc]); kp0 = ld8(&Kpe[(long)((k0) + pr) * 64 + pc]); } while (0)
#define SWRITE(b) do { *(bf16x8*)(V_lds + (b) * SHM_V + vst0) = vs0; *(bf16x8*)(V_lds + (b) * SHM_V + vst1) = vs1; const int kc = sc * 2; \
    *(bf16x8*)(Kn_lds + (b) * SHM_KN + KSWZ(sr, kc)) = ks0; *(bf16x8*)(Kn_lds + (b) * SHM_KN + KSWZ(32 + sr, kc)) = ks1; \
    *(bf16x8*)(Kp_lds + (b) * SHM_KP + KPSWZ(pr, pc * 2)) = kp0; } while (0)
#define SWAIT() asm volatile("s_waitcnt vmcnt(0)" ::: "memory")
  f32x16 pA0, pA1, pB0, pB1; float alA, alB; bf16x8 pa0, pa1, pa2, pa3;
  SLOAD(0); SWAIT(); SWRITE(0); __syncthreads();
  qkt<4>(pA0, pA1, Kn_lds, Kp_lds, qr, qpe, r32, hi); partialSM<11>(pA0, pA1, m_reg, alA);
  SLOAD(KVBLK);
  SWAIT(); SWRITE(1); __syncthreads();
  for (int j = 1; j + 1 < NT; j += 2) {
    SBAR(); qkt<4>(pB0, pB1, Kn_lds + SHM_KN, Kp_lds + SHM_KP, qr, qpe, r32, hi);
    finishSM(pA0, pA1, alA, l_reg, pa0, pa1, pa2, pa3); SBAR();
    SLOAD((j + 1) * KVBLK); SBAR();
    pv_d0(o, vb0, pa0, pa1, pa2, pa3); partialSM<11>(pB0, pB1, m_reg, alB);
    __syncthreads(); SWAIT(); SWRITE(0);
    RESC(alB); __syncthreads();
    SBAR(); qkt<4>(pA0, pA1, Kn_lds, Kp_lds, qr, qpe, r32, hi);
    finishSM(pB0, pB1, alB, l_reg, pa0, pa1, pa2, pa3); SBAR();
    SLOAD((j + 2) * KVBLK); SBAR();
    pv_d0(o, vb0 + SHM_V, pa0, pa1, pa2, pa3); partialSM<11>(pA0, pA1, m_reg, alA);
    __syncthreads(); SWAIT(); SWRITE(1);
    RESC(alA); __syncthreads();
  }
  SBAR(); qkt<4>(pB0, pB1, Kn_lds + SHM_KN, Kp_lds + SHM_KP, qr, qpe, r32, hi);
  finishSM(pA0, pA1, alA, l_reg, pa0, pa1, pa2, pa3); SBAR();
  pv_d0(o, vb0, pa0, pa1, pa2, pa3); partialSM<11>(pB0, pB1, m_reg, alB);
  __syncthreads(); RESC(alB);
  finishSM(pB0, pB1, alB, l_reg, pa0, pa1, pa2, pa3); SBAR();
  pv_d0(o, vb0 + SHM_V, pa0, pa1, pa2, pa3);
  if (hi == 0) li_l[r32] = l_reg; asm volatile("s_waitcnt lgkmcnt(0)" ::: "memory");
  float rli[16];
#pragma unroll
  for (int r = 0; r < 16; ++r) rli[r] = __builtin_amdgcn_rcpf(li_l[crow(r, hi)]);
  __syncthreads();
  bf16_t* Ow = Ob + (long)(wid * QBLK) * LDO; const bf16_t* Gw = Gb + (long)(wid * QBLK) * LDP;
  { bf16_t* stg = (bf16_t*)(lds + wid * 8704);
#pragma unroll
    for (int r = 0; r < 16; ++r) { const int orow = crow(r, hi);
#pragma unroll
      for (int d0 = 0; d0 < 4; ++d0) { const float ov = o[d0][r] * rli[r]; stg[orow * 136 + d0 * 32 + r32] = (bf16_t)(cvtpk(ov, ov) & 0xffffu); } }
    asm volatile("s_waitcnt lgkmcnt(0)" ::: "memory");
    int lz = lane; asm volatile("" : "+v"(lz));
#pragma unroll
    for (int i = 0; i < 8; ++i) { const int id = i * 64 + lz, row = id >> 4, c = (id & 15) * 8;
      const u32x4 ov = *(const u32x4*)(stg + row * 136 + c); const u32x4 gv = *(const u32x4*)(Gw + (long)row * LDP + c); u32x4 w;
#pragma unroll
      for (int k = 0; k < 4; ++k) w[k] = cvtpk(__uint_as_float(ov[k] << 16) * __uint_as_float(gv[k] << 16), __uint_as_float(ov[k] & 0xffff0000u) * __uint_as_float(gv[k] & 0xffff0000u));
      *(u32x4*)(Ow + (long)row * LDO + c) = w; } }
  __syncthreads();
#undef SLOAD
#undef SWRITE
#undef SWAIT
}

__device__ __forceinline__ void dswa_unit(int H, int rs, int qb, const bf16_t* __restrict__ proj, const float* __restrict__ bias2, bf16_t* __restrict__ Od, float* __restrict__ lse, char* lds) {
  const int g = H >> 3, dil = 1 << (2 * g), L = SEQ / dil, Q0 = qb * 256, T0 = Q0 - 64;
  const int tid = opaque_tid(), wid = tid >> 6, lane = tid & 63, r32 = lane & 31, hi = lane >> 5;
  char* V_lds = lds + OFF_V; char* Kn_lds = lds + OFF_KN;
  float* ws = (float*)(lds + OFF_WS) + wid * 64; float* li_l = ws; float* al_l = ws + 32;
  float* bl = (float*)(lds + OFF_BIAS);
  const bf16_t* Qp = proj + C_DQ + H * 128; const bf16_t* Kp = proj + C_DK + H * 128; const bf16_t* Vp = proj + C_DV + H * 128;
  if (tid < 129) bl[tid] = bias2[(g * 8 + (H & 7)) * 129 + tid];
  const int qa = Q0 + wid * QBLK, qi = qa + r32;
  bf16x8 qr[8];
  { const bf16_t* Qw = Qp + (size_t)(qi * dil + rs) * LDP + hi * 8;
#pragma unroll
    for (int d0 = 0; d0 < 8; ++d0) qr[d0] = ld8(Qw + d0 * 16); }
  const int sr = tid >> 4, sc = (tid & 15) * 8, vst0 = v_st(sr, sc), vst1 = v_st(32 + sr, sc);
  const int vb0 = (int)(uintptr_t)V_lds + v_rd_base(lane);
  float m_reg = -1e29f, l_reg = 0.f; f32x16 o[4] = {};
  for (int t = 0; t < 6; ++t) {
    const int k0 = T0 + 64 * t;
    if (k0 + 63 < 0 || k0 >= L) continue;
    int i0 = k0 + sr, i1 = k0 + 32 + sr; i0 = i0 < 0 ? 0 : (i0 >= L ? L - 1 : i0); i1 = i1 < 0 ? 0 : (i1 >= L ? L - 1 : i1);
    const size_t o0 = (size_t)(i0 * dil + rs) * LDP + sc, o1 = (size_t)(i1 * dil + rs) * LDP + sc;
    const bf16x8 vs0 = ld8(Vp + o0), vs1 = ld8(Vp + o1), ks0 = ld8(Kp + o0), ks1 = ld8(Kp + o1);
    __syncthreads();
    *(bf16x8*)(V_lds + vst0) = vs0; *(bf16x8*)(V_lds + vst1) = vs1;
    *(bf16x8*)(Kn_lds + KSWZ(sr, sc * 2)) = ks0; *(bf16x8*)(Kn_lds + KSWZ(32 + sr, sc * 2)) = ks1;
    __syncthreads();
    if (k0 > qa + 31 + 64 || k0 + 63 < qa - 64) continue;
    f32x16 p0, p1; qkt<0>(p0, p1, Kn_lds, Kn_lds, qr, Kn_lds, r32, hi);
#pragma unroll
    for (int r = 0; r < 16; ++r) { const int kj = k0 + crow(r, hi), dj = kj - qi; int bi = dj + 64; bi = bi < 0 ? 0 : (bi > 128 ? 128 : bi);
      const int kj1 = kj + 32, dj1 = dj + 32; int bi1 = dj1 + 64; bi1 = bi1 < 0 ? 0 : (bi1 > 128 ? 128 : bi1);
      const bool ok0 = (dj >= -64) && (dj <= 64) && (kj >= 0) && (kj < L), ok1 = (dj1 >= -64) && (dj1 <= 64) && (kj1 >= 0) && (kj1 < L);
      p0[r] = ok0 ? p0[r] + bl[bi] : -1e30f; p1[r] = ok1 ? p1[r] + bl[bi1] : -1e30f; }
    float al; partialSM<0>(p0, p1, m_reg, al);
    bf16x8 pa0, pa1, pa2, pa3; finishSM(p0, p1, al, l_reg, pa0, pa1, pa2, pa3);
    RESC(al);
    SBAR(); pv_d0(o, vb0, pa0, pa1, pa2, pa3);
  }
  if (hi == 0) li_l[r32] = l_reg; asm volatile("s_waitcnt lgkmcnt(0)" ::: "memory");
  float rli[16];
#pragma unroll
  for (int r = 0; r < 16; ++r) rli[r] = __builtin_amdgcn_rcpf(li_l[crow(r, hi)]);
  const int hh = H & 7;
  bf16_t* Og = Od + (size_t)g * SEQ * 1024 + hh * 128;
#pragma unroll
  for (int r = 0; r < 16; ++r) { const size_t pos = (size_t)(qa + crow(r, hi)) * dil + rs;
#pragma unroll
    for (int d0 = 0; d0 < 4; ++d0) { const float ov = o[d0][r] * rli[r]; Og[pos * 1024 + d0 * 32 + r32] = (bf16_t)(cvtpk(ov, ov) & 0xffffu); } }
  if (hi == 0) lse[((size_t)g * SEQ + (size_t)qi * dil + rs) * 8 + hh] = m_reg + __builtin_amdgcn_logf(l_reg);
  __syncthreads();
}
#undef RESC
#undef KSWZ
#undef KPSWZ
#undef SBAR
}

#define LAS __attribute__((address_space(3)))
typedef unsigned short bf16;
typedef unsigned v4u __attribute__((ext_vector_type(4)));
typedef float f32x4 __attribute__((ext_vector_type(4)));
constexpr int NWAVES = 8;
constexpr size_t MiB = 1u << 20;
constexpr size_t WS_RSSQ = 0, WS_RSSKV = 32768, WS_STATS = 65536, WS_BIAS2 = 131072, WS_LSE = 262144;
constexpr size_t WS_ROPE = 2 * MiB;
constexpr size_t WS_WIN = 4 * MiB, WS_WQB = 178 * MiB, WS_WKVB = 184 * MiB, WS_WOMLA = 188 * MiB, WS_WODSWA = 204 * MiB, WS_WOUT = 212 * MiB;
constexpr size_t WS_H = 244 * MiB, WS_PROJ = 308 * MiB, WS_QMLA = 656 * MiB, WS_KVMLA = 704 * MiB, WS_KPE = 768 * MiB, WS_AMLA = 770 * MiB;
constexpr size_t WS_ODSWA = 802 * MiB, WS_BDSWA = 850 * MiB, WS_T = 866 * MiB, WS_END = 930 * MiB;
static_assert(WS_WIN + (size_t)LDP * 4096 * 2 <= WS_WQB && WS_PROJ + (size_t)SEQ * LDP * 2 <= WS_QMLA && WS_LSE + 3 * SEQ * 8 * 4 <= WS_ROPE, "d_ws map");
constexpr int LDS_BYTES = 147456;

__device__ __forceinline__ unsigned f2bf(float f) { unsigned u = __builtin_bit_cast(unsigned, f); return (u + 0x7fffu + ((u >> 16) & 1u)) >> 16; }
__device__ __forceinline__ unsigned pk2(float lo, float hi) { return f2bf(lo) | (f2bf(hi) << 16); }
__device__ __forceinline__ float wave_sum(float v) {
#pragma unroll
    for (int o = 1; o < 64; o <<= 1) v += __shfl_xor(v, o);
    return v;
}
__device__ __forceinline__ void transpose_item(const float* __restrict__ W, int K, int N, bf16* __restrict__ WT, int k0, int n0, int dbase, int dstride, const float* __restrict__ kscale, LAS float* scr, int lane) {
#pragma unroll 8
    for (int i = 0; i < 32; ++i) { const int kk = 2 * i + (lane >> 5); float w = W[(size_t)(k0 + kk) * N + n0 + (lane & 31)]; if (kscale) w *= kscale[k0 + kk]; scr[kk * 33 + (lane & 31)] = w; }
    asm volatile("s_waitcnt lgkmcnt(0)" ::: "memory");
    const int c = lane & 7;
#pragma unroll
    for (int j = 0; j < 4; ++j) { const int n = (lane >> 3) + 8 * j; const LAS float* s = scr + (8 * c) * 33 + n;
        v4u o; o.x = pk2(s[0 * 33], s[1 * 33]); o.y = pk2(s[2 * 33], s[3 * 33]); o.z = pk2(s[4 * 33], s[5 * 33]); o.w = pk2(s[6 * 33], s[7 * 33]);
        *(v4u*)(WT + (size_t)(dbase + dstride * n) * K + k0 + 8 * c) = o; }
    asm volatile("s_waitcnt lgkmcnt(0)" ::: "memory");
}

struct Args { const float* in[14]; float* out; unsigned char* ws; };

__global__ void __launch_bounds__(NWAVES * 64, 2) fwd_mega(Args a) {
    extern __shared__ __attribute__((aligned(16))) unsigned char lds[];
    cg::grid_group grid = cg::this_grid();
    const int G = gridDim.x, bx = blockIdx.x, vcu = (G % 8 == 0) ? (bx % 8) * (G / 8) + bx / 8 : bx;
    LAS unsigned char* ldsl = (LAS unsigned char*)lds;
    unsigned char* ws = a.ws;
    const float* x = a.in[0]; const float* emb_g = a.in[1]; const float* emb_b = a.in[2]; const float* rel_bias = a.in[3]; const float* w_in = a.in[4];
    const float* qa_g = a.in[5]; const float* w_qb = a.in[6]; const float* kva_g = a.in[7]; const float* w_kvb = a.in[8]; const float* w_omla = a.in[9];
    const float* w_odswa = a.in[10]; const float* w_out = a.in[11]; const float* ln_g = a.in[12]; const float* ln_b = a.in[13];
    float* rss_q = (float*)(ws + WS_RSSQ); float* rss_kv = (float*)(ws + WS_RSSKV); float* stats = (float*)(ws + WS_STATS); float* bias2 = (float*)(ws + WS_BIAS2);
    float* lse = (float*)(ws + WS_LSE); float* rope = (float*)(ws + WS_ROPE);
    bf16* Win_t = (bf16*)(ws + WS_WIN); bf16* Wqb_t = (bf16*)(ws + WS_WQB); bf16* Wkvb_t = (bf16*)(ws + WS_WKVB); bf16* Womla_t = (bf16*)(ws + WS_WOMLA);
    bf16* Wodswa_t = (bf16*)(ws + WS_WODSWA); bf16* Wout_t = (bf16*)(ws + WS_WOUT);
    bf16* Hb = (bf16*)(ws + WS_H); bf16* proj = (bf16*)(ws + WS_PROJ); bf16* Qmla = (bf16*)(ws + WS_QMLA); bf16* KVmla = (bf16*)(ws + WS_KVMLA); bf16* Kpe = (bf16*)(ws + WS_KPE);
    bf16* Amla = (bf16*)(ws + WS_AMLA); bf16* Odswa = (bf16*)(ws + WS_ODSWA); bf16* Bdswa = (bf16*)(ws + WS_BDSWA); bf16* Tm = (bf16*)(ws + WS_T);
    const int NGW = G * NWAVES, NGT = G * NWAVES * 64;
#define PHASE_IDS() const int tid = opaque_tid(), lane = tid & 63, wave = __builtin_amdgcn_readfirstlane(tid >> 6), gw = vcu * NWAVES + wave, gt = bx * (NWAVES * 64) + tid; (void)lane; (void)gw; (void)gt

    {
        PHASE_IDS();
        LAS float* scr = (LAS float*)(ldsl + wave * 16384);
        constexpr int I_IN = 64 * 690, I_QB = 16 * 96, I_KVB = 8 * 128, I_OM = 32 * 128, I_OD = 16 * 128, I_OUT = 64 * 128;
        constexpr int NITEMS = I_IN + I_QB + I_KVB + I_OM + I_OD + I_OUT;
        for (int it = gw; it < NITEMS; it += NGW) {
            int r = it;
            if (r < I_IN) { const int kb = r / 690, nb = r % 690; int db, ds; if (nb < 48) { db = nb * 32; ds = 1; } else if (nb == 48) { db = C_KPE; ds = 2; } else if (nb == 49) { db = C_KPE + 1; ds = 2; } else { db = nb * 32 - 64; ds = 1; }
                transpose_item(w_in, 4096, IN_W, Win_t, kb * 64, nb * 32, db, ds, nullptr, scr, lane); continue; } r -= I_IN;
            if (r < I_QB) { const int kb = r / 96, nb = r % 96, hq = nb / 6, bi = nb % 6; int db, ds; if (bi < 4) { db = hq * 192 + bi * 32; ds = 1; } else { db = hq * 192 + 128 + (bi - 4); ds = 2; }
                transpose_item(w_qb, 1024, 3072, Wqb_t, kb * 64, nb * 32, db, ds, qa_g, scr, lane); continue; } r -= I_QB;
            if (r < I_KVB) { const int kb = r / 128, nb = r % 128; transpose_item(w_kvb, 512, 4096, Wkvb_t, kb * 64, nb * 32, nb * 32, 1, kva_g, scr, lane); continue; } r -= I_KVB;
            if (r < I_OM) { const int kb = r / 128, nb = r % 128; transpose_item(w_omla, 2048, 4096, Womla_t, kb * 64, nb * 32, nb * 32, 1, nullptr, scr, lane); continue; } r -= I_OM;
            if (r < I_OD) { const int kb = r / 128, nb = r % 128; transpose_item(w_odswa, 1024, 4096, Wodswa_t, kb * 64, nb * 32, nb * 32, 1, nullptr, scr, lane); continue; } r -= I_OD;
            { const int kb = r / 128, nb = r % 128; transpose_item(w_out, 4096, 4096, Wout_t, kb * 64, nb * 32, nb * 32, 1, nullptr, scr, lane); }
        }
        for (int m = gw; m < SEQ; m += NGW) {
            const f32x4* xr = (const f32x4*)(x + (size_t)m * DM) + lane;
            f32x4 v[16]; float s = 0.f;
#pragma unroll
            for (int j = 0; j < 16; ++j) { v[j] = xr[64 * j]; s += (v[j].x + v[j].y) + (v[j].z + v[j].w); }
            const float mean = wave_sum(s) * (1.f / DM); float s2 = 0.f;
#pragma unroll
            for (int j = 0; j < 16; ++j) { v[j] = v[j] - mean; s2 += (v[j].x * v[j].x + v[j].y * v[j].y) + (v[j].z * v[j].z + v[j].w * v[j].w); }
            const float rstd = 1.f / sqrtf(wave_sum(s2) * (1.f / DM) + LN_EPS);
            if (lane == 0) { stats[2 * m] = mean; stats[2 * m + 1] = rstd; }
            unsigned long long* o8 = (unsigned long long*)(Hb + (size_t)m * DM) + lane;
#pragma unroll
            for (int j = 0; j < 16; ++j) { const f32x4 gv = ((const f32x4*)emb_g)[64 * j + lane], bv = ((const f32x4*)emb_b)[64 * j + lane]; const f32x4 y = v[j] * rstd * gv + bv;
                o8[64 * j] = (unsigned long long)pk2(y.x, y.y) | ((unsigned long long)pk2(y.z, y.w) << 32); }
        }
        for (int e = gt; e < SEQ * 32; e += NGT) { const int pos = e >> 5, i = e & 31; const float invf = 1.0f / powf(10000.0f, (float)(2 * i) / 64.0f); const float ang = (float)pos * invf;
            double t = (double)ang * 0.15915494309189535; t -= __builtin_floor(t); const float tf = (float)t;
            rope[2 * e] = __builtin_amdgcn_cosf(tf); rope[2 * e + 1] = __builtin_amdgcn_sinf(tf); }
        for (int e = gt; e < 3 * 8 * 129; e += NGT) { const int j = e % 129 - 64, hh = (e / 129) % 8, g = e / (129 * 8), dil = 1 << (2 * g); const int rel = j * dil, n = rel < 0 ? -rel : rel;
            int bk; if (n < 8) bk = n; else { const float nf = (float)n; int lg = 8 + (int)(logf(nf / 8.f) / 4.852030263919617f * 8.f); bk = lg < 15 ? lg : 15; }
            if (rel > 0) bk += 16;
            bias2[e] = rel_bias[bk * 24 + g * 8 + hh] * LOG2E; }
        for (int e = gt; e < 2 * SEQ; e += NGT) rss_q[e] = 0.f;
    }
    grid.sync();

    {
        pg8::Gemm g{Hb, Win_t, SEQ, LDP, 4096, 4096, 4096}; pg8::StaticOrder S; S.init(SEQ, LDP, G, bx);
        pg8::EpiProj E{proj, Kpe, rss_q, rss_kv, rope};
        pg8::gemm_phase<pg8::EpiProj, pg8::StaticOrder, true, true>(ldsl, g, S, E);
    }
    grid.sync();

    {
        { pg8::Gemm g{proj + C_QA, Wqb_t, SEQ, 3072, 1024, LDP, 1024}; pg8::StaticOrder S; S.init(SEQ, 3072, G, bx);
          pg8::EpiQ E{Qmla, rss_q, rope}; pg8::gemm_phase<pg8::EpiQ, pg8::StaticOrder, true, true>(ldsl, g, S, E); }
        { pg8::Gemm g{proj + C_CKV, Wkvb_t, SEQ, 4096, 512, LDP, 512}; pg8::StaticOrder S; S.init(SEQ, 4096, G, bx);
          pg8::EpiKV E{KVmla, rss_kv}; pg8::gemm_phase<pg8::EpiKV, pg8::StaticOrder, true, true>(ldsl, g, S, E); }
        __syncthreads();
        for (int u = vcu; u < 768; u += G) { const int H = u >> 5, rem = u & 31, g = H >> 3, nqb = 32 >> (2 * g); att::dswa_unit(H, rem / nqb, rem % nqb, proj, bias2, Odswa, lse, (char*)lds); }
    }
    grid.sync();

    {
        for (int u = vcu; u < 512; u += G) { const int h = u >> 5, qb = u & 31; const size_t r0 = (size_t)qb * 256;
            att::mla_unit(Qmla + r0 * 3072 + h * 192, KVmla + h * 256, KVmla + h * 256 + 128, Kpe, proj + r0 * LDP + C_GMLA + h * 128, Amla + r0 * 2048 + h * 128, (char*)lds); }
        PHASE_IDS();
        for (int it = gt; it < SEQ * 128; it += NGT) { const int pos = it >> 7, c8 = it & 127, hh = c8 >> 4, col = c8 * 8;
            const float l0 = lse[((size_t)0 * SEQ + pos) * 8 + hh], l1 = lse[((size_t)1 * SEQ + pos) * 8 + hh], l2 = lse[((size_t)2 * SEQ + pos) * 8 + hh];
            const float mx = fmaxf(l0, fmaxf(l1, l2)); float e0 = __builtin_amdgcn_exp2f(l0 - mx), e1 = __builtin_amdgcn_exp2f(l1 - mx), e2 = __builtin_amdgcn_exp2f(l2 - mx);
            const float inv = 1.f / (e0 + e1 + e2); e0 *= inv; e1 *= inv; e2 *= inv;
            const v4u a0 = *(const v4u*)(Odswa + ((size_t)0 * SEQ + pos) * 1024 + col), a1 = *(const v4u*)(Odswa + ((size_t)1 * SEQ + pos) * 1024 + col), a2 = *(const v4u*)(Odswa + ((size_t)2 * SEQ + pos) * 1024 + col);
            const v4u gg = *(const v4u*)(proj + (size_t)pos * LDP + C_GDSWA + col); v4u o;
#pragma unroll
            for (int k = 0; k < 4; ++k) { const float lo = (pg8::bflo(a0[k]) * e0 + pg8::bflo(a1[k]) * e1 + pg8::bflo(a2[k]) * e2) * pg8::bflo(gg[k]);
                const float hi = (pg8::bfhi(a0[k]) * e0 + pg8::bfhi(a1[k]) * e1 + pg8::bfhi(a2[k]) * e2) * pg8::bfhi(gg[k]); o[k] = pk2(lo, hi); }
            *(v4u*)(Bdswa + (size_t)pos * 1024 + col) = o; }
    }
    grid.sync();

    {
        { pg8::Gemm g{Amla, Womla_t, SEQ, 4096, 2048, 2048, 2048}; pg8::StaticOrder S; S.init(SEQ, 4096, G, bx);
          pg8::EpiY<0> E{Tm, proj + C_RMLA}; pg8::gemm_phase<pg8::EpiY<0>, pg8::StaticOrder, true, true>(ldsl, g, S, E); }
        { pg8::Gemm g{Bdswa, Wodswa_t, SEQ, 4096, 1024, 1024, 1024}; pg8::StaticOrder S; S.init(SEQ, 4096, G, bx);
          pg8::EpiY<1> E{Tm, proj + C_RDSWA}; pg8::gemm_phase<pg8::EpiY<1>, pg8::StaticOrder, true, true>(ldsl, g, S, E); }
    }
    grid.sync();

    {
        pg8::Gemm g{Tm, Wout_t, SEQ, 4096, 4096, 4096, 4096}; pg8::StaticOrder S; S.init(SEQ, 4096, G, bx);
        pg8::EpiOut E{x, stats, emb_g, emb_b, a.out}; pg8::gemm_phase<pg8::EpiOut, pg8::StaticOrder, true, true>(ldsl, g, S, E);
    }
    grid.sync();

    { PHASE_IDS();
    for (int m = gw; m < SEQ; m += NGW) {
        f32x4* xr = (f32x4*)(a.out + (size_t)m * DM) + lane;
        f32x4 v[16]; float s = 0.f;
#pragma unroll
        for (int j = 0; j < 16; ++j) { v[j] = xr[64 * j]; s += (v[j].x + v[j].y) + (v[j].z + v[j].w); }
        const float mean = wave_sum(s) * (1.f / DM); float s2 = 0.f;
#pragma unroll
        for (int j = 0; j < 16; ++j) { v[j] = v[j] - mean; s2 += (v[j].x * v[j].x + v[j].y * v[j].y) + (v[j].z * v[j].z + v[j].w * v[j].w); }
        const float rstd = 1.f / sqrtf(wave_sum(s2) * (1.f / DM) + LN_EPS);
#pragma unroll
        for (int j = 0; j < 16; ++j) { const f32x4 gv = ((const f32x4*)ln_g)[64 * j + lane], bv = ((const f32x4*)ln_b)[64 * j + lane]; xr[64 * j] = v[j] * rstd * gv + bv; }
    } }
}

extern "C" void kernel_launch(void* const* d_in, const int* in_sizes, int n_in, void* d_out, int out_size, void* d_ws, size_t ws_size, hipStream_t stream) {
    static int grid = 0;
    if (grid == 0) {
        if (n_in != 14 || in_sizes[0] != SEQ * DM || out_size != SEQ * DM || ws_size < WS_END) { fprintf(stderr, "kernel_launch: unexpected shapes (n_in %d, in0 %d, out %d, ws %zu < %zu)\n", n_in, n_in > 0 ? in_sizes[0] : -1, out_size, ws_size, (size_t)WS_END); grid = -1; return; }
        int dev = 0, cus = 0, per_cu = 0;
        if (hipGetDevice(&dev) != hipSuccess || hipDeviceGetAttribute(&cus, hipDeviceAttributeMultiprocessorCount, dev) != hipSuccess) { grid = -1; return; }
        if (hipFuncSetAttribute((const void*)fwd_mega, hipFuncAttributeMaxDynamicSharedMemorySize, LDS_BYTES) != hipSuccess) { fprintf(stderr, "kernel_launch: hipFuncSetAttribute failed\n"); grid = -1; return; }
        if (hipOccupancyMaxActiveBlocksPerMultiprocessor(&per_cu, (const void*)fwd_mega, NWAVES * 64, LDS_BYTES) != hipSuccess || per_cu < 1) { fprintf(stderr, "kernel_launch: occupancy query says %d blocks per CU\n", per_cu); per_cu = 1; }
        (void)hipGetLastError();
        grid = cus;
    }
    if (grid < 0) return;
    Args a{};
    for (int i = 0; i < 14; ++i) a.in[i] = (const float*)d_in[i];
    a.out = (float*)d_out; a.ws = (unsigned char*)d_ws;
    void* args[] = {&a};
    hipError_t e = hipLaunchCooperativeKernel((const void*)fwd_mega, dim3(grid), dim3(NWAVES * 64), args, LDS_BYTES, stream);
    if (e != hipSuccess) fprintf(stderr, "kernel_launch: cooperative launch failed: %s (grid %d)\n", hipGetErrorString(e), grid);
}
```

```cpp
#include <hip/hip_runtime.h>
#include <hip/hip_cooperative_groups.h>
#include <cstdio>
#include <cstdint>
#include <cmath>
namespace cg = cooperative_groups;

constexpr int SEQ = 8192, DM = 4096;
constexpr int LDP = 22272;
constexpr int C_QA = 0, C_CKV = 1024, C_DQ = 1536, C_DK = 4608, C_DV = 7680, C_GMLA = 10752, C_GDSWA = 12800, C_RMLA = 13824, C_RDSWA = 17920, C_KPE = 22016;
constexpr int IN_W = 22080;
constexpr float LOG2E = 1.4426950408889634f;
constexpr float QS_D = 0.08838834764831845f * LOG2E;
constexpr float QS_M = 0.07216878364870323f * LOG2E;
constexpr float ALPHA = 1.189207115002721f;
constexpr float LN_EPS = 1e-5f, RMS_EPS = 1e-6f;

__device__ __forceinline__ int opaque_tid() { int t = threadIdx.x; asm volatile("" : "+v"(t)); return t; }

namespace pg8 {
#define PG8_LAS __attribute__((address_space(3)))
typedef unsigned short bf16_t;
typedef short bf16x8 __attribute__((ext_vector_type(8)));
typedef float f32x4 __attribute__((ext_vector_type(4)));
typedef unsigned u32x4 __attribute__((ext_vector_type(4)));
constexpr int BM = 256, BK = 64, HALF = 128, HTB = HALF * BK * 2  , STAGE_BYTES = 8 * HTB, NXCD = 8, WGM = 8;

__host__ __device__ __forceinline__ int lds_byte(int r, int c) { const int st = (r >> 4) * 2 + (c >> 5), rr = r & 15, cc = c & 31, ob = rr * 64 + cc * 2; return st * 1024 + (ob ^ (((ob >> 9) & 1) << 5)); }
__host__ __device__ __forceinline__ void stage_rc(int b, int& R, int& C) { const int st = b / 1024, sb = b % 1024, swz = sb ^ (((sb >> 9) & 1) << 5); R = (st >> 1) * 16 + swz / 64; C = (st & 1) * 32 + (swz % 64) / 2; }
__host__ __device__ __forceinline__ int perm32(int rho) { const int n = rho >> 4, i = rho & 15; return 8 * (i >> 2) + 4 * n + (i & 3); }

struct Unit { int pm, pn; };
struct Gemm { const bf16_t* A; const bf16_t* Bt; int M, N, K, lda, ldb; };

struct StaticOrder {
    int nM, nN, nwg, G, c;
    __host__ __device__ void init(int M, int N, int G_, int c_) { nM = M / BM; nN = N / BM; nwg = nM * nN; G = G_; c = c_; }
    __host__ __device__ bool next(int i, Unit& u) const {
        const long L = (long)i * G + c; if (L >= nwg) return false;
        int wgid = (int)L; { const int q = nwg / NXCD, r = nwg % NXCD, xcd = wgid % NXCD, off = wgid / NXCD; wgid = (xcd < r ? xcd * (q + 1) : r * (q + 1) + (xcd - r) * q) + off; }
        const int nig = WGM * nN, gid = wgid / nig, fm = gid * WGM, gsz = (nM - fm) < WGM ? (nM - fm) : WGM;
        u.pm = fm + ((wgid % nig) % gsz); u.pn = (wgid % nig) / gsz; return true;
    }
    __device__ __forceinline__ void a_ready(const Unit&) const {}
    __device__ __forceinline__ void done(const Unit&) const {}
};


typedef float f32x2 __attribute__((ext_vector_type(2))); typedef __bf16 bf16x2_t __attribute__((ext_vector_type(2)));
typedef int i32x4 __attribute__((ext_vector_type(4))); typedef int i32x8 __attribute__((ext_vector_type(8)));
__device__ __forceinline__ i32x8 cat8(bf16x8 a, bf16x8 b) { return __builtin_shufflevector(__builtin_bit_cast(i32x4, a), __builtin_bit_cast(i32x4, b), 0, 1, 2, 3, 4, 5, 6, 7); }
__device__ __forceinline__ unsigned cvt_pk_bf16(float lo, float hi) { f32x2 v = {lo, hi}; bf16x2_t b = __builtin_convertvector(v, bf16x2_t); return __builtin_bit_cast(unsigned, b); }
__device__ __forceinline__ float bflo(unsigned w) { return __uint_as_float(w << 16); }
__device__ __forceinline__ float bfhi(unsigned w) { return __uint_as_float(w & 0xffff0000u); }
__device__ __forceinline__ float sigm(float x) { return __builtin_amdgcn_rcpf(1.f + __builtin_amdgcn_exp2f(-x * 1.4426950408889634f)); }
__device__ __forceinline__ u32x4 pack8(const f32x4 v0, const f32x4 v1) { u32x4 w; w.x = cvt_pk_bf16(v0[0], v0[1]); w.y = cvt_pk_bf16(v0[2], v0[3]); w.z = cvt_pk_bf16(v1[0], v1[1]); w.w = cvt_pk_bf16(v1[2], v1[3]); return w; }
__device__ __forceinline__ void rope8(f32x4& v0, f32x4& v1, const f32x4 cs0, const f32x4 cs1) {
    const float a0 = v0[0] * cs0[0] - v0[1] * cs0[1], b0 = v0[1] * cs0[0] + v0[0] * cs0[1];
    const float a1 = v0[2] * cs0[2] - v0[3] * cs0[3], b1 = v0[3] * cs0[2] + v0[2] * cs0[3];
    const float a2 = v1[0] * cs1[0] - v1[1] * cs1[1], b2 = v1[1] * cs1[0] + v1[0] * cs1[1];
    const float a3 = v1[2] * cs1[2] - v1[3] * cs1[3], b3 = v1[3] * cs1[2] + v1[2] * cs1[3];
    v0 = (f32x4){a0, b0, a1, b1}; v1 = (f32x4){a2, b2, a3, b3};
}

struct EpiProj {
    static constexpr bool PERM = true, AFTER_DRAIN = false;
    bf16_t* proj; bf16_t* kpe; float* rss_q; float* rss_kv; const float* rope; float osc;
    template <int ACT> __device__ __forceinline__ void body(const f32x4 (&acc)[2][2][4][2], const Unit& u, int wr, int wc, int fr, int fq, float sc, float* rss) const {
        const int row0 = u.pm * BM + wr * 64 + fr, col0 = u.pn * BM + wc * 32 + 8 * fq;
#pragma unroll
        for (int ai = 0; ai < 2; ++ai)
#pragma unroll
            for (int m = 0; m < 4; ++m) { const int row = row0 + ai * HALF + m * 16; bf16_t* rowp = proj + (size_t)row * LDP + col0; float ss = 0.f;
#pragma unroll
                for (int bj = 0; bj < 2; ++bj) { f32x4 v0 = acc[ai][bj][m][0] * sc, v1 = acc[ai][bj][m][1] * sc;
                    if (ACT == 1) {
#pragma unroll
                        for (int e = 0; e < 4; ++e) { v0[e] = v0[e] * sigm(v0[e]); v1[e] = v1[e] * sigm(v1[e]); } }
                    if (ACT == 2) {
#pragma unroll
                        for (int e = 0; e < 4; ++e) { v0[e] = sigm(v0[e]); v1[e] = sigm(v1[e]); } }
                    if (ACT == 3) { ss += (v0[0] * v0[0] + v0[1] * v0[1]) + (v0[2] * v0[2] + v0[3] * v0[3]) + (v1[0] * v1[0] + v1[1] * v1[1]) + (v1[2] * v1[2] + v1[3] * v1[3]); }
                    *(u32x4*)(rowp + bj * HALF) = pack8(v0, v1); }
                if (ACT == 3) { ss += __shfl_xor(ss, 16); ss += __shfl_xor(ss, 32); if (fq == 0 && rss) atomicAdd(rss + row, ss); } }
    }
    __device__ __forceinline__ void operator()(const f32x4 (&acc)[2][2][4][2], const Unit& u, int wr, int wc, int fr, int fq) const {
        const int pn = u.pn;
        if (pn < 4) body<3>(acc, u, wr, wc, fr, fq, osc, rss_q);
        else if (pn < 6) body<3>(acc, u, wr, wc, fr, fq, osc, rss_kv);
        else if (pn < 42) body<0>(acc, u, wr, wc, fr, fq, pn < 18 ? QS_D * osc : osc, nullptr);
        else if (pn < 54) body<1>(acc, u, wr, wc, fr, fq, osc, nullptr);
        else if (pn < 86) body<2>(acc, u, wr, wc, fr, fq, osc, nullptr);
        else if (wc < 2) {
            const int row0 = u.pm * BM + wr * 64 + fr, c0 = wc * 32 + 8 * fq;
#pragma unroll
            for (int ai = 0; ai < 2; ++ai)
#pragma unroll
                for (int m = 0; m < 4; ++m) { const int row = row0 + ai * HALF + m * 16; f32x4 v0 = acc[ai][0][m][0] * osc, v1 = acc[ai][0][m][1] * osc;
                    const f32x4* cs = (const f32x4*)(rope + (size_t)row * 64 + c0); rope8(v0, v1, cs[0], cs[1]);
                    *(u32x4*)(kpe + (size_t)row * 64 + c0) = pack8(v0, v1); }
        }
    }
};
struct EpiQ {
    static constexpr bool PERM = true, AFTER_DRAIN = false;
    bf16_t* q; const float* rss; const float* rope;
    __device__ __forceinline__ void operator()(const f32x4 (&acc)[2][2][4][2], const Unit& u, int wr, int wc, int fr, int fq) const {
        const int row0 = u.pm * BM + wr * 64 + fr, col0 = u.pn * BM + wc * 32 + 8 * fq;
        const int cw0 = col0 % 192, cw1 = (col0 + HALF) % 192;
#pragma unroll
        for (int ai = 0; ai < 2; ++ai)
#pragma unroll
            for (int m = 0; m < 4; ++m) { const int row = row0 + ai * HALF + m * 16; const float sc = QS_M / sqrtf(rss[row] * (1.f / 1024.f) + RMS_EPS);
#pragma unroll
                for (int bj = 0; bj < 2; ++bj) { f32x4 v0 = acc[ai][bj][m][0] * sc, v1 = acc[ai][bj][m][1] * sc; const int cw = bj ? cw1 : cw0;
                    if (cw >= 128) { const f32x4* cs = (const f32x4*)(rope + (size_t)row * 64 + (cw - 128)); rope8(v0, v1, cs[0], cs[1]); }
                    *(u32x4*)(q + (size_t)row * 3072 + col0 + bj * HALF) = pack8(v0, v1); } }
    }
};
struct EpiKV {
    static constexpr bool PERM = true, AFTER_DRAIN = false;
    bf16_t* kv; const float* rss;
    __device__ __forceinline__ void operator()(const f32x4 (&acc)[2][2][4][2], const Unit& u, int wr, int wc, int fr, int fq) const {
        const int row0 = u.pm * BM + wr * 64 + fr, col0 = u.pn * BM + wc * 32 + 8 * fq;
#pragma unroll
        for (int ai = 0; ai < 2; ++ai)
#pragma unroll
            for (int m = 0; m < 4; ++m) { const int row = row0 + ai * HALF + m * 16; const float sc = 1.f / sqrtf(rss[row] * (1.f / 512.f) + RMS_EPS);
#pragma unroll
                for (int bj = 0; bj < 2; ++bj) *(u32x4*)(kv + (size_t)row * 4096 + col0 + bj * HALF) = pack8(acc[ai][bj][m][0] * sc, acc[ai][bj][m][1] * sc); }
    }
};
template <int PASS> struct EpiY {
    static constexpr bool PERM = true, AFTER_DRAIN = false;
    bf16_t* T; const bf16_t* gate;
    __device__ __forceinline__ void operator()(const f32x4 (&acc)[2][2][4][2], const Unit& u, int wr, int wc, int fr, int fq) const {
        const int row0 = u.pm * BM + wr * 64 + fr, col0 = u.pn * BM + wc * 32 + 8 * fq;
#pragma unroll
        for (int ai = 0; ai < 2; ++ai)
#pragma unroll
            for (int m = 0; m < 4; ++m) { const int row = row0 + ai * HALF + m * 16;
#pragma unroll
                for (int bj = 0; bj < 2; ++bj) { const u32x4 gw = *(const u32x4*)(gate + (size_t)row * LDP + col0 + bj * HALF); bf16_t* tp = T + (size_t)row * 4096 + col0 + bj * HALF;
                    f32x4 v0 = acc[ai][bj][m][0], v1 = acc[ai][bj][m][1];
                    v0 = v0 * (f32x4){bflo(gw.x), bfhi(gw.x), bflo(gw.y), bfhi(gw.y)}; v1 = v1 * (f32x4){bflo(gw.z), bfhi(gw.z), bflo(gw.w), bfhi(gw.w)};
                    if (PASS == 1) { const u32x4 tw = *(const u32x4*)tp; v0 = v0 + (f32x4){bflo(tw.x), bfhi(tw.x), bflo(tw.y), bfhi(tw.y)}; v1 = v1 + (f32x4){bflo(tw.z), bfhi(tw.z), bflo(tw.w), bfhi(tw.w)}; }
                    *(u32x4*)tp = pack8(v0, v1); } }
    }
};
struct EpiOut {
    static constexpr bool PERM = false, AFTER_DRAIN = false;
    const float* x; const float* stats; const float* g; const float* b; float* out;
    __device__ __forceinline__ void operator()(const f32x4 (&acc)[2][2][4][2], const Unit& u, int wr, int wc, int fr, int fq) const {
        const int row0 = u.pm * BM + wr * 64 + fr, col0 = u.pn * BM + wc * 32 + 4 * fq;
#pragma unroll
        for (int bj = 0; bj < 2; ++bj)
#pragma unroll
            for (int n = 0; n < 2; ++n) { const int col = col0 + bj * HALF + n * 16; const f32x4 gv = *(const f32x4*)(g + col) * ALPHA, bv = *(const f32x4*)(b + col) * ALPHA;
#pragma unroll
                for (int ai = 0; ai < 2; ++ai)
#pragma unroll
                    for (int m = 0; m < 4; ++m) { const int row = row0 + ai * HALF + m * 16; const f32x2 st = *(const f32x2*)(stats + 2 * row);
                        const size_t off = (size_t)row * 4096 + col; const f32x4 xv = *(const f32x4*)(x + off);
                        *(f32x4*)(out + off) = ((xv - st.x) * st.y) * gv + bv + acc[ai][bj][m][n]; } }
    }
};

template <class Epi, class Sched, bool ALIGN_EPI = false, bool SP2 = false, bool FP8 = false>
__device__ __forceinline__ void gemm_phase(PG8_LAS unsigned char* lds, const Gemm g, const Sched& S, const Epi& E) {
    const int tid = opaque_tid(), wid = __builtin_amdgcn_readfirstlane(tid >> 6), lane = tid & 63, wr = wid >> 2, wc = wid & 3, fr = lane & 15, fq = lane >> 4;
    const int K = g.K, nt = K / BK;
    unsigned voffA[2], voffB[2];
#pragma unroll
    for (int i = 0; i < 2; ++i) { int R, C; stage_rc(tid * 16 + i * 8192, R, C); const int Rb = Epi::PERM ? ((R & ~31) + perm32(R & 31)) : R;
        voffA[i] = (unsigned)(R * g.lda + C) * 2u; voffB[i] = (unsigned)(Rb * g.ldb + C) * 2u; }
    const size_t kstep = (size_t)(BK * 2);
    const size_t hstepA = (size_t)HALF * g.lda * 2, hstepB = (size_t)HALF * g.ldb * 2;
    const size_t tstepA = 2 * hstepA, tstepB = 2 * hstepB;
    const unsigned ldsw = (unsigned)wid * 1024u;
    const int aoff = lds_byte(wr * 64 + fr, fq * 8), boff = lds_byte(wc * 32 + fr, fq * 8);
#define PG8_SA(b, h) (((b) * 2 + (h)) * HTB)
#define PG8_SB(b, h) ((4 + (b) * 2 + (h)) * HTB)
#define PG8_STAGE(bufoff, gbase, voff) do { _Pragma("unroll") for (int _i = 0; _i < 2; ++_i) \
        __builtin_amdgcn_global_load_lds((const unsigned*)((const char*)(gbase) + (voff)[_i]), (PG8_LAS unsigned*)(lds + (bufoff) + ldsw + _i * 8192), 16, 0, 0); } while (0)
#define PG8_LDA(dst, b, h) do { if constexpr (FP8) { _Pragma("unroll") for (int m = 0; m < 4; ++m) dst##8[m] = cat8(*(const PG8_LAS bf16x8*)(lds + PG8_SA(b, h) + aoff + m * 2048), *(const PG8_LAS bf16x8*)(lds + PG8_SA(b, h) + aoff + m * 2048 + 1024)); } \
    else { _Pragma("unroll") for (int m = 0; m < 4; ++m) _Pragma("unroll") for (int k = 0; k < 2; ++k) dst[m][k] = *(const PG8_LAS bf16x8*)(lds + PG8_SA(b, h) + aoff + m * 2048 + k * 1024); } } while (0)
#define PG8_LDB(dst, b, h) do { if constexpr (FP8) { _Pragma("unroll") for (int n = 0; n < 2; ++n) dst##8[n] = cat8(*(const PG8_LAS bf16x8*)(lds + PG8_SB(b, h) + boff + n * 2048), *(const PG8_LAS bf16x8*)(lds + PG8_SB(b, h) + boff + n * 2048 + 1024)); } \
    else { _Pragma("unroll") for (int n = 0; n < 2; ++n) _Pragma("unroll") for (int k = 0; k < 2; ++k) dst[n][k] = *(const PG8_LAS bf16x8*)(lds + PG8_SB(b, h) + boff + n * 2048 + k * 1024); } } while (0)
#define PG8_MMA(ai, bj, At, Bt) do { __builtin_amdgcn_s_setprio(1); if constexpr (FP8) { _Pragma("unroll") for (int m = 0; m < 4; ++m) _Pragma("unroll") for (int n = 0; n < 2; ++n) \
        asm volatile("v_mfma_f32_16x16x128_f8f6f4 %0, %1, %2, %0" : "+v"(acc[ai][bj][m][n]) : "v"(Bt##8[n]), "v"(At##8[m])); } else { \
        _Pragma("unroll") for (int m = 0; m < 4; ++m) _Pragma("unroll") for (int n = 0; n < 2; ++n) _Pragma("unroll") for (int k = 0; k < 2; ++k) \
        acc[ai][bj][m][n] = __builtin_amdgcn_mfma_f32_16x16x32_bf16(Bt[n][k], At[m][k], acc[ai][bj][m][n], 0, 0, 0); } __builtin_amdgcn_s_setprio(0); } while (0)
#define PG8_WAIT_V(n) asm volatile("s_waitcnt vmcnt(" #n ")" ::: "memory")
#define PG8_WAIT_L(n) asm volatile("s_waitcnt lgkmcnt(" #n ")" ::: "memory")
#define PG8_BAR __builtin_amdgcn_s_barrier()
#define PG8_SCHED __builtin_amdgcn_sched_barrier(0)
    Unit cur, nxt; int ui = 0;
    if (!S.next(0, cur)) return;
    f32x4 acc[2][2][4][2];
#pragma unroll
    for (int a = 0; a < 2; ++a)
#pragma unroll
        for (int b = 0; b < 2; ++b)
#pragma unroll
            for (int m = 0; m < 4; ++m)
#pragma unroll
                for (int n = 0; n < 2; ++n) acc[a][b][m][n] = (f32x4){0.f, 0.f, 0.f, 0.f};
    bf16x8 At[4][2], B0[2][2], B1[2][2]; i32x8 At8[4], B08[2], B18[2];
    const char* cA = (const char*)g.A + (size_t)cur.pm * tstepA; const char* cB = (const char*)g.Bt + (size_t)cur.pn * tstepB;
    S.a_ready(cur);
    if constexpr (SP2) {
        PG8_STAGE(PG8_SB(0, 0), cB, voffB); PG8_STAGE(PG8_SB(0, 1), cB + hstepB, voffB); PG8_STAGE(PG8_SA(0, 0), cA, voffA); PG8_STAGE(PG8_SA(0, 1), cA + hstepA, voffA);
        if (wr == 1) PG8_BAR;
        PG8_WAIT_V(2); PG8_BAR;
        PG8_STAGE(PG8_SB(1, 0), cB + kstep, voffB); PG8_STAGE(PG8_SA(1, 0), cA + kstep, voffA); PG8_STAGE(PG8_SB(1, 1), cB + hstepB + kstep, voffB);
        PG8_WAIT_V(6); PG8_BAR;
    } else {
        PG8_STAGE(PG8_SB(0, 0), cB, voffB); PG8_STAGE(PG8_SA(0, 0), cA, voffA); PG8_STAGE(PG8_SB(0, 1), cB + hstepB, voffB); PG8_STAGE(PG8_SA(0, 1), cA + hstepA, voffA);
        if (wr == 1) PG8_BAR;
        PG8_WAIT_V(4); PG8_BAR;
        PG8_STAGE(PG8_SB(1, 0), cB + kstep, voffB); PG8_STAGE(PG8_SA(1, 0), cA + kstep, voffA); PG8_STAGE(PG8_SB(1, 1), cB + hstepB + kstep, voffB);
        PG8_WAIT_V(6); PG8_BAR;
    }
    for (;;) {
        const bool has_next = S.next(ui + 1, nxt);
        const char* nA = has_next ? (const char*)g.A + (size_t)nxt.pm * tstepA : cA; const char* nB = has_next ? (const char*)g.Bt + (size_t)nxt.pn * tstepB : cB;
        for (int t = 0; t < nt; t += 2) {
            const bool last = (t == nt - 2);
            const char* a1 = cA + (size_t)(t + 1) * kstep;
            const char* a2 = last ? nA : cA + (size_t)(t + 2) * kstep; const char* b2 = last ? nB : cB + (size_t)(t + 2) * kstep;
            const char* a3 = a2 + kstep; const char* b3 = b2 + kstep;
            if (last && has_next) S.a_ready(nxt);
            if constexpr (SP2) {
            PG8_LDB(B0, 0, 0); PG8_LDB(B1, 0, 1); PG8_SCHED; PG8_LDA(At, 0, 0); PG8_STAGE(PG8_SA(1, 1), a1 + hstepA, voffA);
            PG8_WAIT_V(8); PG8_WAIT_L(0); PG8_BAR; PG8_MMA(0, 0, At, B0); PG8_MMA(0, 1, At, B1); PG8_BAR; PG8_SCHED;
            PG8_LDA(At, 0, 1); PG8_STAGE(PG8_SB(0, 0), b2, voffB); PG8_STAGE(PG8_SB(0, 1), b2 + hstepB, voffB); PG8_STAGE(PG8_SA(0, 0), a2, voffA);
            PG8_WAIT_V(8); PG8_WAIT_L(0); PG8_BAR; PG8_MMA(1, 0, At, B0); PG8_MMA(1, 1, At, B1); PG8_BAR; PG8_SCHED;
            PG8_LDB(B0, 1, 0); PG8_LDB(B1, 1, 1); PG8_SCHED; PG8_LDA(At, 1, 0); PG8_STAGE(PG8_SA(0, 1), a2 + hstepA, voffA);
            PG8_WAIT_V(8); PG8_WAIT_L(0); PG8_BAR; PG8_MMA(0, 0, At, B0); PG8_MMA(0, 1, At, B1); PG8_BAR; PG8_SCHED;
            PG8_LDA(At, 1, 1); PG8_STAGE(PG8_SB(1, 0), b3, voffB); PG8_STAGE(PG8_SB(1, 1), b3 + hstepB, voffB); PG8_STAGE(PG8_SA(1, 0), a3, voffA);
            PG8_WAIT_V(8); PG8_WAIT_L(0); PG8_BAR; PG8_MMA(1, 0, At, B0); PG8_MMA(1, 1, At, B1); PG8_BAR; PG8_SCHED;
            } else {
            PG8_LDB(B0, 0, 0); PG8_SCHED; PG8_LDA(At, 0, 0); PG8_STAGE(PG8_SA(1, 1), a1 + hstepA, voffA);
            PG8_WAIT_L(8); PG8_BAR; PG8_WAIT_L(0); PG8_MMA(0, 0, At, B0); PG8_BAR; PG8_SCHED;
            PG8_LDB(B1, 0, 1); PG8_STAGE(PG8_SB(0, 0), b2, voffB);
            PG8_BAR; PG8_WAIT_L(0); PG8_MMA(0, 1, At, B1); PG8_BAR;
            PG8_LDA(At, 0, 1); PG8_STAGE(PG8_SA(0, 0), a2, voffA);
            PG8_BAR; PG8_WAIT_L(0); PG8_MMA(1, 0, At, B0); PG8_BAR; PG8_SCHED;
            PG8_STAGE(PG8_SB(0, 1), b2 + hstepB, voffB);
            PG8_WAIT_V(6); PG8_BAR; PG8_MMA(1, 1, At, B1); PG8_BAR;
            PG8_LDB(B0, 1, 0); PG8_SCHED; PG8_LDA(At, 1, 0); PG8_STAGE(PG8_SA(0, 1), a2 + hstepA, voffA);
            PG8_WAIT_L(8); PG8_BAR; PG8_WAIT_L(0); PG8_MMA(0, 0, At, B0); PG8_BAR; PG8_SCHED;
            PG8_LDB(B1, 1, 1); PG8_STAGE(PG8_SB(1, 0), b3, voffB);
            PG8_BAR; PG8_WAIT_L(0); PG8_MMA(0, 1, At, B1); PG8_BAR;
            PG8_LDA(At, 1, 1); PG8_STAGE(PG8_SA(1, 0), a3, voffA);
            PG8_BAR; PG8_WAIT_L(0); PG8_MMA(1, 0, At, B0); PG8_BAR; PG8_SCHED;
            PG8_STAGE(PG8_SB(1, 1), b3 + hstepB, voffB);
            PG8_WAIT_V(6); PG8_BAR; PG8_MMA(1, 1, At, B1); PG8_BAR;
            }
        }
        if constexpr (ALIGN_EPI) { if (wr == 0) PG8_BAR; }
        if constexpr (FP8) asm volatile("s_nop 15\n\ts_nop 15" ::: "memory");
        if constexpr (!Epi::AFTER_DRAIN) { E(acc, cur, wr, wc, fr, fq); S.done(cur); }
        if (!has_next) break;
#pragma unroll
        for (int a = 0; a < 2; ++a)
#pragma unroll
            for (int b = 0; b < 2; ++b)
#pragma unroll
                for (int m = 0; m < 4; ++m)
#pragma unroll
                    for (int n = 0; n < 2; ++n) acc[a][b][m][n] = (f32x4){0.f, 0.f, 0.f, 0.f};
        cur = nxt; cA = nA; cB = nB; ++ui;
        if constexpr (ALIGN_EPI) { if (wr == 1) PG8_BAR; }
    }
    PG8_WAIT_V(0);
    if constexpr (!ALIGN_EPI) { if (wr == 0) PG8_BAR; }
    PG8_BAR;
    if constexpr (Epi::AFTER_DRAIN) { E.fused(acc, cur, wr, wc, fr, fq, lds, wid, lane); S.done(cur); }
#undef PG8_SA
#undef PG8_SB
#undef PG8_STAGE
#undef PG8_LDA
#undef PG8_LDB
#undef PG8_MMA
#undef PG8_WAIT_V
#undef PG8_WAIT_L
#undef PG8_BAR
#undef PG8_SCHED
}
}

namespace att {
typedef unsigned short bf16_t;
using bf16x8 = __attribute__((ext_vector_type(8))) short;
using s16x4  = __attribute__((ext_vector_type(4))) short;
using f32x16 = __attribute__((ext_vector_type(16))) float;
using u32x4  = __attribute__((ext_vector_type(4))) unsigned;
constexpr int NW = 8, QBLK = 32, KVBLK = 64;
constexpr int SHM_V = 16384, SHM_KN = 16384, SHM_KP = 8192;
constexpr int OFF_V = 0, OFF_KN = 2 * SHM_V, OFF_KP = OFF_KN + 2 * SHM_KN, OFF_WS = OFF_KP + 2 * SHM_KP, OFF_BIAS = OFF_WS + NW * 64 * 4, OFF_QPE = OFF_BIAS + 1024, ATT_LDS = OFF_QPE + NW * 4096, M_QPE = 3 * 40960 + 2048;
#define KSWZ(row, colB) ((row) * 256 + ((colB) ^ (((row) & 15) << 4)))
#define KPSWZ(row, colB) ((row) * 128 + ((colB) ^ ((((row) >> 1) & 7) << 4)))
#define SBAR() __builtin_amdgcn_sched_barrier(0)
__device__ __forceinline__ int crow(int r, int hi) { return (r & 3) + 8 * (r >> 2) + 4 * hi; }
typedef float f32x2_t __attribute__((ext_vector_type(2))); typedef __bf16 bf16x2_t __attribute__((ext_vector_type(2)));
__device__ __forceinline__ unsigned cvtpk(float lo, float hi) { f32x2_t v = {lo, hi}; bf16x2_t b = __builtin_convertvector(v, bf16x2_t); return __builtin_bit_cast(unsigned, b); }
__device__ __forceinline__ bf16x8 ld8(const bf16_t* p) { return *reinterpret_cast<const bf16x8*>(p); }

template <int THR2>
__device__ __forceinline__ void partialSM(f32x16& p0, f32x16& p1, float& m_reg, float& alpha) {
  float pmax = p0[0];
#pragma unroll
  for (int r = 1; r < 16; ++r) pmax = fmaxf(pmax, p0[r]);
#pragma unroll
  for (int r = 0; r < 16; ++r) pmax = fmaxf(pmax, p1[r]);
  { auto rr = __builtin_amdgcn_permlane32_swap(__float_as_uint(pmax), __float_as_uint(pmax), false, false);
    pmax = fmaxf(__uint_as_float(rr[0]), __uint_as_float(rr[1])); }
  float mn;
  if (THR2 > 0 && __builtin_expect(__all(pmax - m_reg <= (float)THR2), 1)) { mn = m_reg; alpha = 1.f; }
  else { mn = fmaxf(m_reg, pmax); alpha = __builtin_amdgcn_exp2f(m_reg - mn); m_reg = mn; }
#pragma unroll
  for (int r = 0; r < 16; ++r) p0[r] = p0[r] - mn;
#pragma unroll
  for (int r = 0; r < 16; ++r) p1[r] = p1[r] - mn;
#pragma unroll
  for (int r = 0; r < 16; ++r) p0[r] = __builtin_amdgcn_exp2f(p0[r]);
}
__device__ __forceinline__ void finishSM(f32x16& p0, f32x16& p1, float alpha, float& l_reg, bf16x8& pa0, bf16x8& pa1, bf16x8& pa2, bf16x8& pa3) {
#pragma unroll
  for (int r = 0; r < 16; ++r) p1[r] = __builtin_amdgcn_exp2f(p1[r]);
  float ps = 0;
#pragma unroll
  for (int r = 0; r < 16; ++r) ps += p0[r];
#pragma unroll
  for (int r = 0; r < 16; ++r) ps += p1[r];
  { auto rr = __builtin_amdgcn_permlane32_swap(__float_as_uint(ps), __float_as_uint(ps), false, false);
    ps = __uint_as_float(rr[0]) + __uint_as_float(rr[1]); }
  l_reg = l_reg * alpha + ps;
#define PK4(P, BASE, OUT) do { unsigned a0 = cvtpk(P[BASE + 0], P[BASE + 1]), a1 = cvtpk(P[BASE + 2], P[BASE + 3]);   \
    unsigned b0 = cvtpk(P[BASE + 4], P[BASE + 5]), b1 = cvtpk(P[BASE + 6], P[BASE + 7]);                              \
    auto r0 = __builtin_amdgcn_permlane32_swap(a0, b0, false, false); auto r1 = __builtin_amdgcn_permlane32_swap(a1, b1, false, false); \
    u32x4 w = {r0[0], r1[0], r0[1], r1[1]}; OUT = *reinterpret_cast<bf16x8*>(&w); } while (0)
  PK4(p0, 0, pa0); PK4(p0, 8, pa1); PK4(p1, 0, pa2); PK4(p1, 8, pa3);
#undef PK4
}
template <int NPE>
__device__ __forceinline__ void qkt(f32x16& p0, f32x16& p1, const char* Kn, const char* Kp, const bf16x8* qr, const char* qpe, int r32, int hi) {
  p0 = f32x16{}; p1 = f32x16{};
#pragma unroll
  for (int d0 = 0; d0 < 8; ++d0) { const int cb = (d0 * 16 + hi * 8) * 2;
    bf16x8 b0 = *reinterpret_cast<const bf16x8*>(Kn + KSWZ(r32, cb));
    bf16x8 b1 = *reinterpret_cast<const bf16x8*>(Kn + KSWZ(32 + r32, cb));
    p0 = __builtin_amdgcn_mfma_f32_32x32x16_bf16(b0, qr[d0], p0, 0, 0, 0);
    p1 = __builtin_amdgcn_mfma_f32_32x32x16_bf16(b1, qr[d0], p1, 0, 0, 0); }
#pragma unroll
  for (int d0 = 0; d0 < NPE; ++d0) { const int cb = (d0 * 16 + hi * 8) * 2;
    bf16x8 b0 = *reinterpret_cast<const bf16x8*>(Kp + KPSWZ(r32, cb));
    bf16x8 b1 = *reinterpret_cast<const bf16x8*>(Kp + KPSWZ(32 + r32, cb));
    p0 = __builtin_amdgcn_mfma_f32_32x32x16_bf16(b0, qr[8 + d0], p0, 0, 0, 0);
    p1 = __builtin_amdgcn_mfma_f32_32x32x16_bf16(b1, qr[8 + d0], p1, 0, 0, 0); }
}
__device__ __forceinline__ int v_st(int k, int c) { const int kk = (k & ~0xC) | ((k & 4) << 1) | ((k & 8) >> 1); return ((kk >> 3) * 4 + (c >> 5)) * 512 + ((kk & 7) * 32 + (c & 31)) * 2; }
__device__ __forceinline__ int v_rd_base(int lane) { return ((lane & 3) << 3) | (((lane >> 2) & 3) << 6) | (((lane >> 4) & 1) << 5) | (((lane >> 5) & 1) << 8); }
constexpr int v_rd_off(int d0, int ks, int half) { return d0 * 512 + ks * 4096 + half * 2048; }
template <int OFF> __device__ __forceinline__ s16x4 tr_read(int vb) {
  s16x4 r; asm volatile("ds_read_b64_tr_b16 %0, %1 offset:%2" : "=&v"(r) : "v"(vb), "i"(OFF) : "memory"); return r;
}
template <int D0> __device__ __forceinline__ void pv_one(f32x16& od, int vb, bf16x8 pa0, bf16x8 pa1, bf16x8 pa2, bf16x8 pa3) {
  const s16x4 l0 = tr_read<v_rd_off(D0, 0, 0)>(vb), h0 = tr_read<v_rd_off(D0, 0, 1)>(vb), l1 = tr_read<v_rd_off(D0, 1, 0)>(vb), h1 = tr_read<v_rd_off(D0, 1, 1)>(vb);
  const s16x4 l2 = tr_read<v_rd_off(D0, 2, 0)>(vb), h2 = tr_read<v_rd_off(D0, 2, 1)>(vb), l3 = tr_read<v_rd_off(D0, 3, 0)>(vb), h3 = tr_read<v_rd_off(D0, 3, 1)>(vb);
  asm volatile("s_waitcnt lgkmcnt(0)" ::: "memory"); SBAR();
#define PK(L, H) (bf16x8){L[0], L[1], L[2], L[3], H[0], H[1], H[2], H[3]}
  od = __builtin_amdgcn_mfma_f32_32x32x16_bf16(pa0, PK(l0, h0), od, 0, 0, 0);
  od = __builtin_amdgcn_mfma_f32_32x32x16_bf16(pa1, PK(l1, h1), od, 0, 0, 0);
  od = __builtin_amdgcn_mfma_f32_32x32x16_bf16(pa2, PK(l2, h2), od, 0, 0, 0);
  od = __builtin_amdgcn_mfma_f32_32x32x16_bf16(pa3, PK(l3, h3), od, 0, 0, 0);
#undef PK
}
__device__ __forceinline__ void pv_d0(f32x16* o, int vb, bf16x8 pa0, bf16x8 pa1, bf16x8 pa2, bf16x8 pa3) {
  pv_one<0>(o[0], vb, pa0, pa1, pa2, pa3); pv_one<1>(o[1], vb, pa0, pa1, pa2, pa3); pv_one<2>(o[2], vb, pa0, pa1, pa2, pa3); pv_one<3>(o[3], vb, pa0, pa1, pa2, pa3);
}
#define RESC(a) do { if (__any((a) < 1.f)) { if (hi == 0) al_l[r32] = (a); asm volatile("s_waitcnt lgkmcnt(0)" ::: "memory"); \
    _Pragma("unroll") for (int d = 0; d < 4; ++d) _Pragma("unroll") for (int r = 0; r < 16; ++r) o[d][r] *= al_l[crow(r, hi)]; } } while (0)

#define LAS3 __attribute__((address_space(3)))
__device__ __forceinline__ void mla_unit(const bf16_t* __restrict__ Qb, const bf16_t* __restrict__ Kh, const bf16_t* __restrict__ Vh, const bf16_t* __restrict__ Kpe,
                                         const bf16_t* __restrict__ Gb, bf16_t* __restrict__ Ob, char* lds, LAS3 unsigned char* ldsl) {
  constexpr int LDQ = 3072, LDK = 4096, LDO = 2048, NT = SEQ / KVBLK;
  constexpr int STG = 40960, O_V = 0, O_KN = 16384, O_KP = 32768, M_WS = 3 * STG;
  const int tid = opaque_tid(), wid = __builtin_amdgcn_readfirstlane(tid >> 6), lane = tid & 63, r32 = lane & 31, hi = lane >> 5;
  float* ws = (float*)(lds + M_WS) + wid * 64; float* li_l = ws; float* al_l = ws + 32;
  float m_reg = -1e30f, l_reg = 0; f32x16 o[4] = {}; bf16x8 qr[12];
  const bf16_t* Qw = Qb + (long)(wid * QBLK + r32) * LDQ + hi * 8;
#pragma unroll
  for (int d0 = 0; d0 < 12; ++d0) qr[d0] = ld8(Qw + d0 * 16);
  char* qpe = lds + M_QPE + wid * 4096 + lane * 16;
  (void)qpe;
  asm volatile("s_waitcnt vmcnt(0)" ::: "memory"); SBAR();
  int vsrc[2], ksrc[2], psrc;
#pragma unroll
  for (int i = 0; i < 2; ++i) { const int c = wid + 8 * i;
    { const int sub = c * 2 + (lane >> 5), kk = (sub >> 2) * 8 + ((lane & 31) >> 2), k = (kk & ~0xC) | ((kk & 4) << 1) | ((kk & 8) >> 1); vsrc[i] = k * LDK + (sub & 3) * 32 + (lane & 3) * 8; }
    { const int row = c * 4 + (lane >> 4), colB = ((lane & 15) * 16) ^ ((row & 15) << 4); ksrc[i] = row * LDK + (colB >> 1); } }
  { const int row = wid * 8 + (lane >> 3), colB = ((lane & 7) * 16) ^ (((row >> 1) & 7) << 4); psrc = row * 64 + (colB >> 1); }
#define DMA16(gptr, ldsoff) __builtin_amdgcn_global_load_lds((const unsigned*)(gptr), (LAS3 unsigned*)(ldsl + (ldsoff)), 16, 0, 0)
#define ISSUE_K(t, s) do { const bf16_t* kb_ = Kh + (long)(t) * (KVBLK * LDK); DMA16(kb_ + ksrc[0], (s) * STG + O_KN + wid * 1024); DMA16(kb_ + ksrc[1], (s) * STG + O_KN + (wid + 8) * 1024); \
    DMA16(Kpe + (long)(t) * (KVBLK * 64) + psrc, (s) * STG + O_KP + wid * 1024); } while (0)
#define ISSUE_V(t, s) do { const bf16_t* vb_ = Vh + (long)(t) * (KVBLK * LDK); DMA16(vb_ + vsrc[0], (s) * STG + O_V + wid * 1024); DMA16(vb_ + vsrc[1], (s) * STG + O_V + (wid + 8) * 1024); } while (0)
#define WAITBAR(N) do { asm volatile("s_waitcnt vmcnt(" #N ") lgkmcnt(0)" ::: "memory"); __builtin_amdgcn_s_barrier(); asm volatile("" ::: "memory"); } while (0)
  const int vb0 = (int)(uintptr_t)lds + O_V + v_rd_base(lane);
  f32x16 pA0, pA1, pB0, pB1; float alA, alB; bf16x8 pa0, pa1, pa2, pa3;
  int s0 = 0, s1 = 1, s2 = 2;
#define ROT() do { const int t_ = s0; s0 = s1; s1 = s2; s2 = t_; } while (0)
  ISSUE_K(0, 0); ISSUE_V(0, 0); ISSUE_K(1, 1);
  WAITBAR(3);
  ISSUE_K(2, s2); ISSUE_V(1, s1);
  qkt<4>(pA0, pA1, lds + s0 * STG + O_KN, lds + s0 * STG + O_KP, qr, qpe, r32, hi); partialSM<11>(pA0, pA1, m_reg, alA);
  WAITBAR(5); ROT();
#define STEP(PX0, PX1, ALX, PY0, PY1, ALY, j_) do { const bool ik_ = (j_) + 2 < NT, iv_ = (j_) + 1 < NT; \
    if (ik_) ISSUE_K((j_) + 2, s2); if (iv_) ISSUE_V((j_) + 1, s1); \
    SBAR(); qkt<4>(PX0, PX1, lds + s0 * STG + O_KN, lds + s0 * STG + O_KP, qr, qpe, r32, hi); \
    finishSM(PY0, PY1, ALY, l_reg, pa0, pa1, pa2, pa3); SBAR(); \
    pv_d0(o, vb0 + s2 * STG, pa0, pa1, pa2, pa3); partialSM<11>(PX0, PX1, m_reg, ALX); \
    RESC(ALX); \
    if (ik_) WAITBAR(5); else WAITBAR(0); ROT(); } while (0)
  for (int j = 1; j + 1 < NT; j += 2) {
    STEP(pB0, pB1, alB, pA0, pA1, alA, j);
    STEP(pA0, pA1, alA, pB0, pB1, alB, j + 1);
  }
  STEP(pB0, pB1, alB, pA0, pA1, alA, NT - 1);
  finishSM(pB0, pB1, alB, l_reg, pa0, pa1, pa2, pa3); SBAR();
  pv_d0(o, vb0 + s2 * STG, pa0, pa1, pa2, pa3);
  if (hi == 0) li_l[r32] = l_reg; asm volatile("s_waitcnt lgkmcnt(0)" ::: "memory");
  float rli[16];
#pragma unroll
  for (int r = 0; r < 16; ++r) rli[r] = __builtin_amdgcn_rcpf(li_l[crow(r, hi)]);
  __syncthreads();
  bf16_t* Ow = Ob + (long)(wid * QBLK) * LDO; const bf16_t* Gw = Gb + (long)(wid * QBLK) * LDP;
  { bf16_t* stg = (bf16_t*)(lds + wid * 8704);
#pragma unroll
    for (int r = 0; r < 16; ++r) { const int orow = crow(r, hi);
#pragma unroll
      for (int d0 = 0; d0 < 4; ++d0) { const float ov = o[d0][r] * rli[r]; stg[orow * 136 + d0 * 32 + r32] = (bf16_t)(cvtpk(ov, ov) & 0xffffu); } }
    asm volatile("s_waitcnt lgkmcnt(0)" ::: "memory");
    int lz = lane; asm volatile("" : "+v"(lz));
#pragma unroll
    for (int i = 0; i < 8; ++i) { const int id = i * 64 + lz, row = id >> 4, c = (id & 15) * 8;
      const u32x4 ov = *(const u32x4*)(stg + row * 136 + c); const u32x4 gv = *(const u32x4*)(Gw + (long)row * LDP + c); u32x4 w;
#pragma unroll
      for (int k = 0; k < 4; ++k) w[k] = cvtpk(__uint_as_float(ov[k] << 16) * __uint_as_float(gv[k] << 16), __uint_as_float(ov[k] & 0xffff0000u) * __uint_as_float(gv[k] & 0xffff0000u));
      *(u32x4*)(Ow + (long)row * LDO + c) = w; } }
  __syncthreads();
#undef DMA16
#undef ISSUE_K
#undef ISSUE_V
#undef WAITBAR
#undef ROT
#undef STEP
}

__device__ __forceinline__ void dswa_unit(int H, int rs, int qb, const bf16_t* __restrict__ proj, const float* __restrict__ bias2, bf16_t* __restrict__ Od, float* __restrict__ lse, char* lds) {
  const int g = H >> 3, dil = 1 << (2 * g), L = SEQ / dil, Q0 = qb * 256, T0 = Q0 - 64;
  const int tid = opaque_tid(), wid = tid >> 6, lane = tid & 63, r32 = lane & 31, hi = lane >> 5;
  char* V_lds = lds + OFF_V; char* Kn_lds = lds + OFF_KN;
  float* ws = (float*)(lds + OFF_WS) + wid * 64; float* li_l = ws; float* al_l = ws + 32;
  float* bl = (float*)(lds + OFF_BIAS);
  const bf16_t* Qp = proj + C_DQ + H * 128; const bf16_t* Kp = proj + C_DK + H * 128; const bf16_t* Vp = proj + C_DV + H * 128;
  if (tid < 129) bl[tid] = bias2[(g * 8 + (H & 7)) * 129 + tid];
  const int qa = Q0 + wid * QBLK, qi = qa + r32;
  bf16x8 qr[8];
  { const bf16_t* Qw = Qp + (size_t)(qi * dil + rs) * LDP + hi * 8;
#pragma unroll
    for (int d0 = 0; d0 < 8; ++d0) qr[d0] = ld8(Qw + d0 * 16); }
  const int sr = tid >> 4, sc = (tid & 15) * 8, vst0 = v_st(sr, sc), vst1 = v_st(32 + sr, sc);
  const int vb0 = (int)(uintptr_t)V_lds + v_rd_base(lane);
  float m_reg = -1e29f, l_reg = 0.f; f32x16 o[4] = {};
  const int tlo = (Q0 == 0) ? 1 : 0, thi = (Q0 + 256 >= L) ? 5 : 6;
  bf16x8 vs0, vs1, ks0, ks1;
#define DLOAD(t_) do { const int k0_ = T0 + 64 * (t_); int i0 = k0_ + sr, i1 = k0_ + 32 + sr; i0 = i0 < 0 ? 0 : (i0 >= L ? L - 1 : i0); i1 = i1 < 0 ? 0 : (i1 >= L ? L - 1 : i1); \
    const size_t o0 = (size_t)(i0 * dil + rs) * LDP + sc, o1 = (size_t)(i1 * dil + rs) * LDP + sc; vs0 = ld8(Vp + o0); vs1 = ld8(Vp + o1); ks0 = ld8(Kp + o0); ks1 = ld8(Kp + o1); } while (0)
  DLOAD(tlo);
  for (int t = tlo; t < thi; ++t) {
    const int k0 = T0 + 64 * t;
    __syncthreads();
    *(bf16x8*)(V_lds + vst0) = vs0; *(bf16x8*)(V_lds + vst1) = vs1;
    *(bf16x8*)(Kn_lds + KSWZ(sr, sc * 2)) = ks0; *(bf16x8*)(Kn_lds + KSWZ(32 + sr, sc * 2)) = ks1;
    __syncthreads();
    if (t + 1 < thi) DLOAD(t + 1);
    if (k0 > qa + 31 + 64 || k0 + 63 < qa - 64) continue;
    f32x16 p0, p1; qkt<0>(p0, p1, Kn_lds, Kn_lds, qr, Kn_lds, r32, hi);
#pragma unroll
    for (int r = 0; r < 16; ++r) { const int kj = k0 + crow(r, hi), dj = kj - qi; int bi = dj + 64; bi = bi < 0 ? 0 : (bi > 128 ? 128 : bi);
      const int kj1 = kj + 32, dj1 = dj + 32; int bi1 = dj1 + 64; bi1 = bi1 < 0 ? 0 : (bi1 > 128 ? 128 : bi1);
      const bool ok0 = (dj >= -64) && (dj <= 64) && (kj >= 0) && (kj < L), ok1 = (dj1 >= -64) && (dj1 <= 64) && (kj1 >= 0) && (kj1 < L);
      p0[r] = ok0 ? p0[r] + bl[bi] : -1e30f; p1[r] = ok1 ? p1[r] + bl[bi1] : -1e30f; }
    float al; partialSM<0>(p0, p1, m_reg, al);
    bf16x8 pa0, pa1, pa2, pa3; finishSM(p0, p1, al, l_reg, pa0, pa1, pa2, pa3);
    RESC(al);
    SBAR(); pv_d0(o, vb0, pa0, pa1, pa2, pa3);
  }
#undef DLOAD
  if (hi == 0) li_l[r32] = l_reg; asm volatile("s_waitcnt lgkmcnt(0)" ::: "memory");
  float rli[16];
#pragma unroll
  for (int r = 0; r < 16; ++r) rli[r] = __builtin_amdgcn_rcpf(li_l[crow(r, hi)]);
  const int hh = H & 7;
  bf16_t* Og = Od + (size_t)g * SEQ * 1024 + hh * 128;
#pragma unroll
  for (int r = 0; r < 16; ++r) { const size_t pos = (size_t)(qa + crow(r, hi)) * dil + rs;
#pragma unroll
    for (int d0 = 0; d0 < 4; ++d0) { const float ov = o[d0][r] * rli[r]; Og[pos * 1024 + d0 * 32 + r32] = (bf16_t)(cvtpk(ov, ov) & 0xffffu); } }
  if (hi == 0) lse[((size_t)g * SEQ + (size_t)qi * dil + rs) * 8 + hh] = m_reg + __builtin_amdgcn_logf(l_reg);
  __syncthreads();
}
#undef RESC
#undef KSWZ
#undef KPSWZ
#undef SBAR
}

#define LAS __attribute__((address_space(3)))
typedef unsigned short bf16;
typedef unsigned v4u __attribute__((ext_vector_type(4)));
typedef float f32x4 __attribute__((ext_vector_type(4)));
constexpr int NWAVES = 8;
constexpr size_t MiB = 1u << 20;
constexpr size_t WS_RSSQ = 0, WS_RSSKV = 32768, WS_STATS = 65536, WS_BIAS2 = 131072, WS_LSE = 262144;
constexpr size_t WS_ROPE = 2 * MiB;
constexpr size_t WS_WIN = 4 * MiB, WS_WQB = 178 * MiB, WS_WKVB = 184 * MiB, WS_WOMLA = 188 * MiB, WS_WODSWA = 204 * MiB, WS_WOUT = 212 * MiB;
constexpr size_t WS_H = 244 * MiB, WS_PROJ = 308 * MiB, WS_QMLA = 656 * MiB, WS_KVMLA = 704 * MiB, WS_KPE = 768 * MiB, WS_AMLA = 770 * MiB;
constexpr size_t WS_ODSWA = 802 * MiB, WS_BDSWA = 850 * MiB, WS_T = 866 * MiB, WS_END = 930 * MiB;
static_assert(WS_WIN + (size_t)LDP * 4096 * 2 <= WS_WQB && WS_PROJ + (size_t)SEQ * LDP * 2 <= WS_QMLA && WS_LSE + 3 * SEQ * 8 * 4 <= WS_ROPE, "d_ws map");
constexpr int LDS_BYTES = 163840;

__device__ __forceinline__ unsigned f2bf(float f) { unsigned u = __builtin_bit_cast(unsigned, f); return (u + 0x7fffu + ((u >> 16) & 1u)) >> 16; }
__device__ __forceinline__ unsigned pk2(float lo, float hi) { return f2bf(lo) | (f2bf(hi) << 16); }
__device__ __forceinline__ float wave_sum(float v) {
#pragma unroll
    for (int o = 1; o < 64; o <<= 1) v += __shfl_xor(v, o);
    return v;
}
__device__ __forceinline__ void transpose_item(const float* __restrict__ W, int K, int N, bf16* __restrict__ WT, int k0, int n0, int dbase, int dstride, const float* __restrict__ kscale, LAS float* scr, int lane) {
    float wv[32];
#pragma unroll
    for (int i = 0; i < 32; ++i) { const int kk = 2 * i + (lane >> 5); wv[i] = __builtin_nontemporal_load(W + (size_t)(k0 + kk) * N + n0 + (lane & 31)); }
#pragma unroll
    for (int i = 0; i < 32; ++i) { const int kk = 2 * i + (lane >> 5); float w = wv[i]; if (kscale) w *= kscale[k0 + kk]; scr[kk * 33 + (lane & 31)] = w; }
    asm volatile("s_waitcnt lgkmcnt(0)" ::: "memory");
    const int c = lane & 7;
#pragma unroll
    for (int j = 0; j < 4; ++j) { const int n = (lane >> 3) + 8 * j; const LAS float* s = scr + (8 * c) * 33 + n;
        v4u o; o.x = pk2(s[0 * 33], s[1 * 33]); o.y = pk2(s[2 * 33], s[3 * 33]); o.z = pk2(s[4 * 33], s[5 * 33]); o.w = pk2(s[6 * 33], s[7 * 33]);
        *(v4u*)(WT + (size_t)(dbase + dstride * n) * K + k0 + 8 * c) = o; }
    asm volatile("s_waitcnt lgkmcnt(0)" ::: "memory");
}

#define REP0 1
#define REP1 1
#define REP2 1
#define REP3 1
#define REP4 1
#define REP5 1
constexpr float H_SC = 16.f, W_SC = 1024.f;
__device__ __forceinline__ void transpose_item8(const float* __restrict__ W, int K, int N, unsigned char* __restrict__ WT, int k0, int n0, int dbase, int dstride, LAS float* scr, int lane) {
    float wv[32];
#pragma unroll
    for (int i = 0; i < 32; ++i) { const int kk = 2 * i + (lane >> 5); wv[i] = __builtin_nontemporal_load(W + (size_t)(k0 + kk) * N + n0 + (lane & 31)); }
#pragma unroll
    for (int i = 0; i < 32; ++i) { const int kk = 2 * i + (lane >> 5); scr[kk * 33 + (lane & 31)] = wv[i] * W_SC; }
    asm volatile("s_waitcnt lgkmcnt(0)" ::: "memory");
    const int c = lane & 7;
#pragma unroll
    for (int j = 0; j < 4; ++j) { const int n = (lane >> 3) + 8 * j; const LAS float* s = scr + (8 * c) * 33 + n;
        int d0 = __builtin_amdgcn_cvt_pk_fp8_f32(s[0 * 33], s[1 * 33], 0, false); d0 = __builtin_amdgcn_cvt_pk_fp8_f32(s[2 * 33], s[3 * 33], d0, true);
        int d1 = __builtin_amdgcn_cvt_pk_fp8_f32(s[4 * 33], s[5 * 33], 0, false); d1 = __builtin_amdgcn_cvt_pk_fp8_f32(s[6 * 33], s[7 * 33], d1, true);
        typedef int i32x2 __attribute__((ext_vector_type(2)));
        *(i32x2*)(WT + (size_t)(dbase + dstride * n) * K + k0 + 8 * c) = (i32x2){d0, d1}; }
    asm volatile("s_waitcnt lgkmcnt(0)" ::: "memory");
}
struct Args { const float* in[14]; float* out; unsigned char* ws; };

__global__ void __launch_bounds__(NWAVES * 64, 2) fwd_mega(Args a) {
    extern __shared__ __attribute__((aligned(16))) unsigned char lds[];
    cg::grid_group grid = cg::this_grid();
    const int G = gridDim.x, bx = blockIdx.x, vcu = (G % 8 == 0) ? (bx % 8) * (G / 8) + bx / 8 : bx;
    LAS unsigned char* ldsl = (LAS unsigned char*)lds;
    unsigned char* ws = a.ws;
    const float* x = a.in[0]; const float* emb_g = a.in[1]; const float* emb_b = a.in[2]; const float* rel_bias = a.in[3]; const float* w_in = a.in[4];
    const float* qa_g = a.in[5]; const float* w_qb = a.in[6]; const float* kva_g = a.in[7]; const float* w_kvb = a.in[8]; const float* w_omla = a.in[9];
    const float* w_odswa = a.in[10]; const float* w_out = a.in[11]; const float* ln_g = a.in[12]; const float* ln_b = a.in[13];
    float* rss_q = (float*)(ws + WS_RSSQ); float* rss_kv = (float*)(ws + WS_RSSKV); float* stats = (float*)(ws + WS_STATS); float* bias2 = (float*)(ws + WS_BIAS2);
    float* lse = (float*)(ws + WS_LSE); float* rope = (float*)(ws + WS_ROPE);
    bf16* Win_t = (bf16*)(ws + WS_WIN); bf16* Wqb_t = (bf16*)(ws + WS_WQB); bf16* Wkvb_t = (bf16*)(ws + WS_WKVB); bf16* Womla_t = (bf16*)(ws + WS_WOMLA);
    bf16* Wodswa_t = (bf16*)(ws + WS_WODSWA); bf16* Wout_t = (bf16*)(ws + WS_WOUT);
    bf16* Hb = (bf16*)(ws + WS_H); bf16* proj = (bf16*)(ws + WS_PROJ); bf16* Qmla = (bf16*)(ws + WS_QMLA); bf16* KVmla = (bf16*)(ws + WS_KVMLA); bf16* Kpe = (bf16*)(ws + WS_KPE);
    bf16* Amla = (bf16*)(ws + WS_AMLA); bf16* Odswa = (bf16*)(ws + WS_ODSWA); bf16* Bdswa = (bf16*)(ws + WS_BDSWA); bf16* Tm = (bf16*)(ws + WS_T);
    const int NGW = G * NWAVES, NGT = G * NWAVES * 64;
#define PHASE_IDS() const int tid = opaque_tid(), lane = tid & 63, wave = __builtin_amdgcn_readfirstlane(tid >> 6), gw = vcu * NWAVES + wave, gt = bx * (NWAVES * 64) + tid; (void)lane; (void)gw; (void)gt

    for (int rep = 0; rep < REP0; ++rep) {
        PHASE_IDS();
        LAS float* scr = (LAS float*)(ldsl + wave * 16384);
        constexpr int I_IN = 64 * 690, I_QB = 16 * 96, I_KVB = 8 * 128, I_OM = 32 * 128, I_OD = 16 * 128, I_OUT = 64 * 128;
        constexpr int NITEMS = I_IN + I_QB + I_KVB + I_OM + I_OD + I_OUT;
        for (int it = gw; it < NITEMS; it += NGW) {
            int r = it;
            if (r < I_IN) { const int kb = r / 690, nb = r % 690; int db, ds; if (nb < 48) { db = nb * 32; ds = 1; } else if (nb == 48) { db = C_KPE; ds = 2; } else if (nb == 49) { db = C_KPE + 1; ds = 2; } else { db = nb * 32 - 64; ds = 1; }
                transpose_item8(w_in, 4096, IN_W, (unsigned char*)Win_t, kb * 64, nb * 32, db, ds, scr, lane); continue; } r -= I_IN;
            if (r < I_QB) { const int kb = r / 96, nb = r % 96, hq = nb / 6, bi = nb % 6; int db, ds; if (bi < 4) { db = hq * 192 + bi * 32; ds = 1; } else { db = hq * 192 + 128 + (bi - 4); ds = 2; }
                transpose_item(w_qb, 1024, 3072, Wqb_t, kb * 64, nb * 32, db, ds, qa_g, scr, lane); continue; } r -= I_QB;
            if (r < I_KVB) { const int kb = r / 128, nb = r % 128; transpose_item(w_kvb, 512, 4096, Wkvb_t, kb * 64, nb * 32, nb * 32, 1, kva_g, scr, lane); continue; } r -= I_KVB;
            if (r < I_OM) { const int kb = r / 128, nb = r % 128; transpose_item(w_omla, 2048, 4096, Womla_t, kb * 64, nb * 32, nb * 32, 1, nullptr, scr, lane); continue; } r -= I_OM;
            if (r < I_OD) { const int kb = r / 128, nb = r % 128; transpose_item(w_odswa, 1024, 4096, Wodswa_t, kb * 64, nb * 32, nb * 32, 1, nullptr, scr, lane); continue; } r -= I_OD;
            { const int kb = r / 128, nb = r % 128; transpose_item(w_out, 4096, 4096, Wout_t, kb * 64, nb * 32, nb * 32, 1, nullptr, scr, lane); }
        }
        for (int m = gw; m < SEQ; m += NGW) {
            const f32x4* xr = (const f32x4*)(x + (size_t)m * DM) + lane;
            f32x4 v[16]; float s = 0.f;
#pragma unroll
            for (int j = 0; j < 16; ++j) { v[j] = xr[64 * j]; s += (v[j].x + v[j].y) + (v[j].z + v[j].w); }
            const float mean = wave_sum(s) * (1.f / DM); float s2 = 0.f;
#pragma unroll
            for (int j = 0; j < 16; ++j) { v[j] = v[j] - mean; s2 += (v[j].x * v[j].x + v[j].y * v[j].y) + (v[j].z * v[j].z + v[j].w * v[j].w); }
            const float rstd = 1.f / sqrtf(wave_sum(s2) * (1.f / DM) + LN_EPS);
            if (lane == 0) { stats[2 * m] = mean; stats[2 * m + 1] = rstd; }
            int* o4 = (int*)((unsigned char*)Hb + (size_t)m * DM) + lane;
#pragma unroll
            for (int j = 0; j < 16; ++j) { const f32x4 gv = ((const f32x4*)emb_g)[64 * j + lane], bv = ((const f32x4*)emb_b)[64 * j + lane]; const f32x4 y = (v[j] * rstd * gv + bv) * H_SC;
                int d = __builtin_amdgcn_cvt_pk_fp8_f32(y.x, y.y, 0, false); d = __builtin_amdgcn_cvt_pk_fp8_f32(y.z, y.w, d, true); o4[64 * j] = d; }
        }
        for (int e = gt; e < SEQ * 32; e += NGT) { const int pos = e >> 5, i = e & 31; const float invf = 1.0f / powf(10000.0f, (float)(2 * i) / 64.0f); const float ang = (float)pos * invf;
            double t = (double)ang * 0.15915494309189535; t -= __builtin_floor(t); const float tf = (float)t;
            rope[2 * e] = __builtin_amdgcn_cosf(tf); rope[2 * e + 1] = __builtin_amdgcn_sinf(tf); }
        for (int e = gt; e < 3 * 8 * 129; e += NGT) { const int j = e % 129 - 64, hh = (e / 129) % 8, g = e / (129 * 8), dil = 1 << (2 * g); const int rel = j * dil, n = rel < 0 ? -rel : rel;
            int bk; if (n < 8) bk = n; else { const float nf = (float)n; int lg = 8 + (int)(logf(nf / 8.f) / 4.852030263919617f * 8.f); bk = lg < 15 ? lg : 15; }
            if (rel > 0) bk += 16;
            bias2[e] = rel_bias[bk * 24 + g * 8 + hh] * LOG2E; }
        for (int e = gt; e < 2 * SEQ; e += NGT) rss_q[e] = 0.f;
    }
    grid.sync();

    for (int rep = 0; rep < REP1; ++rep) {
        pg8::Gemm g{Hb, Win_t, SEQ, LDP, 2048, 2048, 2048}; pg8::StaticOrder S; S.init(SEQ, LDP, G, bx);
        pg8::EpiProj E{proj, Kpe, rep ? nullptr : rss_q, rep ? nullptr : rss_kv, rope, 1.f / (H_SC * W_SC)};
        pg8::gemm_phase<pg8::EpiProj, pg8::StaticOrder, true, true, true>(ldsl, g, S, E);
    }
    grid.sync();

    for (int rep = 0; rep < REP2; ++rep) {
        { pg8::Gemm g{proj + C_QA, Wqb_t, SEQ, 3072, 1024, LDP, 1024}; pg8::StaticOrder S; S.init(SEQ, 3072, G, bx);
          pg8::EpiQ E{Qmla, rss_q, rope}; pg8::gemm_phase<pg8::EpiQ, pg8::StaticOrder, true, true>(ldsl, g, S, E); }
        { pg8::Gemm g{proj + C_CKV, Wkvb_t, SEQ, 4096, 512, LDP, 512}; pg8::StaticOrder S; S.init(SEQ, 4096, G, bx);
          pg8::EpiKV E{KVmla, rss_kv}; pg8::gemm_phase<pg8::EpiKV, pg8::StaticOrder, true, true>(ldsl, g, S, E); }
        __syncthreads();
        for (int u = vcu; u < 768; u += G) { const int H = u >> 5, rem = u & 31, g = H >> 3, nqb = 32 >> (2 * g); att::dswa_unit(H, rem / nqb, rem % nqb, proj, bias2, Odswa, lse, (char*)lds); }
    }
    grid.sync();

    for (int rep = 0; rep < REP3; ++rep) {
        for (int u = vcu; u < 512; u += G) { const int h = u >> 5, qb = u & 31; const size_t r0 = (size_t)qb * 256;
            att::mla_unit(Qmla + r0 * 3072 + h * 192, KVmla + h * 256, KVmla + h * 256 + 128, Kpe, proj + r0 * LDP + C_GMLA + h * 128, Amla + r0 * 2048 + h * 128, (char*)lds, ldsl); }
        PHASE_IDS();
        for (int it = gt; it < SEQ * 128; it += NGT) { const int pos = it >> 7, c8 = it & 127, hh = c8 >> 4, col = c8 * 8;
            const float l0 = lse[((size_t)0 * SEQ + pos) * 8 + hh], l1 = lse[((size_t)1 * SEQ + pos) * 8 + hh], l2 = lse[((size_t)2 * SEQ + pos) * 8 + hh];
            const float mx = fmaxf(l0, fmaxf(l1, l2)); float e0 = __builtin_amdgcn_exp2f(l0 - mx), e1 = __builtin_amdgcn_exp2f(l1 - mx), e2 = __builtin_amdgcn_exp2f(l2 - mx);
            const float inv = 1.f / (e0 + e1 + e2); e0 *= inv; e1 *= inv; e2 *= inv;
            const v4u a0 = *(const v4u*)(Odswa + ((size_t)0 * SEQ + pos) * 1024 + col), a1 = *(const v4u*)(Odswa + ((size_t)1 * SEQ + pos) * 1024 + col), a2 = *(const v4u*)(Odswa + ((size_t)2 * SEQ + pos) * 1024 + col);
            const v4u gg = *(const v4u*)(proj + (size_t)pos * LDP + C_GDSWA + col); v4u o;
#pragma unroll
            for (int k = 0; k < 4; ++k) { const float lo = (pg8::bflo(a0[k]) * e0 + pg8::bflo(a1[k]) * e1 + pg8::bflo(a2[k]) * e2) * pg8::bflo(gg[k]);
                const float hi = (pg8::bfhi(a0[k]) * e0 + pg8::bfhi(a1[k]) * e1 + pg8::bfhi(a2[k]) * e2) * pg8::bfhi(gg[k]); o[k] = pk2(lo, hi); }
            *(v4u*)(Bdswa + (size_t)pos * 1024 + col) = o; }
    }
    grid.sync();

    for (int rep = 0; rep < REP4; ++rep) {
        { pg8::Gemm g{Amla, Womla_t, SEQ, 4096, 2048, 2048, 2048}; pg8::StaticOrder S; S.init(SEQ, 4096, G, bx);
          pg8::EpiY<0> E{Tm, proj + C_RMLA}; pg8::gemm_phase<pg8::EpiY<0>, pg8::StaticOrder, true, true>(ldsl, g, S, E); }
        { pg8::Gemm g{Bdswa, Wodswa_t, SEQ, 4096, 1024, 1024, 1024}; pg8::StaticOrder S; S.init(SEQ, 4096, G, bx);
          pg8::EpiY<1> E{Tm, proj + C_RDSWA}; pg8::gemm_phase<pg8::EpiY<1>, pg8::StaticOrder, true, true>(ldsl, g, S, E); }
    }
    grid.sync();

    for (int rep = 0; rep < REP5; ++rep) {
        pg8::Gemm g{Tm, Wout_t, SEQ, 4096, 4096, 4096, 4096}; pg8::StaticOrder S; S.init(SEQ, 4096, G, bx);
        pg8::EpiOut E{x, stats, emb_g, emb_b, a.out}; pg8::gemm_phase<pg8::EpiOut, pg8::StaticOrder, true, true>(ldsl, g, S, E);
    }
    grid.sync();

    { PHASE_IDS();
    for (int m = gw; m < SEQ; m += NGW) {
        f32x4* xr = (f32x4*)(a.out + (size_t)m * DM) + lane;
        f32x4 v[16]; float s = 0.f;
#pragma unroll
        for (int j = 0; j < 16; ++j) { v[j] = xr[64 * j]; s += (v[j].x + v[j].y) + (v[j].z + v[j].w); }
        const float mean = wave_sum(s) * (1.f / DM); float s2 = 0.f;
#pragma unroll
        for (int j = 0; j < 16; ++j) { v[j] = v[j] - mean; s2 += (v[j].x * v[j].x + v[j].y * v[j].y) + (v[j].z * v[j].z + v[j].w * v[j].w); }
        const float rstd = 1.f / sqrtf(wave_sum(s2) * (1.f / DM) + LN_EPS);
#pragma unroll
        for (int j = 0; j < 16; ++j) { const f32x4 gv = ((const f32x4*)ln_g)[64 * j + lane], bv = ((const f32x4*)ln_b)[64 * j + lane]; xr[64 * j] = v[j] * rstd * gv + bv; }
    } }
}

extern "C" void kernel_launch(void* const* d_in, const int* in_sizes, int n_in, void* d_out, int out_size, void* d_ws, size_t ws_size, hipStream_t stream) {
    static int grid = 0;
    if (grid == 0) {
        if (n_in != 14 || in_sizes[0] != SEQ * DM || out_size != SEQ * DM || ws_size < WS_END) { fprintf(stderr, "kernel_launch: unexpected shapes (n_in %d, in0 %d, out %d, ws %zu < %zu)\n", n_in, n_in > 0 ? in_sizes[0] : -1, out_size, ws_size, (size_t)WS_END); grid = -1; return; }
        int dev = 0, cus = 0, per_cu = 0;
        if (hipGetDevice(&dev) != hipSuccess || hipDeviceGetAttribute(&cus, hipDeviceAttributeMultiprocessorCount, dev) != hipSuccess) { grid = -1; return; }
        if (hipFuncSetAttribute((const void*)fwd_mega, hipFuncAttributeMaxDynamicSharedMemorySize, LDS_BYTES) != hipSuccess) { fprintf(stderr, "kernel_launch: hipFuncSetAttribute failed\n"); grid = -1; return; }
        if (hipOccupancyMaxActiveBlocksPerMultiprocessor(&per_cu, (const void*)fwd_mega, NWAVES * 64, LDS_BYTES) != hipSuccess || per_cu < 1) { fprintf(stderr, "kernel_launch: occupancy query says %d blocks per CU\n", per_cu); per_cu = 1; }
        (void)hipGetLastError();
        grid = cus;
    }
    if (grid < 0) return;
    Args a{};
    for (int i = 0; i < 14; ++i) a.in[i] = (const float*)d_in[i];
    a.out = (float*)d_out; a.ws = (unsigned char*)d_ws;
    void* args[] = {&a};
    hipError_t e = hipLaunchCooperativeKernel((const void*)fwd_mega, dim3(grid), dim3(NWAVES * 64), args, LDS_BYTES, stream);
    if (e != hipSuccess) fprintf(stderr, "kernel_launch: cooperative launch failed: %s (grid %d)\n", hipGetErrorString(e), grid);
}
```

```cpp
#include <hip/hip_runtime.h>
#include <hip/hip_cooperative_groups.h>
#include <cstdio>
#include <cstdint>
#include <cmath>
namespace cg = cooperative_groups;

constexpr int SEQ = 8192, DM = 4096;
constexpr int LDP = 22272;
constexpr int C_QA = 0, C_CKV = 1024, C_DQ = 1536, C_DK = 4608, C_DV = 7680, C_GMLA = 10752, C_GDSWA = 12800, C_RMLA = 13824, C_RDSWA = 17920, C_KPE = 22016;
constexpr int IN_W = 22080;
constexpr float LOG2E = 1.4426950408889634f;
constexpr float QS_D = 0.08838834764831845f * LOG2E;
constexpr float QS_M = 0.07216878364870323f * LOG2E;
constexpr float ALPHA = 1.189207115002721f;
constexpr float LN_EPS = 1e-5f, RMS_EPS = 1e-6f;
constexpr float A_SC = 256.f, B_SC = 128.f, T_SC = 512.f, W_OM_SC = 1024.f, W_OD_SC = 1024.f, W_OUT_SC = 2048.f;

__device__ __forceinline__ int opaque_tid() { int t = threadIdx.x; asm volatile("" : "+v"(t)); return t; }

namespace pg8 {
#define PG8_LAS __attribute__((address_space(3)))
typedef unsigned short bf16_t;
typedef short bf16x8 __attribute__((ext_vector_type(8)));
typedef float f32x4 __attribute__((ext_vector_type(4)));
typedef unsigned u32x4 __attribute__((ext_vector_type(4)));
constexpr int BM = 256, BK = 64, HALF = 128, HTB = HALF * BK * 2  , STAGE_BYTES = 8 * HTB, NXCD = 8, WGM = 8;

__host__ __device__ __forceinline__ int lds_byte(int r, int c) { const int st = (r >> 4) * 2 + (c >> 5), rr = r & 15, cc = c & 31, ob = rr * 64 + cc * 2; return st * 1024 + (ob ^ (((ob >> 9) & 1) << 5)); }
__host__ __device__ __forceinline__ void stage_rc(int b, int& R, int& C) { const int st = b / 1024, sb = b % 1024, swz = sb ^ (((sb >> 9) & 1) << 5); R = (st >> 1) * 16 + swz / 64; C = (st & 1) * 32 + (swz % 64) / 2; }
__host__ __device__ __forceinline__ int perm32(int rho) { const int n = rho >> 4, i = rho & 15; return 8 * (i >> 2) + 4 * n + (i & 3); }

struct Unit { int pm, pn; };
struct Gemm { const bf16_t* A; const bf16_t* Bt; int M, N, K, lda, ldb; };

struct StaticOrder {
    int nM, nN, nwg, G, c;
    __host__ __device__ void init(int M, int N, int G_, int c_) { nM = M / BM; nN = N / BM; nwg = nM * nN; G = G_; c = c_; }
    __host__ __device__ bool next(int i, Unit& u) const {
        const long L = (long)i * G + c; if (L >= nwg) return false;
        int wgid = (int)L; { const int q = nwg / NXCD, r = nwg % NXCD, xcd = wgid % NXCD, off = wgid / NXCD; wgid = (xcd < r ? xcd * (q + 1) : r * (q + 1) + (xcd - r) * q) + off; }
        const int nig = WGM * nN, gid = wgid / nig, fm = gid * WGM, gsz = (nM - fm) < WGM ? (nM - fm) : WGM;
        u.pm = fm + ((wgid % nig) % gsz); u.pn = (wgid % nig) / gsz; return true;
    }
    __device__ __forceinline__ void a_ready(const Unit&) const {}
    __device__ __forceinline__ void done(const Unit&) const {}
};


typedef float f32x2 __attribute__((ext_vector_type(2))); typedef __bf16 bf16x2_t __attribute__((ext_vector_type(2)));
typedef int i32x4 __attribute__((ext_vector_type(4))); typedef int i32x8 __attribute__((ext_vector_type(8)));
__device__ __forceinline__ i32x8 cat8(bf16x8 a, bf16x8 b) { return __builtin_shufflevector(__builtin_bit_cast(i32x4, a), __builtin_bit_cast(i32x4, b), 0, 1, 2, 3, 4, 5, 6, 7); }
__device__ __forceinline__ unsigned cvt_pk_bf16(float lo, float hi) { f32x2 v = {lo, hi}; bf16x2_t b = __builtin_convertvector(v, bf16x2_t); return __builtin_bit_cast(unsigned, b); }
typedef int i32x2 __attribute__((ext_vector_type(2)));
__device__ __forceinline__ int cvt4_fp8(float a, float b, float c, float d) { a = __builtin_amdgcn_fmed3f(a, -440.f, 440.f); b = __builtin_amdgcn_fmed3f(b, -440.f, 440.f); c = __builtin_amdgcn_fmed3f(c, -440.f, 440.f); d = __builtin_amdgcn_fmed3f(d, -440.f, 440.f);
    int r = __builtin_amdgcn_cvt_pk_fp8_f32(a, b, 0, false); return __builtin_amdgcn_cvt_pk_fp8_f32(c, d, r, true); }
__device__ __forceinline__ float bflo(unsigned w) { return __uint_as_float(w << 16); }
__device__ __forceinline__ float bfhi(unsigned w) { return __uint_as_float(w & 0xffff0000u); }
__device__ __forceinline__ float sigm(float x) { return __builtin_amdgcn_rcpf(1.f + __builtin_amdgcn_exp2f(-x * 1.4426950408889634f)); }
__device__ __forceinline__ u32x4 pack8(const f32x4 v0, const f32x4 v1) { u32x4 w; w.x = cvt_pk_bf16(v0[0], v0[1]); w.y = cvt_pk_bf16(v0[2], v0[3]); w.z = cvt_pk_bf16(v1[0], v1[1]); w.w = cvt_pk_bf16(v1[2], v1[3]); return w; }
__device__ __forceinline__ void rope8(f32x4& v0, f32x4& v1, const f32x4 cs0, const f32x4 cs1) {
    const float a0 = v0[0] * cs0[0] - v0[1] * cs0[1], b0 = v0[1] * cs0[0] + v0[0] * cs0[1];
    const float a1 = v0[2] * cs0[2] - v0[3] * cs0[3], b1 = v0[3] * cs0[2] + v0[2] * cs0[3];
    const float a2 = v1[0] * cs1[0] - v1[1] * cs1[1], b2 = v1[1] * cs1[0] + v1[0] * cs1[1];
    const float a3 = v1[2] * cs1[2] - v1[3] * cs1[3], b3 = v1[3] * cs1[2] + v1[2] * cs1[3];
    v0 = (f32x4){a0, b0, a1, b1}; v1 = (f32x4){a2, b2, a3, b3};
}

struct EpiProj {
    static constexpr bool PERM = true, AFTER_DRAIN = false;
    bf16_t* proj; bf16_t* kpe; float* rss_q; float* rss_kv; const float* rope; float osc;
    template <int ACT> __device__ __forceinline__ void body(const f32x4 (&acc)[2][2][4][2], const Unit& u, int wr, int wc, int fr, int fq, float sc, float* rss) const {
        const int row0 = u.pm * BM + wr * 64 + fr, col0 = u.pn * BM + wc * 32 + 8 * fq;
#pragma unroll
        for (int ai = 0; ai < 2; ++ai)
#pragma unroll
            for (int m = 0; m < 4; ++m) { const int row = row0 + ai * HALF + m * 16; bf16_t* rowp = proj + (size_t)row * LDP + col0; float ss = 0.f;
#pragma unroll
                for (int bj = 0; bj < 2; ++bj) { f32x4 v0 = acc[ai][bj][m][0] * sc, v1 = acc[ai][bj][m][1] * sc;
                    if (ACT == 1) {
#pragma unroll
                        for (int e = 0; e < 4; ++e) { v0[e] = v0[e] * sigm(v0[e]); v1[e] = v1[e] * sigm(v1[e]); } }
                    if (ACT == 2) {
#pragma unroll
                        for (int e = 0; e < 4; ++e) { v0[e] = sigm(v0[e]); v1[e] = sigm(v1[e]); } }
                    if (ACT == 3) { ss += (v0[0] * v0[0] + v0[1] * v0[1]) + (v0[2] * v0[2] + v0[3] * v0[3]) + (v1[0] * v1[0] + v1[1] * v1[1]) + (v1[2] * v1[2] + v1[3] * v1[3]); }
                    *(u32x4*)(rowp + bj * HALF) = pack8(v0, v1); }
                if (ACT == 3) { ss += __shfl_xor(ss, 16); ss += __shfl_xor(ss, 32); if (fq == 0 && rss) atomicAdd(rss + row, ss); } }
    }
    __device__ __forceinline__ void operator()(const f32x4 (&acc)[2][2][4][2], const Unit& u, int wr, int wc, int fr, int fq) const {
        const int pn = u.pn;
        if (pn < 4) body<3>(acc, u, wr, wc, fr, fq, osc, rss_q);
        else if (pn < 6) body<3>(acc, u, wr, wc, fr, fq, osc, rss_kv);
        else if (pn < 42) body<0>(acc, u, wr, wc, fr, fq, pn < 18 ? QS_D * osc : osc, nullptr);
        else if (pn < 54) body<1>(acc, u, wr, wc, fr, fq, osc, nullptr);
        else if (pn < 86) body<2>(acc, u, wr, wc, fr, fq, osc, nullptr);
        else if (wc < 2) {
            const int row0 = u.pm * BM + wr * 64 + fr, c0 = wc * 32 + 8 * fq;
#pragma unroll
            for (int ai = 0; ai < 2; ++ai)
#pragma unroll
                for (int m = 0; m < 4; ++m) { const int row = row0 + ai * HALF + m * 16; f32x4 v0 = acc[ai][0][m][0] * osc, v1 = acc[ai][0][m][1] * osc;
                    const f32x4* cs = (const f32x4*)(rope + (size_t)row * 64 + c0); rope8(v0, v1, cs[0], cs[1]);
                    *(u32x4*)(kpe + (size_t)row * 64 + c0) = pack8(v0, v1); }
        }
    }
};
struct EpiQ {
    static constexpr bool PERM = true, AFTER_DRAIN = false;
    bf16_t* q; const float* rss; const float* rope;
    __device__ __forceinline__ void operator()(const f32x4 (&acc)[2][2][4][2], const Unit& u, int wr, int wc, int fr, int fq) const {
        const int row0 = u.pm * BM + wr * 64 + fr, col0 = u.pn * BM + wc * 32 + 8 * fq;
        const int cw0 = col0 % 192, cw1 = (col0 + HALF) % 192;
#pragma unroll
        for (int ai = 0; ai < 2; ++ai)
#pragma unroll
            for (int m = 0; m < 4; ++m) { const int row = row0 + ai * HALF + m * 16; const float sc = QS_M / sqrtf(rss[row] * (1.f / 1024.f) + RMS_EPS);
#pragma unroll
                for (int bj = 0; bj < 2; ++bj) { f32x4 v0 = acc[ai][bj][m][0] * sc, v1 = acc[ai][bj][m][1] * sc; const int cw = bj ? cw1 : cw0;
                    if (cw >= 128) { const f32x4* cs = (const f32x4*)(rope + (size_t)row * 64 + (cw - 128)); rope8(v0, v1, cs[0], cs[1]); }
                    *(u32x4*)(q + (size_t)row * 3072 + col0 + bj * HALF) = pack8(v0, v1); } }
    }
};
struct EpiKV {
    static constexpr bool PERM = true, AFTER_DRAIN = false;
    bf16_t* kv; const float* rss;
    __device__ __forceinline__ void operator()(const f32x4 (&acc)[2][2][4][2], const Unit& u, int wr, int wc, int fr, int fq) const {
        const int row0 = u.pm * BM + wr * 64 + fr, col0 = u.pn * BM + wc * 32 + 8 * fq;
#pragma unroll
        for (int ai = 0; ai < 2; ++ai)
#pragma unroll
            for (int m = 0; m < 4; ++m) { const int row = row0 + ai * HALF + m * 16; const float sc = 1.f / sqrtf(rss[row] * (1.f / 512.f) + RMS_EPS);
#pragma unroll
                for (int bj = 0; bj < 2; ++bj) *(u32x4*)(kv + (size_t)row * 4096 + col0 + bj * HALF) = pack8(acc[ai][bj][m][0] * sc, acc[ai][bj][m][1] * sc); }
    }
};
template <int PASS> struct EpiY {
    static constexpr bool PERM = true, AFTER_DRAIN = false;
    bf16_t* T; const bf16_t* gate; unsigned char* T8;
    __device__ __forceinline__ void operator()(const f32x4 (&acc)[2][2][4][2], const Unit& u, int wr, int wc, int fr, int fq) const {
        const int row0 = u.pm * BM + wr * 64 + fr, col0 = u.pn * BM + wc * 32 + 8 * fq;
        constexpr float osc = PASS == 0 ? 1.f / (A_SC * W_OM_SC) : 1.f / (B_SC * W_OD_SC), tsc = T_SC;
#pragma unroll
        for (int ai = 0; ai < 2; ++ai)
#pragma unroll
            for (int m = 0; m < 4; ++m) { const int row = row0 + ai * HALF + m * 16;
#pragma unroll
                for (int bj = 0; bj < 2; ++bj) { const u32x4 gw = *(const u32x4*)(gate + (size_t)row * LDP + col0 + bj * HALF); bf16_t* tp = T + (size_t)row * 4096 + col0 + bj * HALF;
                    f32x4 v0 = acc[ai][bj][m][0] * osc, v1 = acc[ai][bj][m][1] * osc;
                    v0 = v0 * (f32x4){bflo(gw.x), bfhi(gw.x), bflo(gw.y), bfhi(gw.y)}; v1 = v1 * (f32x4){bflo(gw.z), bfhi(gw.z), bflo(gw.w), bfhi(gw.w)};
                    if (PASS == 0) { *(u32x4*)tp = pack8(v0, v1); }
                    else { const u32x4 tw = *(const u32x4*)tp; v0 = (v0 + (f32x4){bflo(tw.x), bfhi(tw.x), bflo(tw.y), bfhi(tw.y)}) * tsc; v1 = (v1 + (f32x4){bflo(tw.z), bfhi(tw.z), bflo(tw.w), bfhi(tw.w)}) * tsc;
                        *(i32x2*)(T8 + (size_t)row * 4096 + col0 + bj * HALF) = (i32x2){cvt4_fp8(v0[0], v0[1], v0[2], v0[3]), cvt4_fp8(v1[0], v1[1], v1[2], v1[3])}; } } }
    }
};
struct EpiOut {
    static constexpr bool PERM = false, AFTER_DRAIN = false;
    const float* x; const float* stats; const float* g; const float* b; float* out; float osc;
    __device__ __forceinline__ void operator()(const f32x4 (&acc)[2][2][4][2], const Unit& u, int wr, int wc, int fr, int fq) const {
        const int row0 = u.pm * BM + wr * 64 + fr, col0 = u.pn * BM + wc * 32 + 4 * fq;
#pragma unroll
        for (int bj = 0; bj < 2; ++bj)
#pragma unroll
            for (int n = 0; n < 2; ++n) { const int col = col0 + bj * HALF + n * 16; const f32x4 gv = *(const f32x4*)(g + col) * ALPHA, bv = *(const f32x4*)(b + col) * ALPHA;
#pragma unroll
                for (int ai = 0; ai < 2; ++ai)
#pragma unroll
                    for (int m = 0; m < 4; ++m) { const int row = row0 + ai * HALF + m * 16; const f32x2 st = *(const f32x2*)(stats + 2 * row);
                        const size_t off = (size_t)row * 4096 + col; const f32x4 xv = *(const f32x4*)(x + off);
                        *(f32x4*)(out + off) = ((xv - st.x) * st.y) * gv + bv + acc[ai][bj][m][n] * osc; } }
    }
};

template <class Epi, class Sched, bool ALIGN_EPI = false, bool SP2 = false, bool FP8 = false>
__device__ __forceinline__ void gemm_phase(PG8_LAS unsigned char* lds, const Gemm g, const Sched S, const Epi E) {
    const int tid = opaque_tid(), wid = __builtin_amdgcn_readfirstlane(tid >> 6), lane = tid & 63, wr = wid >> 2, wc = wid & 3, fr = lane & 15, fq = lane >> 4;
    const int K = g.K, nt = K / BK;
    unsigned voffA[2], voffB[2];
#pragma unroll
    for (int i = 0; i < 2; ++i) { int R, C; stage_rc(tid * 16 + i * 8192, R, C); const int Rb = Epi::PERM ? ((R & ~31) + perm32(R & 31)) : R;
        voffA[i] = (unsigned)(R * g.lda + C) * 2u; voffB[i] = (unsigned)(Rb * g.ldb + C) * 2u; }
    const size_t kstep = (size_t)(BK * 2);
    const size_t hstepA = (size_t)HALF * g.lda * 2, hstepB = (size_t)HALF * g.ldb * 2;
    const size_t tstepA = 2 * hstepA, tstepB = 2 * hstepB;
    const unsigned ldsw = (unsigned)wid * 1024u;
    const int aoff = lds_byte(wr * 64 + fr, fq * 8), boff = lds_byte(wc * 32 + fr, fq * 8);
#define PG8_SA(b, h) (((b) * 2 + (h)) * HTB)
#define PG8_SB(b, h) ((4 + (b) * 2 + (h)) * HTB)
#define PG8_STAGE(bufoff, gbase, voff) do { _Pragma("unroll") for (int _i = 0; _i < 2; ++_i) \
        __builtin_amdgcn_global_load_lds((const unsigned*)((const char*)(gbase) + (voff)[_i]), (PG8_LAS unsigned*)(lds + (bufoff) + ldsw + _i * 8192), 16, 0, 0); } while (0)
#define PG8_LDA(dst, b, h) do { if constexpr (FP8) { _Pragma("unroll") for (int m = 0; m < 4; ++m) dst##8[m] = cat8(*(const PG8_LAS bf16x8*)(lds + PG8_SA(b, h) + aoff + m * 2048), *(const PG8_LAS bf16x8*)(lds + PG8_SA(b, h) + aoff + m * 2048 + 1024)); } \
    else { _Pragma("unroll") for (int m = 0; m < 4; ++m) _Pragma("unroll") for (int k = 0; k < 2; ++k) dst[m][k] = *(const PG8_LAS bf16x8*)(lds + PG8_SA(b, h) + aoff + m * 2048 + k * 1024); } } while (0)
#define PG8_LDB(dst, b, h) do { if constexpr (FP8) { _Pragma("unroll") for (int n = 0; n < 2; ++n) dst##8[n] = cat8(*(const PG8_LAS bf16x8*)(lds + PG8_SB(b, h) + boff + n * 2048), *(const PG8_LAS bf16x8*)(lds + PG8_SB(b, h) + boff + n * 2048 + 1024)); } \
    else { _Pragma("unroll") for (int n = 0; n < 2; ++n) _Pragma("unroll") for (int k = 0; k < 2; ++k) dst[n][k] = *(const PG8_LAS bf16x8*)(lds + PG8_SB(b, h) + boff + n * 2048 + k * 1024); } } while (0)
#define PG8_MMA(ai, bj, At, Bt) do { __builtin_amdgcn_s_setprio(1); if constexpr (FP8) { _Pragma("unroll") for (int m = 0; m < 4; ++m) _Pragma("unroll") for (int n = 0; n < 2; ++n) \
        asm volatile("v_mfma_f32_16x16x128_f8f6f4 %0, %1, %2, %0" : "+v"(acc[ai][bj][m][n]) : "v"(Bt##8[n]), "v"(At##8[m])); } else { \
        _Pragma("unroll") for (int m = 0; m < 4; ++m) _Pragma("unroll") for (int n = 0; n < 2; ++n) _Pragma("unroll") for (int k = 0; k < 2; ++k) \
        acc[ai][bj][m][n] = __builtin_amdgcn_mfma_f32_16x16x32_bf16(Bt[n][k], At[m][k], acc[ai][bj][m][n], 0, 0, 0); } __builtin_amdgcn_s_setprio(0); } while (0)
#define PG8_WAIT_V(n) asm volatile("s_waitcnt vmcnt(" #n ")" ::: "memory")
#define PG8_WAIT_L(n) asm volatile("s_waitcnt lgkmcnt(" #n ")" ::: "memory")
#define PG8_BAR __builtin_amdgcn_s_barrier()
#define PG8_SCHED __builtin_amdgcn_sched_barrier(0)
    Unit cur, nxt; int ui = 0;
    if (!S.next(0, cur)) return;
    f32x4 acc[2][2][4][2];
#pragma unroll
    for (int a = 0; a < 2; ++a)
#pragma unroll
        for (int b = 0; b < 2; ++b)
#pragma unroll
            for (int m = 0; m < 4; ++m)
#pragma unroll
                for (int n = 0; n < 2; ++n) acc[a][b][m][n] = (f32x4){0.f, 0.f, 0.f, 0.f};
    bf16x8 At[4][2], B0[2][2], B1[2][2]; i32x8 At8[4], B08[2], B18[2];
    const char* cA = (const char*)g.A + (size_t)cur.pm * tstepA; const char* cB = (const char*)g.Bt + (size_t)cur.pn * tstepB;
    S.a_ready(cur);
    if constexpr (SP2) {
        PG8_STAGE(PG8_SB(0, 0), cB, voffB); PG8_STAGE(PG8_SB(0, 1), cB + hstepB, voffB); PG8_STAGE(PG8_SA(0, 0), cA, voffA); PG8_STAGE(PG8_SA(0, 1), cA + hstepA, voffA);
        if (wr == 1) PG8_BAR;
        PG8_WAIT_V(2); PG8_BAR;
        PG8_STAGE(PG8_SB(1, 0), cB + kstep, voffB); PG8_STAGE(PG8_SA(1, 0), cA + kstep, voffA); PG8_STAGE(PG8_SB(1, 1), cB + hstepB + kstep, voffB);
        PG8_WAIT_V(6); PG8_BAR;
    } else {
        PG8_STAGE(PG8_SB(0, 0), cB, voffB); PG8_STAGE(PG8_SA(0, 0), cA, voffA); PG8_STAGE(PG8_SB(0, 1), cB + hstepB, voffB); PG8_STAGE(PG8_SA(0, 1), cA + hstepA, voffA);
        if (wr == 1) PG8_BAR;
        PG8_WAIT_V(4); PG8_BAR;
        PG8_STAGE(PG8_SB(1, 0), cB + kstep, voffB); PG8_STAGE(PG8_SA(1, 0), cA + kstep, voffA); PG8_STAGE(PG8_SB(1, 1), cB + hstepB + kstep, voffB);
        PG8_WAIT_V(6); PG8_BAR;
    }
    for (;;) {
        const bool has_next = S.next(ui + 1, nxt);
        const char* nA = has_next ? (const char*)g.A + (size_t)nxt.pm * tstepA : cA; const char* nB = has_next ? (const char*)g.Bt + (size_t)nxt.pn * tstepB : cB;
        for (int t = 0; t < nt; t += 2) {
            const bool last = (t == nt - 2);
            const char* a1 = cA + (size_t)(t + 1) * kstep;
            const char* a2 = last ? nA : cA + (size_t)(t + 2) * kstep; const char* b2 = last ? nB : cB + (size_t)(t + 2) * kstep;
            const char* a3 = a2 + kstep; const char* b3 = b2 + kstep;
            if (last && has_next) S.a_ready(nxt);
            if constexpr (SP2) {
            PG8_LDB(B0, 0, 0); PG8_LDB(B1, 0, 1); PG8_SCHED; PG8_LDA(At, 0, 0); PG8_STAGE(PG8_SA(1, 1), a1 + hstepA, voffA);
            PG8_WAIT_V(8); PG8_WAIT_L(0); PG8_BAR; PG8_MMA(0, 0, At, B0); PG8_MMA(0, 1, At, B1); PG8_BAR; PG8_SCHED;
            PG8_LDA(At, 0, 1); PG8_STAGE(PG8_SB(0, 0), b2, voffB); PG8_STAGE(PG8_SB(0, 1), b2 + hstepB, voffB); PG8_STAGE(PG8_SA(0, 0), a2, voffA);
            PG8_WAIT_V(8); PG8_WAIT_L(0); PG8_BAR; PG8_MMA(1, 0, At, B0); PG8_MMA(1, 1, At, B1); PG8_BAR; PG8_SCHED;
            PG8_LDB(B0, 1, 0); PG8_LDB(B1, 1, 1); PG8_SCHED; PG8_LDA(At, 1, 0); PG8_STAGE(PG8_SA(0, 1), a2 + hstepA, voffA);
            PG8_WAIT_V(8); PG8_WAIT_L(0); PG8_BAR; PG8_MMA(0, 0, At, B0); PG8_MMA(0, 1, At, B1); PG8_BAR; PG8_SCHED;
            PG8_LDA(At, 1, 1); PG8_STAGE(PG8_SB(1, 0), b3, voffB); PG8_STAGE(PG8_SB(1, 1), b3 + hstepB, voffB); PG8_STAGE(PG8_SA(1, 0), a3, voffA);
            PG8_WAIT_V(8); PG8_WAIT_L(0); PG8_BAR; PG8_MMA(1, 0, At, B0); PG8_MMA(1, 1, At, B1); PG8_BAR; PG8_SCHED;
            } else {
            PG8_LDB(B0, 0, 0); PG8_SCHED; PG8_LDA(At, 0, 0); PG8_STAGE(PG8_SA(1, 1), a1 + hstepA, voffA);
            PG8_WAIT_L(8); PG8_BAR; PG8_WAIT_L(0); PG8_MMA(0, 0, At, B0); PG8_BAR; PG8_SCHED;
            PG8_LDB(B1, 0, 1); PG8_STAGE(PG8_SB(0, 0), b2, voffB);
            PG8_BAR; PG8_WAIT_L(0); PG8_MMA(0, 1, At, B1); PG8_BAR;
            PG8_LDA(At, 0, 1); PG8_STAGE(PG8_SA(0, 0), a2, voffA);
            PG8_BAR; PG8_WAIT_L(0); PG8_MMA(1, 0, At, B0); PG8_BAR; PG8_SCHED;
            PG8_STAGE(PG8_SB(0, 1), b2 + hstepB, voffB);
            PG8_WAIT_V(6); PG8_BAR; PG8_MMA(1, 1, At, B1); PG8_BAR;
            PG8_LDB(B0, 1, 0); PG8_SCHED; PG8_LDA(At, 1, 0); PG8_STAGE(PG8_SA(0, 1), a2 + hstepA, voffA);
            PG8_WAIT_L(8); PG8_BAR; PG8_WAIT_L(0); PG8_MMA(0, 0, At, B0); PG8_BAR; PG8_SCHED;
            PG8_LDB(B1, 1, 1); PG8_STAGE(PG8_SB(1, 0), b3, voffB);
            PG8_BAR; PG8_WAIT_L(0); PG8_MMA(0, 1, At, B1); PG8_BAR;
            PG8_LDA(At, 1, 1); PG8_STAGE(PG8_SA(1, 0), a3, voffA);
            PG8_BAR; PG8_WAIT_L(0); PG8_MMA(1, 0, At, B0); PG8_BAR; PG8_SCHED;
            PG8_STAGE(PG8_SB(1, 1), b3 + hstepB, voffB);
            PG8_WAIT_V(6); PG8_BAR; PG8_MMA(1, 1, At, B1); PG8_BAR;
            }
        }
        if constexpr (ALIGN_EPI) { if (wr == 0) PG8_BAR; }
        if constexpr (FP8) asm volatile("s_nop 15\n\ts_nop 15" ::: "memory");
        if constexpr (!Epi::AFTER_DRAIN) { E(acc, cur, wr, wc, fr, fq); S.done(cur); }
        if (!has_next) break;
#pragma unroll
        for (int a = 0; a < 2; ++a)
#pragma unroll
            for (int b = 0; b < 2; ++b)
#pragma unroll
                for (int m = 0; m < 4; ++m)
#pragma unroll
                    for (int n = 0; n < 2; ++n) acc[a][b][m][n] = (f32x4){0.f, 0.f, 0.f, 0.f};
        cur = nxt; cA = nA; cB = nB; ++ui;
        if constexpr (ALIGN_EPI) { if (wr == 1) PG8_BAR; }
    }
    PG8_WAIT_V(0);
    if constexpr (!ALIGN_EPI) { if (wr == 0) PG8_BAR; }
    PG8_BAR;
    if constexpr (Epi::AFTER_DRAIN) { E.fused(acc, cur, wr, wc, fr, fq, lds, wid, lane); S.done(cur); }
#undef PG8_SA
#undef PG8_SB
#undef PG8_STAGE
#undef PG8_LDA
#undef PG8_LDB
#undef PG8_MMA
#undef PG8_WAIT_V
#undef PG8_WAIT_L
#undef PG8_BAR
#undef PG8_SCHED
}
}

namespace att {
typedef unsigned short bf16_t;
using bf16x8 = __attribute__((ext_vector_type(8))) short;
using s16x4  = __attribute__((ext_vector_type(4))) short;
using f32x16 = __attribute__((ext_vector_type(16))) float;
using u32x4  = __attribute__((ext_vector_type(4))) unsigned;
constexpr int NW = 8, QBLK = 32, KVBLK = 64;
constexpr int SHM_V = 16384, SHM_KN = 16384, SHM_KP = 8192;
constexpr int OFF_V = 0, OFF_KN = 2 * SHM_V, OFF_KP = OFF_KN + 2 * SHM_KN, OFF_WS = OFF_KP + 2 * SHM_KP, OFF_BIAS = OFF_WS + NW * 64 * 4, OFF_QPE = OFF_BIAS + 1024, ATT_LDS = OFF_QPE + NW * 4096, M_QPE = 3 * 40960 + 2048;
#define KSWZ(row, colB) ((row) * 256 + ((colB) ^ (((row) & 15) << 4)))
#define KPSWZ(row, colB) ((row) * 128 + ((colB) ^ ((((row) >> 1) & 7) << 4)))
#define SBAR() __builtin_amdgcn_sched_barrier(0)
__device__ __forceinline__ int crow(int r, int hi) { return (r & 3) + 8 * (r >> 2) + 4 * hi; }
typedef float f32x2_t __attribute__((ext_vector_type(2))); typedef __bf16 bf16x2_t __attribute__((ext_vector_type(2)));
__device__ __forceinline__ unsigned cvtpk(float lo, float hi) { f32x2_t v = {lo, hi}; bf16x2_t b = __builtin_convertvector(v, bf16x2_t); return __builtin_bit_cast(unsigned, b); }
__device__ __forceinline__ bf16x8 ld8(const bf16_t* p) { return *reinterpret_cast<const bf16x8*>(p); }

template <int THR2>
__device__ __forceinline__ void partialSM(f32x16& p0, f32x16& p1, float& m_reg, float& alpha) {
  float pmax = p0[0];
#pragma unroll
  for (int r = 1; r < 16; ++r) pmax = fmaxf(pmax, p0[r]);
#pragma unroll
  for (int r = 0; r < 16; ++r) pmax = fmaxf(pmax, p1[r]);
  { auto rr = __builtin_amdgcn_permlane32_swap(__float_as_uint(pmax), __float_as_uint(pmax), false, false);
    pmax = fmaxf(__uint_as_float(rr[0]), __uint_as_float(rr[1])); }
  float mn;
  if (THR2 > 0 && __builtin_expect(__all(pmax - m_reg <= (float)THR2), 1)) { mn = m_reg; alpha = 1.f; }
  else { mn = fmaxf(m_reg, pmax); alpha = __builtin_amdgcn_exp2f(m_reg - mn); m_reg = mn; }
#pragma unroll
  for (int r = 0; r < 16; ++r) p0[r] = p0[r] - mn;
#pragma unroll
  for (int r = 0; r < 16; ++r) p1[r] = p1[r] - mn;
#pragma unroll
  for (int r = 0; r < 16; ++r) p0[r] = __builtin_amdgcn_exp2f(p0[r]);
}
__device__ __forceinline__ void finishSM(f32x16& p0, f32x16& p1, float alpha, float& l_reg, bf16x8& pa0, bf16x8& pa1, bf16x8& pa2, bf16x8& pa3) {
#pragma unroll
  for (int r = 0; r < 16; ++r) p1[r] = __builtin_amdgcn_exp2f(p1[r]);
  float ps = 0;
#pragma unroll
  for (int r = 0; r < 16; ++r) ps += p0[r];
#pragma unroll
  for (int r = 0; r < 16; ++r) ps += p1[r];
  { auto rr = __builtin_amdgcn_permlane32_swap(__float_as_uint(ps), __float_as_uint(ps), false, false);
    ps = __uint_as_float(rr[0]) + __uint_as_float(rr[1]); }
  l_reg = l_reg * alpha + ps;
#define PK4(P, BASE, OUT) do { unsigned a0 = cvtpk(P[BASE + 0], P[BASE + 1]), a1 = cvtpk(P[BASE + 2], P[BASE + 3]);   \
    unsigned b0 = cvtpk(P[BASE + 4], P[BASE + 5]), b1 = cvtpk(P[BASE + 6], P[BASE + 7]);                              \
    auto r0 = __builtin_amdgcn_permlane32_swap(a0, b0, false, false); auto r1 = __builtin_amdgcn_permlane32_swap(a1, b1, false, false); \
    u32x4 w = {r0[0], r1[0], r0[1], r1[1]}; OUT = *reinterpret_cast<bf16x8*>(&w); } while (0)
  PK4(p0, 0, pa0); PK4(p0, 8, pa1); PK4(p1, 0, pa2); PK4(p1, 8, pa3);
#undef PK4
}
template <int NPE>
__device__ __forceinline__ void qkt(f32x16& p0, f32x16& p1, const char* Kn, const char* Kp, const bf16x8* qr, const char* qpe, int r32, int hi) {
  p0 = f32x16{}; p1 = f32x16{};
#pragma unroll
  for (int d0 = 0; d0 < 8; ++d0) { const int cb = (d0 * 16 + hi * 8) * 2;
    bf16x8 b0 = *reinterpret_cast<const bf16x8*>(Kn + KSWZ(r32, cb));
    bf16x8 b1 = *reinterpret_cast<const bf16x8*>(Kn + KSWZ(32 + r32, cb));
    p0 = __builtin_amdgcn_mfma_f32_32x32x16_bf16(b0, qr[d0], p0, 0, 0, 0);
    p1 = __builtin_amdgcn_mfma_f32_32x32x16_bf16(b1, qr[d0], p1, 0, 0, 0); }
#pragma unroll
  for (int d0 = 0; d0 < NPE; ++d0) { const int cb = (d0 * 16 + hi * 8) * 2;
    bf16x8 b0 = *reinterpret_cast<const bf16x8*>(Kp + KPSWZ(r32, cb));
    bf16x8 b1 = *reinterpret_cast<const bf16x8*>(Kp + KPSWZ(32 + r32, cb));
    p0 = __builtin_amdgcn_mfma_f32_32x32x16_bf16(b0, qr[8 + d0], p0, 0, 0, 0);
    p1 = __builtin_amdgcn_mfma_f32_32x32x16_bf16(b1, qr[8 + d0], p1, 0, 0, 0); }
}
__device__ __forceinline__ int v_st(int k, int c) { const int kk = (k & ~0xC) | ((k & 4) << 1) | ((k & 8) >> 1); return ((kk >> 3) * 4 + (c >> 5)) * 512 + ((kk & 7) * 32 + (c & 31)) * 2; }
__device__ __forceinline__ int v_rd_base(int lane) { return ((lane & 3) << 3) | (((lane >> 2) & 3) << 6) | (((lane >> 4) & 1) << 5) | (((lane >> 5) & 1) << 8); }
constexpr int v_rd_off(int d0, int ks, int half) { return d0 * 512 + ks * 4096 + half * 2048; }
template <int OFF> __device__ __forceinline__ s16x4 tr_read(int vb) {
  s16x4 r; asm volatile("ds_read_b64_tr_b16 %0, %1 offset:%2" : "=&v"(r) : "v"(vb), "i"(OFF) : "memory"); return r;
}
template <int D0> __device__ __forceinline__ void pv_one(f32x16& od, int vb, bf16x8 pa0, bf16x8 pa1, bf16x8 pa2, bf16x8 pa3) {
  const s16x4 l0 = tr_read<v_rd_off(D0, 0, 0)>(vb), h0 = tr_read<v_rd_off(D0, 0, 1)>(vb), l1 = tr_read<v_rd_off(D0, 1, 0)>(vb), h1 = tr_read<v_rd_off(D0, 1, 1)>(vb);
  const s16x4 l2 = tr_read<v_rd_off(D0, 2, 0)>(vb), h2 = tr_read<v_rd_off(D0, 2, 1)>(vb), l3 = tr_read<v_rd_off(D0, 3, 0)>(vb), h3 = tr_read<v_rd_off(D0, 3, 1)>(vb);
  asm volatile("s_waitcnt lgkmcnt(0)" ::: "memory"); SBAR();
#define PK(L, H) (bf16x8){L[0], L[1], L[2], L[3], H[0], H[1], H[2], H[3]}
  od = __builtin_amdgcn_mfma_f32_32x32x16_bf16(pa0, PK(l0, h0), od, 0, 0, 0);
  od = __builtin_amdgcn_mfma_f32_32x32x16_bf16(pa1, PK(l1, h1), od, 0, 0, 0);
  od = __builtin_amdgcn_mfma_f32_32x32x16_bf16(pa2, PK(l2, h2), od, 0, 0, 0);
  od = __builtin_amdgcn_mfma_f32_32x32x16_bf16(pa3, PK(l3, h3), od, 0, 0, 0);
#undef PK
}
__device__ __forceinline__ void pv_d0(f32x16* o, int vb, bf16x8 pa0, bf16x8 pa1, bf16x8 pa2, bf16x8 pa3) {
  pv_one<0>(o[0], vb, pa0, pa1, pa2, pa3); pv_one<1>(o[1], vb, pa0, pa1, pa2, pa3); pv_one<2>(o[2], vb, pa0, pa1, pa2, pa3); pv_one<3>(o[3], vb, pa0, pa1, pa2, pa3);
}
#define RESC(a) do { if (__any((a) < 1.f)) { if (hi == 0) al_l[r32] = (a); asm volatile("s_waitcnt lgkmcnt(0)" ::: "memory"); \
    _Pragma("unroll") for (int d = 0; d < 4; ++d) _Pragma("unroll") for (int r = 0; r < 16; ++r) o[d][r] *= al_l[crow(r, hi)]; } } while (0)

#define LAS3 __attribute__((address_space(3)))
__device__ __forceinline__ void mla_unit(const bf16_t* __restrict__ Qb, const bf16_t* __restrict__ Kh, const bf16_t* __restrict__ Vh, const bf16_t* __restrict__ Kpe,
                                         const bf16_t* __restrict__ Gb, bf16_t* __restrict__ Ob, char* lds, LAS3 unsigned char* ldsl) {
  constexpr int LDQ = 3072, LDK = 4096, LDO = 2048, NT = SEQ / KVBLK;
  constexpr int STG = 40960, O_V = 0, O_KN = 16384, O_KP = 32768, M_WS = 3 * STG;
  const int tid = opaque_tid(), wid = __builtin_amdgcn_readfirstlane(tid >> 6), lane = tid & 63, r32 = lane & 31, hi = lane >> 5;
  float* ws = (float*)(lds + M_WS) + wid * 64; float* li_l = ws; float* al_l = ws + 32;
  float m_reg = -1e30f, l_reg = 0; f32x16 o[4] = {}; bf16x8 qr[12];
  const bf16_t* Qw = Qb + (long)(wid * QBLK + r32) * LDQ + hi * 8;
#pragma unroll
  for (int d0 = 0; d0 < 12; ++d0) qr[d0] = ld8(Qw + d0 * 16);
  char* qpe = lds + M_QPE + wid * 4096 + lane * 16;
  (void)qpe;
  asm volatile("s_waitcnt vmcnt(0)" ::: "memory"); SBAR();
  int vsrc[2], ksrc[2], psrc;
#pragma unroll
  for (int i = 0; i < 2; ++i) { const int c = wid + 8 * i;
    { const int sub = c * 2 + (lane >> 5), kk = (sub >> 2) * 8 + ((lane & 31) >> 2), k = (kk & ~0xC) | ((kk & 4) << 1) | ((kk & 8) >> 1); vsrc[i] = k * LDK + (sub & 3) * 32 + (lane & 3) * 8; }
    { const int row = c * 4 + (lane >> 4), colB = ((lane & 15) * 16) ^ ((row & 15) << 4); ksrc[i] = row * LDK + (colB >> 1); } }
  { const int row = wid * 8 + (lane >> 3), colB = ((lane & 7) * 16) ^ (((row >> 1) & 7) << 4); psrc = row * 64 + (colB >> 1); }
#define DMA16(gptr, ldsoff) __builtin_amdgcn_global_load_lds((const unsigned*)(gptr), (LAS3 unsigned*)(ldsl + (ldsoff)), 16, 0, 0)
#define ISSUE_K(t, s) do { const bf16_t* kb_ = Kh + (long)(t) * (KVBLK * LDK); DMA16(kb_ + ksrc[0], (s) * STG + O_KN + wid * 1024); DMA16(kb_ + ksrc[1], (s) * STG + O_KN + (wid + 8) * 1024); \
    DMA16(Kpe + (long)(t) * (KVBLK * 64) + psrc, (s) * STG + O_KP + wid * 1024); } while (0)
#define ISSUE_V(t, s) do { const bf16_t* vb_ = Vh + (long)(t) * (KVBLK * LDK); DMA16(vb_ + vsrc[0], (s) * STG + O_V + wid * 1024); DMA16(vb_ + vsrc[1], (s) * STG + O_V + (wid + 8) * 1024); } while (0)
#define WAITBAR(N) do { asm volatile("s_waitcnt vmcnt(" #N ") lgkmcnt(0)" ::: "memory"); __builtin_amdgcn_s_barrier(); asm volatile("" ::: "memory"); } while (0)
  const int vb0 = (int)(uintptr_t)lds + O_V + v_rd_base(lane);
  f32x16 pA0, pA1, pB0, pB1; float alA, alB; bf16x8 pa0, pa1, pa2, pa3;
  int s0 = 0, s1 = 1, s2 = 2;
#define ROT() do { const int t_ = s0; s0 = s1; s1 = s2; s2 = t_; } while (0)
  ISSUE_K(0, 0); ISSUE_V(0, 0); ISSUE_K(1, 1);
  WAITBAR(3);
  ISSUE_K(2, s2); ISSUE_V(1, s1);
  qkt<4>(pA0, pA1, lds + s0 * STG + O_KN, lds + s0 * STG + O_KP, qr, qpe, r32, hi); partialSM<11>(pA0, pA1, m_reg, alA);
  WAITBAR(5); ROT();
#define STEP(PX0, PX1, ALX, PY0, PY1, ALY, j_) do { const bool ik_ = (j_) + 2 < NT, iv_ = (j_) + 1 < NT; \
    if (ik_) ISSUE_K((j_) + 2, s2); if (iv_) ISSUE_V((j_) + 1, s1); \
    SBAR(); qkt<4>(PX0, PX1, lds + s0 * STG + O_KN, lds + s0 * STG + O_KP, qr, qpe, r32, hi); \
    finishSM(PY0, PY1, ALY, l_reg, pa0, pa1, pa2, pa3); SBAR(); \
    pv_d0(o, vb0 + s2 * STG, pa0, pa1, pa2, pa3); partialSM<11>(PX0, PX1, m_reg, ALX); \
    RESC(ALX); \
    if (ik_) WAITBAR(5); else WAITBAR(0); ROT(); } while (0)
  for (int j = 1; j + 1 < NT; j += 2) {
    STEP(pB0, pB1, alB, pA0, pA1, alA, j);
    STEP(pA0, pA1, alA, pB0, pB1, alB, j + 1);
  }
  STEP(pB0, pB1, alB, pA0, pA1, alA, NT - 1);
  finishSM(pB0, pB1, alB, l_reg, pa0, pa1, pa2, pa3); SBAR();
  pv_d0(o, vb0 + s2 * STG, pa0, pa1, pa2, pa3);
  if (hi == 0) li_l[r32] = l_reg; asm volatile("s_waitcnt lgkmcnt(0)" ::: "memory");
  float rli[16];
#pragma unroll
  for (int r = 0; r < 16; ++r) rli[r] = __builtin_amdgcn_rcpf(li_l[crow(r, hi)]);
  __syncthreads();
  const bf16_t* Gw = Gb + (long)(wid * QBLK) * LDP;
  { bf16_t* stg = (bf16_t*)(lds + wid * 8704);
#pragma unroll
    for (int r = 0; r < 16; ++r) { const int orow = crow(r, hi);
#pragma unroll
      for (int d0 = 0; d0 < 4; ++d0) { const float ov = o[d0][r] * rli[r]; stg[orow * 136 + d0 * 32 + r32] = (bf16_t)(cvtpk(ov, ov) & 0xffffu); } }
    asm volatile("s_waitcnt lgkmcnt(0)" ::: "memory");
    int lz = lane; asm volatile("" : "+v"(lz));
#pragma unroll
    for (int i = 0; i < 8; ++i) { const int id = i * 64 + lz, row = id >> 4, c = (id & 15) * 8;
      const u32x4 ov = *(const u32x4*)(stg + row * 136 + c); const u32x4 gv = *(const u32x4*)(Gw + (long)row * LDP + c);
#define PLO(k) (__uint_as_float(ov[k] << 16) * __uint_as_float(gv[k] << 16) * A_SC)
#define PHI(k) (__uint_as_float(ov[k] & 0xffff0000u) * __uint_as_float(gv[k] & 0xffff0000u) * A_SC)
      typedef int i32x2 __attribute__((ext_vector_type(2)));
      *(i32x2*)((unsigned char*)Ob + (long)(wid * QBLK + row) * LDO + c) = (i32x2){pg8::cvt4_fp8(PLO(0), PHI(0), PLO(1), PHI(1)), pg8::cvt4_fp8(PLO(2), PHI(2), PLO(3), PHI(3))}; } }
#undef PLO
#undef PHI
  __syncthreads();
#undef DMA16
#undef ISSUE_K
#undef ISSUE_V
#undef WAITBAR
#undef ROT
#undef STEP
}

__device__ __forceinline__ void dswa_unit(int H, int rs, int qb, const bf16_t* __restrict__ proj, const float* __restrict__ bias2, bf16_t* __restrict__ Od, float* __restrict__ lse, char* lds) {
  const int g = H >> 3, dil = 1 << (2 * g), L = SEQ / dil, Q0 = qb * 256, T0 = Q0 - 64;
  const int tid = opaque_tid(), wid = tid >> 6, lane = tid & 63, r32 = lane & 31, hi = lane >> 5;
  char* V_lds = lds + OFF_V; char* Kn_lds = lds + OFF_KN;
  float* ws = (float*)(lds + OFF_WS) + wid * 64; float* li_l = ws; float* al_l = ws + 32;
  float* bl = (float*)(lds + OFF_BIAS);
  const bf16_t* Qp = proj + C_DQ + H * 128; const bf16_t* Kp = proj + C_DK + H * 128; const bf16_t* Vp = proj + C_DV + H * 128;
  if (tid < 129) bl[tid] = bias2[(g * 8 + (H & 7)) * 129 + tid];
  const int qa = Q0 + wid * QBLK, qi = qa + r32;
  bf16x8 qr[8];
  { const bf16_t* Qw = Qp + (size_t)(qi * dil + rs) * LDP + hi * 8;
#pragma unroll
    for (int d0 = 0; d0 < 8; ++d0) qr[d0] = ld8(Qw + d0 * 16); }
  const int sr = tid >> 4, sc = (tid & 15) * 8, vst0 = v_st(sr, sc), vst1 = v_st(32 + sr, sc);
  const int vb0 = (int)(uintptr_t)V_lds + v_rd_base(lane);
  float m_reg = -1e29f, l_reg = 0.f; f32x16 o[4] = {};
  const int tlo = (Q0 == 0) ? 1 : 0, thi = (Q0 + 256 >= L) ? 5 : 6;
  bf16x8 vs0, vs1, ks0, ks1;
#define DLOAD(t_) do { const int k0_ = T0 + 64 * (t_); int i0 = k0_ + sr, i1 = k0_ + 32 + sr; i0 = i0 < 0 ? 0 : (i0 >= L ? L - 1 : i0); i1 = i1 < 0 ? 0 : (i1 >= L ? L - 1 : i1); \
    const size_t o0 = (size_t)(i0 * dil + rs) * LDP + sc, o1 = (size_t)(i1 * dil + rs) * LDP + sc; vs0 = ld8(Vp + o0); vs1 = ld8(Vp + o1); ks0 = ld8(Kp + o0); ks1 = ld8(Kp + o1); } while (0)
  DLOAD(tlo);
  for (int t = tlo; t < thi; ++t) {
    const int k0 = T0 + 64 * t;
    __syncthreads();
    *(bf16x8*)(V_lds + vst0) = vs0; *(bf16x8*)(V_lds + vst1) = vs1;
    *(bf16x8*)(Kn_lds + KSWZ(sr, sc * 2)) = ks0; *(bf16x8*)(Kn_lds + KSWZ(32 + sr, sc * 2)) = ks1;
    __syncthreads();
    if (t + 1 < thi) DLOAD(t + 1);
    if (k0 > qa + 31 + 64 || k0 + 63 < qa - 64) continue;
    f32x16 p0, p1; qkt<0>(p0, p1, Kn_lds, Kn_lds, qr, Kn_lds, r32, hi);
#pragma unroll
    for (int r = 0; r < 16; ++r) { const int kj = k0 + crow(r, hi), dj = kj - qi; int bi = dj + 64; bi = bi < 0 ? 0 : (bi > 128 ? 128 : bi);
      const int kj1 = kj + 32, dj1 = dj + 32; int bi1 = dj1 + 64; bi1 = bi1 < 0 ? 0 : (bi1 > 128 ? 128 : bi1);
      const bool ok0 = (dj >= -64) && (dj <= 64) && (kj >= 0) && (kj < L), ok1 = (dj1 >= -64) && (dj1 <= 64) && (kj1 >= 0) && (kj1 < L);
      p0[r] = ok0 ? p0[r] + bl[bi] : -1e30f; p1[r] = ok1 ? p1[r] + bl[bi1] : -1e30f; }
    float al; partialSM<0>(p0, p1, m_reg, al);
    bf16x8 pa0, pa1, pa2, pa3; finishSM(p0, p1, al, l_reg, pa0, pa1, pa2, pa3);
    RESC(al);
    SBAR(); pv_d0(o, vb0, pa0, pa1, pa2, pa3);
  }
#undef DLOAD
  if (hi == 0) li_l[r32] = l_reg; asm volatile("s_waitcnt lgkmcnt(0)" ::: "memory");
  float rli[16];
#pragma unroll
  for (int r = 0; r < 16; ++r) rli[r] = __builtin_amdgcn_rcpf(li_l[crow(r, hi)]);
  const int hh = H & 7;
  bf16_t* Og = Od + (size_t)g * SEQ * 1024 + hh * 128;
#pragma unroll
  for (int r = 0; r < 16; ++r) { const size_t pos = (size_t)(qa + crow(r, hi)) * dil + rs;
#pragma unroll
    for (int d0 = 0; d0 < 4; ++d0) { const float ov = o[d0][r] * rli[r]; Og[pos * 1024 + d0 * 32 + r32] = (bf16_t)(cvtpk(ov, ov) & 0xffffu); } }
  if (hi == 0) lse[((size_t)g * SEQ + (size_t)qi * dil + rs) * 8 + hh] = m_reg + __builtin_amdgcn_logf(l_reg);
  __syncthreads();
}
#undef RESC
#undef KSWZ
#undef KPSWZ
#undef SBAR
}

#define LAS __attribute__((address_space(3)))
typedef unsigned short bf16;
typedef unsigned v4u __attribute__((ext_vector_type(4)));
typedef float f32x4 __attribute__((ext_vector_type(4)));
constexpr int NWAVES = 8;
constexpr size_t MiB = 1u << 20;
constexpr size_t WS_RSSQ = 0, WS_RSSKV = 32768, WS_STATS = 65536, WS_BIAS2 = 131072, WS_LSE = 262144;
constexpr size_t WS_ROPE = 2 * MiB;
constexpr size_t WS_WIN = 4 * MiB, WS_WQB = 178 * MiB, WS_WKVB = 184 * MiB, WS_WOMLA = 188 * MiB, WS_WODSWA = 204 * MiB, WS_WOUT = 212 * MiB;
constexpr size_t WS_H = 244 * MiB, WS_PROJ = 308 * MiB, WS_QMLA = 656 * MiB, WS_KVMLA = 704 * MiB, WS_KPE = 768 * MiB, WS_AMLA = 770 * MiB;
constexpr size_t WS_ODSWA = 802 * MiB, WS_BDSWA = 850 * MiB, WS_T = 866 * MiB, WS_END = 930 * MiB;
static_assert(WS_WIN + (size_t)LDP * 4096 * 2 <= WS_WQB && WS_PROJ + (size_t)SEQ * LDP * 2 <= WS_QMLA && WS_LSE + 3 * SEQ * 8 * 4 <= WS_ROPE, "d_ws map");
constexpr int LDS_BYTES = 163840;

__device__ __forceinline__ unsigned f2bf(float f) { unsigned u = __builtin_bit_cast(unsigned, f); return (u + 0x7fffu + ((u >> 16) & 1u)) >> 16; }
__device__ __forceinline__ unsigned pk2(float lo, float hi) { return f2bf(lo) | (f2bf(hi) << 16); }
__device__ __forceinline__ float wave_sum(float v) {
#pragma unroll
    for (int o = 1; o < 64; o <<= 1) v += __shfl_xor(v, o);
    return v;
}
__device__ __forceinline__ void transpose_item(const float* __restrict__ W, int K, int N, bf16* __restrict__ WT, int k0, int n0, int dbase, int dstride, const float* __restrict__ kscale, LAS float* scr, int lane) {
    float wv[32];
#pragma unroll
    for (int i = 0; i < 32; ++i) { const int kk = 2 * i + (lane >> 5); wv[i] = __builtin_nontemporal_load(W + (size_t)(k0 + kk) * N + n0 + (lane & 31)); }
#pragma unroll
    for (int i = 0; i < 32; ++i) { const int kk = 2 * i + (lane >> 5); float w = wv[i]; if (kscale) w *= kscale[k0 + kk]; scr[kk * 33 + (lane & 31)] = w; }
    asm volatile("s_waitcnt lgkmcnt(0)" ::: "memory");
    const int c = lane & 7;
#pragma unroll
    for (int j = 0; j < 4; ++j) { const int n = (lane >> 3) + 8 * j; const LAS float* s = scr + (8 * c) * 33 + n;
        v4u o; o.x = pk2(s[0 * 33], s[1 * 33]); o.y = pk2(s[2 * 33], s[3 * 33]); o.z = pk2(s[4 * 33], s[5 * 33]); o.w = pk2(s[6 * 33], s[7 * 33]);
        *(v4u*)(WT + (size_t)(dbase + dstride * n) * K + k0 + 8 * c) = o; }
    asm volatile("s_waitcnt lgkmcnt(0)" ::: "memory");
}

#define REP0 1
#define REP1 1
#define REP2 1
#define REP3 1
#define REP4 1
#define REP5 1
constexpr float H_SC = 16.f, W_SC = 1024.f;
__device__ __forceinline__ void transpose_item8(const float* __restrict__ W, int K, int N, unsigned char* __restrict__ WT, int k0, int n0, int dbase, int dstride, float wsc, LAS float* scr, int lane) {
    float wv[32];
#pragma unroll
    for (int i = 0; i < 32; ++i) { const int kk = 2 * i + (lane >> 5); wv[i] = __builtin_nontemporal_load(W + (size_t)(k0 + kk) * N + n0 + (lane & 31)); }
#pragma unroll
    for (int i = 0; i < 32; ++i) { const int kk = 2 * i + (lane >> 5); scr[kk * 33 + (lane & 31)] = wv[i] * wsc; }
    asm volatile("s_waitcnt lgkmcnt(0)" ::: "memory");
    const int c = lane & 7;
#pragma unroll
    for (int j = 0; j < 4; ++j) { const int n = (lane >> 3) + 8 * j; const LAS float* s = scr + (8 * c) * 33 + n;
        int d0 = __builtin_amdgcn_cvt_pk_fp8_f32(s[0 * 33], s[1 * 33], 0, false); d0 = __builtin_amdgcn_cvt_pk_fp8_f32(s[2 * 33], s[3 * 33], d0, true);
        int d1 = __builtin_amdgcn_cvt_pk_fp8_f32(s[4 * 33], s[5 * 33], 0, false); d1 = __builtin_amdgcn_cvt_pk_fp8_f32(s[6 * 33], s[7 * 33], d1, true);
        typedef int i32x2 __attribute__((ext_vector_type(2)));
        *(i32x2*)(WT + (size_t)(dbase + dstride * n) * K + k0 + 8 * c) = (i32x2){d0, d1}; }
    asm volatile("s_waitcnt lgkmcnt(0)" ::: "memory");
}
struct Args { const float* in[14]; float* out; unsigned char* ws; };

__global__ void __launch_bounds__(NWAVES * 64, 2) fwd_mega(Args a) {
    extern __shared__ __attribute__((aligned(16))) unsigned char lds[];
    cg::grid_group grid = cg::this_grid();
    const int G = gridDim.x, bx = blockIdx.x, vcu = (G % 8 == 0) ? (bx % 8) * (G / 8) + bx / 8 : bx;
    LAS unsigned char* ldsl = (LAS unsigned char*)lds;
    unsigned char* ws = a.ws;
    const float* x = a.in[0]; const float* emb_g = a.in[1]; const float* emb_b = a.in[2]; const float* rel_bias = a.in[3]; const float* w_in = a.in[4];
    const float* qa_g = a.in[5]; const float* w_qb = a.in[6]; const float* kva_g = a.in[7]; const float* w_kvb = a.in[8]; const float* w_omla = a.in[9];
    const float* w_odswa = a.in[10]; const float* w_out = a.in[11]; const float* ln_g = a.in[12]; const float* ln_b = a.in[13];
    float* rss_q = (float*)(ws + WS_RSSQ); float* rss_kv = (float*)(ws + WS_RSSKV); float* stats = (float*)(ws + WS_STATS); float* bias2 = (float*)(ws + WS_BIAS2);
    float* lse = (float*)(ws + WS_LSE); float* rope = (float*)(ws + WS_ROPE);
    bf16* Win_t = (bf16*)(ws + WS_WIN); bf16* Wqb_t = (bf16*)(ws + WS_WQB); bf16* Wkvb_t = (bf16*)(ws + WS_WKVB); bf16* Womla_t = (bf16*)(ws + WS_WOMLA);
    bf16* Wodswa_t = (bf16*)(ws + WS_WODSWA); bf16* Wout_t = (bf16*)(ws + WS_WOUT);
    bf16* Hb = (bf16*)(ws + WS_H); bf16* proj = (bf16*)(ws + WS_PROJ); bf16* Qmla = (bf16*)(ws + WS_QMLA); bf16* KVmla = (bf16*)(ws + WS_KVMLA); bf16* Kpe = (bf16*)(ws + WS_KPE);
    bf16* Amla = (bf16*)(ws + WS_AMLA); bf16* Odswa = (bf16*)(ws + WS_ODSWA); bf16* Bdswa = (bf16*)(ws + WS_BDSWA); bf16* Tm = (bf16*)(ws + WS_T); unsigned char* T8 = ws + WS_H + 32 * MiB;
    const int NGW = G * NWAVES, NGT = G * NWAVES * 64;
#define PHASE_IDS() const int tid = opaque_tid(), lane = tid & 63, wave = __builtin_amdgcn_readfirstlane(tid >> 6), gw = vcu * NWAVES + wave, gt = bx * (NWAVES * 64) + tid; (void)lane; (void)gw; (void)gt

    for (int rep = 0; rep < REP0; ++rep) {
        PHASE_IDS();
        LAS float* scr = (LAS float*)(ldsl + wave * 16384);
        constexpr int I_IN = 64 * 690, I_QB = 16 * 96, I_KVB = 8 * 128, I_OM = 32 * 128, I_OD = 16 * 128, I_OUT = 64 * 128;
        constexpr int NITEMS = I_IN + I_QB + I_KVB + I_OM + I_OD + I_OUT;
        for (int it = gw; it < NITEMS; it += NGW) {
            int r = it;
            if (r < I_IN) { const int kb = r / 690, nb = r % 690; int db, ds; if (nb < 48) { db = nb * 32; ds = 1; } else if (nb == 48) { db = C_KPE; ds = 2; } else if (nb == 49) { db = C_KPE + 1; ds = 2; } else { db = nb * 32 - 64; ds = 1; }
                transpose_item8(w_in, 4096, IN_W, (unsigned char*)Win_t, kb * 64, nb * 32, db, ds, W_SC, scr, lane); continue; } r -= I_IN;
            if (r < I_QB) { const int kb = r / 96, nb = r % 96, hq = nb / 6, bi = nb % 6; int db, ds; if (bi < 4) { db = hq * 192 + bi * 32; ds = 1; } else { db = hq * 192 + 128 + (bi - 4); ds = 2; }
                transpose_item(w_qb, 1024, 3072, Wqb_t, kb * 64, nb * 32, db, ds, qa_g, scr, lane); continue; } r -= I_QB;
            if (r < I_KVB) { const int kb = r / 128, nb = r % 128; transpose_item(w_kvb, 512, 4096, Wkvb_t, kb * 64, nb * 32, nb * 32, 1, kva_g, scr, lane); continue; } r -= I_KVB;
            if (r < I_OM) { const int kb = r / 128, nb = r % 128; transpose_item8(w_omla, 2048, 4096, (unsigned char*)Womla_t, kb * 64, nb * 32, nb * 32, 1, W_OM_SC, scr, lane); continue; } r -= I_OM;
            if (r < I_OD) { const int kb = r / 128, nb = r % 128; transpose_item8(w_odswa, 1024, 4096, (unsigned char*)Wodswa_t, kb * 64, nb * 32, nb * 32, 1, W_OD_SC, scr, lane); continue; } r -= I_OD;
            { const int kb = r / 128, nb = r % 128; transpose_item8(w_out, 4096, 4096, (unsigned char*)Wout_t, kb * 64, nb * 32, nb * 32, 1, W_OUT_SC, scr, lane); }
        }
        for (int m = gw; m < SEQ; m += NGW) {
            const f32x4* xr = (const f32x4*)(x + (size_t)m * DM) + lane;
            f32x4 v[16]; float s = 0.f;
#pragma unroll
            for (int j = 0; j < 16; ++j) { v[j] = xr[64 * j]; s += (v[j].x + v[j].y) + (v[j].z + v[j].w); }
            const float mean = wave_sum(s) * (1.f / DM); float s2 = 0.f;
#pragma unroll
            for (int j = 0; j < 16; ++j) { v[j] = v[j] - mean; s2 += (v[j].x * v[j].x + v[j].y * v[j].y) + (v[j].z * v[j].z + v[j].w * v[j].w); }
            const float rstd = 1.f / sqrtf(wave_sum(s2) * (1.f / DM) + LN_EPS);
            if (lane == 0) { stats[2 * m] = mean; stats[2 * m + 1] = rstd; }
            int* o4 = (int*)((unsigned char*)Hb + (size_t)m * DM) + lane;
#pragma unroll
            for (int j = 0; j < 16; ++j) { const f32x4 gv = ((const f32x4*)emb_g)[64 * j + lane], bv = ((const f32x4*)emb_b)[64 * j + lane]; const f32x4 y = (v[j] * rstd * gv + bv) * H_SC;
                int d = __builtin_amdgcn_cvt_pk_fp8_f32(y.x, y.y, 0, false); d = __builtin_amdgcn_cvt_pk_fp8_f32(y.z, y.w, d, true); o4[64 * j] = d; }
        }
        for (int e = gt; e < SEQ * 32; e += NGT) { const int pos = e >> 5, i = e & 31; const float invf = 1.0f / powf(10000.0f, (float)(2 * i) / 64.0f); const float ang = (float)pos * invf;
            double t = (double)ang * 0.15915494309189535; t -= __builtin_floor(t); const float tf = (float)t;
            rope[2 * e] = __builtin_amdgcn_cosf(tf); rope[2 * e + 1] = __builtin_amdgcn_sinf(tf); }
        for (int e = gt; e < 3 * 8 * 129; e += NGT) { const int j = e % 129 - 64, hh = (e / 129) % 8, g = e / (129 * 8), dil = 1 << (2 * g); const int rel = j * dil, n = rel < 0 ? -rel : rel;
            int bk; if (n < 8) bk = n; else { const float nf = (float)n; int lg = 8 + (int)(logf(nf / 8.f) / 4.852030263919617f * 8.f); bk = lg < 15 ? lg : 15; }
            if (rel > 0) bk += 16;
            bias2[e] = rel_bias[bk * 24 + g * 8 + hh] * LOG2E; }
        for (int e = gt; e < 2 * SEQ; e += NGT) rss_q[e] = 0.f;
    }
    grid.sync();

    for (int rep = 0; rep < REP1; ++rep) {
        pg8::Gemm g{Hb, Win_t, SEQ, LDP, 2048, 2048, 2048}; pg8::StaticOrder S; S.init(SEQ, LDP, G, bx);
        pg8::EpiProj E{proj, Kpe, rep ? nullptr : rss_q, rep ? nullptr : rss_kv, rope, 1.f / (H_SC * W_SC)};
        pg8::gemm_phase<pg8::EpiProj, pg8::StaticOrder, true, true, true>(ldsl, g, S, E);
    }
    grid.sync();

    for (int rep = 0; rep < REP2; ++rep) {
        { pg8::Gemm g{proj + C_QA, Wqb_t, SEQ, 3072, 1024, LDP, 1024}; pg8::StaticOrder S; S.init(SEQ, 3072, G, bx);
          pg8::EpiQ E{Qmla, rss_q, rope}; pg8::gemm_phase<pg8::EpiQ, pg8::StaticOrder, true, true>(ldsl, g, S, E); }
        { pg8::Gemm g{proj + C_CKV, Wkvb_t, SEQ, 4096, 512, LDP, 512}; pg8::StaticOrder S; S.init(SEQ, 4096, G, bx);
          pg8::EpiKV E{KVmla, rss_kv}; pg8::gemm_phase<pg8::EpiKV, pg8::StaticOrder, true, true>(ldsl, g, S, E); }
        __syncthreads();
        for (int u = vcu; u < 768; u += G) { const int H = u >> 5, rem = u & 31, g = H >> 3, nqb = 32 >> (2 * g); att::dswa_unit(H, rem / nqb, rem % nqb, proj, bias2, Odswa, lse, (char*)lds); }
    }
    grid.sync();

    for (int rep = 0; rep < REP3; ++rep) {
        for (int u = vcu; u < 512; u += G) { const int h = u >> 5, qb = u & 31; const size_t r0 = (size_t)qb * 256;
            att::mla_unit(Qmla + r0 * 3072 + h * 192, KVmla + h * 256, KVmla + h * 256 + 128, Kpe, proj + r0 * LDP + C_GMLA + h * 128, (bf16*)((unsigned char*)Amla + r0 * 2048 + h * 128), (char*)lds, ldsl); }
        PHASE_IDS();
        for (int it = gt; it < SEQ * 128; it += NGT) { const int pos = it >> 7, c8 = it & 127, hh = c8 >> 4, col = c8 * 8;
            const float l0 = lse[((size_t)0 * SEQ + pos) * 8 + hh], l1 = lse[((size_t)1 * SEQ + pos) * 8 + hh], l2 = lse[((size_t)2 * SEQ + pos) * 8 + hh];
            const float mx = fmaxf(l0, fmaxf(l1, l2)); float e0 = __builtin_amdgcn_exp2f(l0 - mx), e1 = __builtin_amdgcn_exp2f(l1 - mx), e2 = __builtin_amdgcn_exp2f(l2 - mx);
            const float inv = 1.f / (e0 + e1 + e2); e0 *= inv; e1 *= inv; e2 *= inv;
            const v4u a0 = *(const v4u*)(Odswa + ((size_t)0 * SEQ + pos) * 1024 + col), a1 = *(const v4u*)(Odswa + ((size_t)1 * SEQ + pos) * 1024 + col), a2 = *(const v4u*)(Odswa + ((size_t)2 * SEQ + pos) * 1024 + col);
            const v4u gg = *(const v4u*)(proj + (size_t)pos * LDP + C_GDSWA + col);
#define MLO(k) ((pg8::bflo(a0[k]) * e0 + pg8::bflo(a1[k]) * e1 + pg8::bflo(a2[k]) * e2) * pg8::bflo(gg[k]) * B_SC)
#define MHI(k) ((pg8::bfhi(a0[k]) * e0 + pg8::bfhi(a1[k]) * e1 + pg8::bfhi(a2[k]) * e2) * pg8::bfhi(gg[k]) * B_SC)
            *(pg8::i32x2*)((unsigned char*)Bdswa + (size_t)pos * 1024 + col) = (pg8::i32x2){pg8::cvt4_fp8(MLO(0), MHI(0), MLO(1), MHI(1)), pg8::cvt4_fp8(MLO(2), MHI(2), MLO(3), MHI(3))}; }
#undef MLO
#undef MHI
    }
    grid.sync();

    for (int rep = 0; rep < REP4; ++rep) {
        { pg8::Gemm g{Amla, Womla_t, SEQ, 4096, 1024, 1024, 1024}; pg8::StaticOrder S; S.init(SEQ, 4096, G, bx);
          pg8::EpiY<0> E{Tm, proj + C_RMLA, T8}; pg8::gemm_phase<pg8::EpiY<0>, pg8::StaticOrder, true, true, true>(ldsl, g, S, E); }
        { pg8::Gemm g{Bdswa, Wodswa_t, SEQ, 4096, 512, 512, 512}; pg8::StaticOrder S; S.init(SEQ, 4096, G, bx);
          pg8::EpiY<1> E{Tm, proj + C_RDSWA, T8}; pg8::gemm_phase<pg8::EpiY<1>, pg8::StaticOrder, true, true, true>(ldsl, g, S, E); }
    }
    grid.sync();

    for (int rep = 0; rep < REP5; ++rep) {
        pg8::Gemm g{(const bf16*)T8, Wout_t, SEQ, 4096, 2048, 2048, 2048}; pg8::StaticOrder S; S.init(SEQ, 4096, G, bx);
        pg8::EpiOut E{x, stats, emb_g, emb_b, a.out, 1.f / (T_SC * W_OUT_SC)}; pg8::gemm_phase<pg8::EpiOut, pg8::StaticOrder, true, true, true>(ldsl, g, S, E);
    }
    grid.sync();

    { PHASE_IDS();
    for (int m = gw; m < SEQ; m += NGW) {
        f32x4* xr = (f32x4*)(a.out + (size_t)m * DM) + lane;
        f32x4 v[16]; float s = 0.f;
#pragma unroll
        for (int j = 0; j < 16; ++j) { v[j] = xr[64 * j]; s += (v[j].x + v[j].y) + (v[j].z + v[j].w); }
        const float mean = wave_sum(s) * (1.f / DM); float s2 = 0.f;
#pragma unroll
        for (int j = 0; j < 16; ++j) { v[j] = v[j] - mean; s2 += (v[j].x * v[j].x + v[j].y * v[j].y) + (v[j].z * v[j].z + v[j].w * v[j].w); }
        const float rstd = 1.f / sqrtf(wave_sum(s2) * (1.f / DM) + LN_EPS);
#pragma unroll
        for (int j = 0; j < 16; ++j) { const f32x4 gv = ((const f32x4*)ln_g)[64 * j + lane], bv = ((const f32x4*)ln_b)[64 * j + lane]; xr[64 * j] = v[j] * rstd * gv + bv; }
    } }
}

extern "C" void kernel_launch(void* const* d_in, const int* in_sizes, int n_in, void* d_out, int out_size, void* d_ws, size_t ws_size, hipStream_t stream) {
    static int grid = 0;
    if (grid == 0) {
        if (n_in != 14 || in_sizes[0] != SEQ * DM || out_size != SEQ * DM || ws_size < WS_END) { fprintf(stderr, "kernel_launch: unexpected shapes (n_in %d, in0 %d, out %d, ws %zu < %zu)\n", n_in, n_in > 0 ? in_sizes[0] : -1, out_size, ws_size, (size_t)WS_END); grid = -1; return; }
        int dev = 0, cus = 0, per_cu = 0;
        if (hipGetDevice(&dev) != hipSuccess || hipDeviceGetAttribute(&cus, hipDeviceAttributeMultiprocessorCount, dev) != hipSuccess) { grid = -1; return; }
        if (hipFuncSetAttribute((const void*)fwd_mega, hipFuncAttributeMaxDynamicSharedMemorySize, LDS_BYTES) != hipSuccess) { fprintf(stderr, "kernel_launch: hipFuncSetAttribute failed\n"); grid = -1; return; }
        if (hipOccupancyMaxActiveBlocksPerMultiprocessor(&per_cu, (const void*)fwd_mega, NWAVES * 64, LDS_BYTES) != hipSuccess || per_cu < 1) { fprintf(stderr, "kernel_launch: occupancy query says %d blocks per CU\n", per_cu); per_cu = 1; }
        (void)hipGetLastError();
        grid = cus;
    }
    if (grid < 0) return;
    Args a{};
    for (int i = 0; i < 14; ++i) a.in[i] = (const float*)d_in[i];
    a.out = (float*)d_out; a.ws = (unsigned char*)d_ws;
    void* args[] = {&a};
    hipError_t e = hipLaunchCooperativeKernel((const void*)fwd_mega, dim3(grid), dim3(NWAVES * 64), args, LDS_BYTES, stream);
    if (e != hipSuccess) fprintf(stderr, "kernel_launch: cooperative launch failed: %s (grid %d)\n", hipGetErrorString(e), grid);
}
```

```cpp
#include <hip/hip_runtime.h>
#include <hip/hip_cooperative_groups.h>
#include <cstdio>
#include <cstdint>
#include <cmath>
namespace cg = cooperative_groups;

constexpr int SEQ = 8192, DM = 4096;
constexpr int LDP = 22272;
constexpr int C_QA = 0, C_CKV = 1024, C_DQ = 1536, C_DK = 4608, C_DV = 7680, C_GMLA = 10752, C_GDSWA = 12800, C_RMLA = 13824, C_RDSWA = 17920, C_KPE = 22016;
constexpr int IN_W = 22080;
constexpr float LOG2E = 1.4426950408889634f;
constexpr float QS_D = 0.08838834764831845f * LOG2E;
constexpr float QS_M = 0.07216878364870323f * LOG2E;
constexpr float ALPHA = 1.189207115002721f;
constexpr float LN_EPS = 1e-5f, RMS_EPS = 1e-6f;
constexpr float Q8_SC = 64.f, K8_SC = 16.f;
constexpr float A_SC = 256.f, B_SC = 128.f, T_SC = 512.f, W_OM_SC = 1024.f, W_OD_SC = 1024.f, W_OUT_SC = 2048.f;

__device__ __forceinline__ int opaque_tid() { int t = threadIdx.x; asm volatile("" : "+v"(t)); return t; }

namespace pg8 {
#define PG8_LAS __attribute__((address_space(3)))
typedef unsigned short bf16_t;
typedef short bf16x8 __attribute__((ext_vector_type(8)));
typedef float f32x4 __attribute__((ext_vector_type(4)));
typedef unsigned u32x4 __attribute__((ext_vector_type(4)));
constexpr int BM = 256, BK = 64, HALF = 128, HTB = HALF * BK * 2  , STAGE_BYTES = 8 * HTB, NXCD = 8, WGM = 8;

__host__ __device__ __forceinline__ int lds_byte(int r, int c) { const int st = (r >> 4) * 2 + (c >> 5), rr = r & 15, cc = c & 31, ob = rr * 64 + cc * 2; return st * 1024 + (ob ^ (((ob >> 9) & 1) << 5)); }
__host__ __device__ __forceinline__ void stage_rc(int b, int& R, int& C) { const int st = b / 1024, sb = b % 1024, swz = sb ^ (((sb >> 9) & 1) << 5); R = (st >> 1) * 16 + swz / 64; C = (st & 1) * 32 + (swz % 64) / 2; }
__host__ __device__ __forceinline__ int perm32(int rho) { const int n = rho >> 4, i = rho & 15; return 8 * (i >> 2) + 4 * n + (i & 3); }

struct Unit { int pm, pn; };
struct Gemm { const bf16_t* A; const bf16_t* Bt; int M, N, K, lda, ldb; };

struct StaticOrder {
    int nM, nN, nwg, G, c;
    __host__ __device__ void init(int M, int N, int G_, int c_) { nM = M / BM; nN = N / BM; nwg = nM * nN; G = G_; c = c_; }
    __host__ __device__ bool next(int i, Unit& u) const {
        const long L = (long)i * G + c; if (L >= nwg) return false;
        int wgid = (int)L; { const int q = nwg / NXCD, r = nwg % NXCD, xcd = wgid % NXCD, off = wgid / NXCD; wgid = (xcd < r ? xcd * (q + 1) : r * (q + 1) + (xcd - r) * q) + off; }
        const int nig = WGM * nN, gid = wgid / nig, fm = gid * WGM, gsz = (nM - fm) < WGM ? (nM - fm) : WGM;
        u.pm = fm + ((wgid % nig) % gsz); u.pn = (wgid % nig) / gsz; return true;
    }
    __device__ __forceinline__ void a_ready(const Unit&) const {}
    __device__ __forceinline__ void done(const Unit&) const {}
};


typedef float f32x2 __attribute__((ext_vector_type(2))); typedef __bf16 bf16x2_t __attribute__((ext_vector_type(2)));
typedef int i32x4 __attribute__((ext_vector_type(4))); typedef int i32x8 __attribute__((ext_vector_type(8)));
__device__ __forceinline__ i32x8 cat8(bf16x8 a, bf16x8 b) { return __builtin_shufflevector(__builtin_bit_cast(i32x4, a), __builtin_bit_cast(i32x4, b), 0, 1, 2, 3, 4, 5, 6, 7); }
__device__ __forceinline__ unsigned cvt_pk_bf16(float lo, float hi) { f32x2 v = {lo, hi}; bf16x2_t b = __builtin_convertvector(v, bf16x2_t); return __builtin_bit_cast(unsigned, b); }
typedef int i32x2 __attribute__((ext_vector_type(2)));
__device__ __forceinline__ int cvt4_fp8(float a, float b, float c, float d) { a = __builtin_amdgcn_fmed3f(a, -440.f, 440.f); b = __builtin_amdgcn_fmed3f(b, -440.f, 440.f); c = __builtin_amdgcn_fmed3f(c, -440.f, 440.f); d = __builtin_amdgcn_fmed3f(d, -440.f, 440.f);
    int r = __builtin_amdgcn_cvt_pk_fp8_f32(a, b, 0, false); return __builtin_amdgcn_cvt_pk_fp8_f32(c, d, r, true); }
__device__ __forceinline__ float bflo(unsigned w) { return __uint_as_float(w << 16); }
__device__ __forceinline__ float bfhi(unsigned w) { return __uint_as_float(w & 0xffff0000u); }
__device__ __forceinline__ float sigm(float x) { return __builtin_amdgcn_rcpf(1.f + __builtin_amdgcn_exp2f(-x * 1.4426950408889634f)); }
__device__ __forceinline__ u32x4 pack8(const f32x4 v0, const f32x4 v1) { u32x4 w; w.x = cvt_pk_bf16(v0[0], v0[1]); w.y = cvt_pk_bf16(v0[2], v0[3]); w.z = cvt_pk_bf16(v1[0], v1[1]); w.w = cvt_pk_bf16(v1[2], v1[3]); return w; }
__device__ __forceinline__ void rope8(f32x4& v0, f32x4& v1, const f32x4 cs0, const f32x4 cs1) {
    const float a0 = v0[0] * cs0[0] - v0[1] * cs0[1], b0 = v0[1] * cs0[0] + v0[0] * cs0[1];
    const float a1 = v0[2] * cs0[2] - v0[3] * cs0[3], b1 = v0[3] * cs0[2] + v0[2] * cs0[3];
    const float a2 = v1[0] * cs1[0] - v1[1] * cs1[1], b2 = v1[1] * cs1[0] + v1[0] * cs1[1];
    const float a3 = v1[2] * cs1[2] - v1[3] * cs1[3], b3 = v1[3] * cs1[2] + v1[2] * cs1[3];
    v0 = (f32x4){a0, b0, a1, b1}; v1 = (f32x4){a2, b2, a3, b3};
}

struct EpiProj {
    static constexpr bool PERM = true, AFTER_DRAIN = false;
    bf16_t* proj; bf16_t* kpe; float* rss_q; float* rss_kv; const float* rope; float osc;
    template <int ACT> __device__ __forceinline__ void body(const f32x4 (&acc)[2][2][4][2], const Unit& u, int wr, int wc, int fr, int fq, float sc, float* rss) const {
        const int row0 = u.pm * BM + wr * 64 + fr, col0 = u.pn * BM + wc * 32 + 8 * fq;
#pragma unroll
        for (int ai = 0; ai < 2; ++ai)
#pragma unroll
            for (int m = 0; m < 4; ++m) { const int row = row0 + ai * HALF + m * 16; bf16_t* rowp = proj + (size_t)row * LDP + col0; float ss = 0.f;
#pragma unroll
                for (int bj = 0; bj < 2; ++bj) { f32x4 v0 = acc[ai][bj][m][0] * sc, v1 = acc[ai][bj][m][1] * sc;
                    if (ACT == 1) {
#pragma unroll
                        for (int e = 0; e < 4; ++e) { v0[e] = v0[e] * sigm(v0[e]); v1[e] = v1[e] * sigm(v1[e]); } }
                    if (ACT == 2) {
#pragma unroll
                        for (int e = 0; e < 4; ++e) { v0[e] = sigm(v0[e]); v1[e] = sigm(v1[e]); } }
                    if (ACT == 3) { ss += (v0[0] * v0[0] + v0[1] * v0[1]) + (v0[2] * v0[2] + v0[3] * v0[3]) + (v1[0] * v1[0] + v1[1] * v1[1]) + (v1[2] * v1[2] + v1[3] * v1[3]); }
                    *(u32x4*)(rowp + bj * HALF) = pack8(v0, v1); }
                if (ACT == 3) { ss += __shfl_xor(ss, 16); ss += __shfl_xor(ss, 32); if (fq == 0 && rss) atomicAdd(rss + row, ss); } }
    }
    __device__ __forceinline__ void operator()(const f32x4 (&acc)[2][2][4][2], const Unit& u, int wr, int wc, int fr, int fq) const {
        const int pn = u.pn;
        if (pn < 4) body<3>(acc, u, wr, wc, fr, fq, osc, rss_q);
        else if (pn < 6) body<3>(acc, u, wr, wc, fr, fq, osc, rss_kv);
        else if (pn < 42) body<0>(acc, u, wr, wc, fr, fq, pn < 18 ? QS_D * osc : osc, nullptr);
        else if (pn < 54) body<1>(acc, u, wr, wc, fr, fq, osc, nullptr);
        else if (pn < 86) body<2>(acc, u, wr, wc, fr, fq, osc, nullptr);
        else if (wc < 2) {
            const int row0 = u.pm * BM + wr * 64 + fr, c0 = wc * 32 + 8 * fq;
#pragma unroll
            for (int ai = 0; ai < 2; ++ai)
#pragma unroll
                for (int m = 0; m < 4; ++m) { const int row = row0 + ai * HALF + m * 16; f32x4 v0 = acc[ai][0][m][0] * osc, v1 = acc[ai][0][m][1] * osc;
                    const f32x4* cs = (const f32x4*)(rope + (size_t)row * 64 + c0); rope8(v0, v1, cs[0], cs[1]);
                    v0 = v0 * K8_SC; v1 = v1 * K8_SC; const i32x2 w8 = {cvt4_fp8(v0[0], v0[1], v0[2], v0[3]), cvt4_fp8(v1[0], v1[1], v1[2], v1[3])};
#pragma unroll
                    for (int hh = 0; hh < 16; ++hh) *(i32x2*)((unsigned char*)kpe + ((size_t)hh * SEQ + row) * 256 + 128 + c0) = w8; }
        }
    }
};
struct EpiQ {
    static constexpr bool PERM = true, AFTER_DRAIN = false;
    bf16_t* q; const float* rss; const float* rope;
    __device__ __forceinline__ void operator()(const f32x4 (&acc)[2][2][4][2], const Unit& u, int wr, int wc, int fr, int fq) const {
        const int row0 = u.pm * BM + wr * 64 + fr, col0 = u.pn * BM + wc * 32 + 8 * fq;
        const int cw0 = col0 % 192, cw1 = (col0 + HALF) % 192;
#pragma unroll
        for (int ai = 0; ai < 2; ++ai)
#pragma unroll
            for (int m = 0; m < 4; ++m) { const int row = row0 + ai * HALF + m * 16; const float sc = QS_M / sqrtf(rss[row] * (1.f / 1024.f) + RMS_EPS);
#pragma unroll
                for (int bj = 0; bj < 2; ++bj) { f32x4 v0 = acc[ai][bj][m][0] * sc, v1 = acc[ai][bj][m][1] * sc; const int cw = bj ? cw1 : cw0;
                    if (cw >= 128) { const f32x4* cs = (const f32x4*)(rope + (size_t)row * 64 + (cw - 128)); rope8(v0, v1, cs[0], cs[1]); }
                    v0 = v0 * Q8_SC; v1 = v1 * Q8_SC; *(i32x2*)((unsigned char*)q + (size_t)row * 3072 + col0 + bj * HALF) = (i32x2){cvt4_fp8(v0[0], v0[1], v0[2], v0[3]), cvt4_fp8(v1[0], v1[1], v1[2], v1[3])}; } }
    }
};
struct EpiKV {
    static constexpr bool PERM = true, AFTER_DRAIN = false;
    bf16_t* kv; const float* rss; unsigned char* k8;
    __device__ __forceinline__ void operator()(const f32x4 (&acc)[2][2][4][2], const Unit& u, int wr, int wc, int fr, int fq) const {
        const int row0 = u.pm * BM + wr * 64 + fr, col0 = u.pn * BM + wc * 32 + 8 * fq;
#pragma unroll
        for (int ai = 0; ai < 2; ++ai)
#pragma unroll
            for (int m = 0; m < 4; ++m) { const int row = row0 + ai * HALF + m * 16; const float sc = 1.f / sqrtf(rss[row] * (1.f / 512.f) + RMS_EPS);
                { const f32x4 k0v = acc[ai][0][m][0] * (sc * K8_SC), k1v = acc[ai][0][m][1] * (sc * K8_SC);
                  *(i32x2*)(k8 + ((size_t)u.pn * SEQ + row) * 256 + wc * 32 + 8 * fq) = (i32x2){cvt4_fp8(k0v[0], k0v[1], k0v[2], k0v[3]), cvt4_fp8(k1v[0], k1v[1], k1v[2], k1v[3])}; }
                *(u32x4*)(kv + (size_t)row * 4096 + col0 + HALF) = pack8(acc[ai][1][m][0] * sc, acc[ai][1][m][1] * sc); }
    }
};
template <int PASS> struct EpiY {
    static constexpr bool PERM = true, AFTER_DRAIN = false;
    bf16_t* T; const bf16_t* gate; unsigned char* T8;
    __device__ __forceinline__ void operator()(const f32x4 (&acc)[2][2][4][2], const Unit& u, int wr, int wc, int fr, int fq) const {
        const int row0 = u.pm * BM + wr * 64 + fr, col0 = u.pn * BM + wc * 32 + 8 * fq;
        constexpr float osc = PASS == 0 ? 1.f / (A_SC * W_OM_SC) : 1.f / (B_SC * W_OD_SC), tsc = T_SC;
#pragma unroll
        for (int ai = 0; ai < 2; ++ai)
#pragma unroll
            for (int m = 0; m < 4; ++m) { const int row = row0 + ai * HALF + m * 16;
#pragma unroll
                for (int bj = 0; bj < 2; ++bj) { const u32x4 gw = *(const u32x4*)(gate + (size_t)row * LDP + col0 + bj * HALF); bf16_t* tp = T + (size_t)row * 4096 + col0 + bj * HALF;
                    f32x4 v0 = acc[ai][bj][m][0] * osc, v1 = acc[ai][bj][m][1] * osc;
                    v0 = v0 * (f32x4){bflo(gw.x), bfhi(gw.x), bflo(gw.y), bfhi(gw.y)}; v1 = v1 * (f32x4){bflo(gw.z), bfhi(gw.z), bflo(gw.w), bfhi(gw.w)};
                    if (PASS == 0) { *(u32x4*)tp = pack8(v0, v1); }
                    else { const u32x4 tw = *(const u32x4*)tp; v0 = (v0 + (f32x4){bflo(tw.x), bfhi(tw.x), bflo(tw.y), bfhi(tw.y)}) * tsc; v1 = (v1 + (f32x4){bflo(tw.z), bfhi(tw.z), bflo(tw.w), bfhi(tw.w)}) * tsc;
                        *(i32x2*)(T8 + (size_t)row * 4096 + col0 + bj * HALF) = (i32x2){cvt4_fp8(v0[0], v0[1], v0[2], v0[3]), cvt4_fp8(v1[0], v1[1], v1[2], v1[3])}; } } }
    }
};
struct EpiOut {
    static constexpr bool PERM = false, AFTER_DRAIN = false;
    const float* x; const float* stats; const float* g; const float* b; float* out; float osc;
    __device__ __forceinline__ void operator()(const f32x4 (&acc)[2][2][4][2], const Unit& u, int wr, int wc, int fr, int fq) const {
        const int row0 = u.pm * BM + wr * 64 + fr, col0 = u.pn * BM + wc * 32 + 4 * fq;
#pragma unroll
        for (int bj = 0; bj < 2; ++bj)
#pragma unroll
            for (int n = 0; n < 2; ++n) { const int col = col0 + bj * HALF + n * 16; const f32x4 gv = *(const f32x4*)(g + col) * ALPHA, bv = *(const f32x4*)(b + col) * ALPHA;
#pragma unroll
                for (int ai = 0; ai < 2; ++ai)
#pragma unroll
                    for (int m = 0; m < 4; ++m) { const int row = row0 + ai * HALF + m * 16; const f32x2 st = *(const f32x2*)(stats + 2 * row);
                        const size_t off = (size_t)row * 4096 + col; const f32x4 xv = *(const f32x4*)(x + off);
                        *(f32x4*)(out + off) = ((xv - st.x) * st.y) * gv + bv + acc[ai][bj][m][n] * osc; } }
    }
};

template <class Epi, class Sched, bool ALIGN_EPI = false, bool SP2 = false, bool FP8 = false>
__device__ __forceinline__ void gemm_phase(PG8_LAS unsigned char* lds, const Gemm g, const Sched S, const Epi E) {
    const int tid = opaque_tid(), wid = __builtin_amdgcn_readfirstlane(tid >> 6), lane = tid & 63, wr = wid >> 2, wc = wid & 3, fr = lane & 15, fq = lane >> 4;
    const int K = g.K, nt = K / BK;
    unsigned voffA[2], voffB[2];
#pragma unroll
    for (int i = 0; i < 2; ++i) { int R, C; stage_rc(tid * 16 + i * 8192, R, C); const int Rb = Epi::PERM ? ((R & ~31) + perm32(R & 31)) : R;
        voffA[i] = (unsigned)(R * g.lda + C) * 2u; voffB[i] = (unsigned)(Rb * g.ldb + C) * 2u; }
    const size_t kstep = (size_t)(BK * 2);
    const size_t hstepA = (size_t)HALF * g.lda * 2, hstepB = (size_t)HALF * g.ldb * 2;
    const size_t tstepA = 2 * hstepA, tstepB = 2 * hstepB;
    const unsigned ldsw = (unsigned)wid * 1024u;
    const int aoff = lds_byte(wr * 64 + fr, fq * 8), boff = lds_byte(wc * 32 + fr, fq * 8);
#define PG8_SA(b, h) (((b) * 2 + (h)) * HTB)
#define PG8_SB(b, h) ((4 + (b) * 2 + (h)) * HTB)
#define PG8_STAGE(bufoff, gbase, voff) do { _Pragma("unroll") for (int _i = 0; _i < 2; ++_i) \
        __builtin_amdgcn_global_load_lds((const unsigned*)((const char*)(gbase) + (voff)[_i]), (PG8_LAS unsigned*)(lds + (bufoff) + ldsw + _i * 8192), 16, 0, 0); } while (0)
#define PG8_LDA(dst, b, h) do { if constexpr (FP8) { _Pragma("unroll") for (int m = 0; m < 4; ++m) dst##8[m] = cat8(*(const PG8_LAS bf16x8*)(lds + PG8_SA(b, h) + aoff + m * 2048), *(const PG8_LAS bf16x8*)(lds + PG8_SA(b, h) + aoff + m * 2048 + 1024)); } \
    else { _Pragma("unroll") for (int m = 0; m < 4; ++m) _Pragma("unroll") for (int k = 0; k < 2; ++k) dst[m][k] = *(const PG8_LAS bf16x8*)(lds + PG8_SA(b, h) + aoff + m * 2048 + k * 1024); } } while (0)
#define PG8_LDB(dst, b, h) do { if constexpr (FP8) { _Pragma("unroll") for (int n = 0; n < 2; ++n) dst##8[n] = cat8(*(const PG8_LAS bf16x8*)(lds + PG8_SB(b, h) + boff + n * 2048), *(const PG8_LAS bf16x8*)(lds + PG8_SB(b, h) + boff + n * 2048 + 1024)); } \
    else { _Pragma("unroll") for (int n = 0; n < 2; ++n) _Pragma("unroll") for (int k = 0; k < 2; ++k) dst[n][k] = *(const PG8_LAS bf16x8*)(lds + PG8_SB(b, h) + boff + n * 2048 + k * 1024); } } while (0)
#define PG8_MMA(ai, bj, At, Bt) do { __builtin_amdgcn_s_setprio(1); if constexpr (FP8) { _Pragma("unroll") for (int m = 0; m < 4; ++m) _Pragma("unroll") for (int n = 0; n < 2; ++n) \
        asm volatile("v_mfma_f32_16x16x128_f8f6f4 %0, %1, %2, %0" : "+v"(acc[ai][bj][m][n]) : "v"(Bt##8[n]), "v"(At##8[m])); } else { \
        _Pragma("unroll") for (int m = 0; m < 4; ++m) _Pragma("unroll") for (int n = 0; n < 2; ++n) _Pragma("unroll") for (int k = 0; k < 2; ++k) \
        acc[ai][bj][m][n] = __builtin_amdgcn_mfma_f32_16x16x32_bf16(Bt[n][k], At[m][k], acc[ai][bj][m][n], 0, 0, 0); } __builtin_amdgcn_s_setprio(0); } while (0)
#define PG8_WAIT_V(n) asm volatile("s_waitcnt vmcnt(" #n ")" ::: "memory")
#define PG8_WAIT_L(n) asm volatile("s_waitcnt lgkmcnt(" #n ")" ::: "memory")
#define PG8_BAR __builtin_amdgcn_s_barrier()
#define PG8_SCHED __builtin_amdgcn_sched_barrier(0)
    Unit cur, nxt; int ui = 0;
    if (!S.next(0, cur)) return;
    f32x4 acc[2][2][4][2];
#pragma unroll
    for (int a = 0; a < 2; ++a)
#pragma unroll
        for (int b = 0; b < 2; ++b)
#pragma unroll
            for (int m = 0; m < 4; ++m)
#pragma unroll
                for (int n = 0; n < 2; ++n) acc[a][b][m][n] = (f32x4){0.f, 0.f, 0.f, 0.f};
    bf16x8 At[4][2], B0[2][2], B1[2][2]; i32x8 At8[4], B08[2], B18[2];
    const char* cA = (const char*)g.A + (size_t)cur.pm * tstepA; const char* cB = (const char*)g.Bt + (size_t)cur.pn * tstepB;
    S.a_ready(cur);
    if constexpr (SP2) {
        PG8_STAGE(PG8_SB(0, 0), cB, voffB); PG8_STAGE(PG8_SB(0, 1), cB + hstepB, voffB); PG8_STAGE(PG8_SA(0, 0), cA, voffA); PG8_STAGE(PG8_SA(0, 1), cA + hstepA, voffA);
        if (wr == 1) PG8_BAR;
        PG8_WAIT_V(2); PG8_BAR;
        PG8_STAGE(PG8_SB(1, 0), cB + kstep, voffB); PG8_STAGE(PG8_SA(1, 0), cA + kstep, voffA); PG8_STAGE(PG8_SB(1, 1), cB + hstepB + kstep, voffB);
        PG8_WAIT_V(6); PG8_BAR;
    } else {
        PG8_STAGE(PG8_SB(0, 0), cB, voffB); PG8_STAGE(PG8_SA(0, 0), cA, voffA); PG8_STAGE(PG8_SB(0, 1), cB + hstepB, voffB); PG8_STAGE(PG8_SA(0, 1), cA + hstepA, voffA);
        if (wr == 1) PG8_BAR;
        PG8_WAIT_V(4); PG8_BAR;
        PG8_STAGE(PG8_SB(1, 0), cB + kstep, voffB); PG8_STAGE(PG8_SA(1, 0), cA + kstep, voffA); PG8_STAGE(PG8_SB(1, 1), cB + hstepB + kstep, voffB);
        PG8_WAIT_V(6); PG8_BAR;
    }
    for (;;) {
        const bool has_next = S.next(ui + 1, nxt);
        const char* nA = has_next ? (const char*)g.A + (size_t)nxt.pm * tstepA : cA; const char* nB = has_next ? (const char*)g.Bt + (size_t)nxt.pn * tstepB : cB;
        for (int t = 0; t < nt; t += 2) {
            const bool last = (t == nt - 2);
            const char* a1 = cA + (size_t)(t + 1) * kstep;
            const char* a2 = last ? nA : cA + (size_t)(t + 2) * kstep; const char* b2 = last ? nB : cB + (size_t)(t + 2) * kstep;
            const char* a3 = a2 + kstep; const char* b3 = b2 + kstep;
            if (last && has_next) S.a_ready(nxt);
            if constexpr (SP2) {
            PG8_LDB(B0, 0, 0); PG8_LDB(B1, 0, 1); PG8_SCHED; PG8_LDA(At, 0, 0); PG8_STAGE(PG8_SA(1, 1), a1 + hstepA, voffA);
            PG8_WAIT_V(8); PG8_WAIT_L(0); PG8_BAR; PG8_MMA(0, 0, At, B0); PG8_MMA(0, 1, At, B1); PG8_BAR; PG8_SCHED;
            PG8_LDA(At, 0, 1); PG8_STAGE(PG8_SB(0, 0), b2, voffB); PG8_STAGE(PG8_SB(0, 1), b2 + hstepB, voffB); PG8_STAGE(PG8_SA(0, 0), a2, voffA);
            PG8_WAIT_V(8); PG8_WAIT_L(0); PG8_BAR; PG8_MMA(1, 0, At, B0); PG8_MMA(1, 1, At, B1); PG8_BAR; PG8_SCHED;
            PG8_LDB(B0, 1, 0); PG8_LDB(B1, 1, 1); PG8_SCHED; PG8_LDA(At, 1, 0); PG8_STAGE(PG8_SA(0, 1), a2 + hstepA, voffA);
            PG8_WAIT_V(8); PG8_WAIT_L(0); PG8_BAR; PG8_MMA(0, 0, At, B0); PG8_MMA(0, 1, At, B1); PG8_BAR; PG8_SCHED;
            PG8_LDA(At, 1, 1); PG8_STAGE(PG8_SB(1, 0), b3, voffB); PG8_STAGE(PG8_SB(1, 1), b3 + hstepB, voffB); PG8_STAGE(PG8_SA(1, 0), a3, voffA);
            PG8_WAIT_V(8); PG8_WAIT_L(0); PG8_BAR; PG8_MMA(1, 0, At, B0); PG8_MMA(1, 1, At, B1); PG8_BAR; PG8_SCHED;
            } else {
            PG8_LDB(B0, 0, 0); PG8_SCHED; PG8_LDA(At, 0, 0); PG8_STAGE(PG8_SA(1, 1), a1 + hstepA, voffA);
            PG8_WAIT_L(8); PG8_BAR; PG8_WAIT_L(0); PG8_MMA(0, 0, At, B0); PG8_BAR; PG8_SCHED;
            PG8_LDB(B1, 0, 1); PG8_STAGE(PG8_SB(0, 0), b2, voffB);
            PG8_BAR; PG8_WAIT_L(0); PG8_MMA(0, 1, At, B1); PG8_BAR;
            PG8_LDA(At, 0, 1); PG8_STAGE(PG8_SA(0, 0), a2, voffA);
            PG8_BAR; PG8_WAIT_L(0); PG8_MMA(1, 0, At, B0); PG8_BAR; PG8_SCHED;
            PG8_STAGE(PG8_SB(0, 1), b2 + hstepB, voffB);
            PG8_WAIT_V(6); PG8_BAR; PG8_MMA(1, 1, At, B1); PG8_BAR;
            PG8_LDB(B0, 1, 0); PG8_SCHED; PG8_LDA(At, 1, 0); PG8_STAGE(PG8_SA(0, 1), a2 + hstepA, voffA);
            PG8_WAIT_L(8); PG8_BAR; PG8_WAIT_L(0); PG8_MMA(0, 0, At, B0); PG8_BAR; PG8_SCHED;
            PG8_LDB(B1, 1, 1); PG8_STAGE(PG8_SB(1, 0), b3, voffB);
            PG8_BAR; PG8_WAIT_L(0); PG8_MMA(0, 1, At, B1); PG8_BAR;
            PG8_LDA(At, 1, 1); PG8_STAGE(PG8_SA(1, 0), a3, voffA);
            PG8_BAR; PG8_WAIT_L(0); PG8_MMA(1, 0, At, B0); PG8_BAR; PG8_SCHED;
            PG8_STAGE(PG8_SB(1, 1), b3 + hstepB, voffB);
            PG8_WAIT_V(6); PG8_BAR; PG8_MMA(1, 1, At, B1); PG8_BAR;
            }
        }
        if constexpr (ALIGN_EPI) { if (wr == 0) PG8_BAR; }
        if constexpr (FP8) asm volatile("s_nop 15\n\ts_nop 15" ::: "memory");
        if constexpr (!Epi::AFTER_DRAIN) { E(acc, cur, wr, wc, fr, fq); S.done(cur); }
        if (!has_next) break;
#pragma unroll
        for (int a = 0; a < 2; ++a)
#pragma unroll
            for (int b = 0; b < 2; ++b)
#pragma unroll
                for (int m = 0; m < 4; ++m)
#pragma unroll
                    for (int n = 0; n < 2; ++n) acc[a][b][m][n] = (f32x4){0.f, 0.f, 0.f, 0.f};
        cur = nxt; cA = nA; cB = nB; ++ui;
        if constexpr (ALIGN_EPI) { if (wr == 1) PG8_BAR; }
    }
    PG8_WAIT_V(0);
    if constexpr (!ALIGN_EPI) { if (wr == 0) PG8_BAR; }
    PG8_BAR;
    if constexpr (Epi::AFTER_DRAIN) { E.fused(acc, cur, wr, wc, fr, fq, lds, wid, lane); S.done(cur); }
#undef PG8_SA
#undef PG8_SB
#undef PG8_STAGE
#undef PG8_LDA
#undef PG8_LDB
#undef PG8_MMA
#undef PG8_WAIT_V
#undef PG8_WAIT_L
#undef PG8_BAR
#undef PG8_SCHED
}
}

namespace att {
typedef unsigned short bf16_t;
using bf16x8 = __attribute__((ext_vector_type(8))) short;
using s16x4  = __attribute__((ext_vector_type(4))) short;
using f32x16 = __attribute__((ext_vector_type(16))) float;
using u32x4  = __attribute__((ext_vector_type(4))) unsigned;
constexpr int NW = 8, QBLK = 32, KVBLK = 64;
constexpr int SHM_V = 16384, SHM_KN = 16384, SHM_KP = 8192;
constexpr int OFF_V = 0, OFF_KN = 2 * SHM_V, OFF_KP = OFF_KN + 2 * SHM_KN, OFF_WS = OFF_KP + 2 * SHM_KP, OFF_BIAS = OFF_WS + NW * 64 * 4, OFF_QPE = OFF_BIAS + 1024, ATT_LDS = OFF_QPE + NW * 4096, M_QPE = 3 * 40960 + 2048;
#define KSWZ(row, colB) ((row) * 256 + ((colB) ^ (((row) & 15) << 4)))
#define KPSWZ(row, colB) ((row) * 128 + ((colB) ^ ((((row) >> 1) & 7) << 4)))
#define SBAR() __builtin_amdgcn_sched_barrier(0)
__device__ __forceinline__ int crow(int r, int hi) { return (r & 3) + 8 * (r >> 2) + 4 * hi; }
typedef float f32x2_t __attribute__((ext_vector_type(2))); typedef __bf16 bf16x2_t __attribute__((ext_vector_type(2)));
__device__ __forceinline__ unsigned cvtpk(float lo, float hi) { f32x2_t v = {lo, hi}; bf16x2_t b = __builtin_convertvector(v, bf16x2_t); return __builtin_bit_cast(unsigned, b); }
__device__ __forceinline__ bf16x8 ld8(const bf16_t* p) { return *reinterpret_cast<const bf16x8*>(p); }

template <int THR2>
__device__ __forceinline__ void partialSM(f32x16& p0, f32x16& p1, float& m_reg, float& alpha, const float C = 1.f) {
  float pmax = p0[0];
#pragma unroll
  for (int r = 1; r < 16; ++r) pmax = fmaxf(pmax, p0[r]);
#pragma unroll
  for (int r = 0; r < 16; ++r) pmax = fmaxf(pmax, p1[r]);
  { auto rr = __builtin_amdgcn_permlane32_swap(__float_as_uint(pmax), __float_as_uint(pmax), false, false);
    pmax = fmaxf(__uint_as_float(rr[0]), __uint_as_float(rr[1])) * C; }
  float mn;
  if (THR2 > 0 && __builtin_expect(__all(pmax - m_reg <= (float)THR2), 1)) { mn = m_reg; alpha = 1.f; }
  else { mn = fmaxf(m_reg, pmax); alpha = __builtin_amdgcn_exp2f(m_reg - mn); m_reg = mn; }
#pragma unroll
  for (int r = 0; r < 16; ++r) p0[r] = fmaf(p0[r], C, -mn);
#pragma unroll
  for (int r = 0; r < 16; ++r) p1[r] = fmaf(p1[r], C, -mn);
#pragma unroll
  for (int r = 0; r < 16; ++r) p0[r] = __builtin_amdgcn_exp2f(p0[r]);
}
__device__ __forceinline__ void finishSM(f32x16& p0, f32x16& p1, float alpha, float& l_reg, bf16x8& pa0, bf16x8& pa1, bf16x8& pa2, bf16x8& pa3) {
#pragma unroll
  for (int r = 0; r < 16; ++r) p1[r] = __builtin_amdgcn_exp2f(p1[r]);
  float ps = 0;
#pragma unroll
  for (int r = 0; r < 16; ++r) ps += p0[r];
#pragma unroll
  for (int r = 0; r < 16; ++r) ps += p1[r];
  { auto rr = __builtin_amdgcn_permlane32_swap(__float_as_uint(ps), __float_as_uint(ps), false, false);
    ps = __uint_as_float(rr[0]) + __uint_as_float(rr[1]); }
  l_reg = l_reg * alpha + ps;
#define PK4(P, BASE, OUT) do { unsigned a0 = cvtpk(P[BASE + 0], P[BASE + 1]), a1 = cvtpk(P[BASE + 2], P[BASE + 3]);   \
    unsigned b0 = cvtpk(P[BASE + 4], P[BASE + 5]), b1 = cvtpk(P[BASE + 6], P[BASE + 7]);                              \
    auto r0 = __builtin_amdgcn_permlane32_swap(a0, b0, false, false); auto r1 = __builtin_amdgcn_permlane32_swap(a1, b1, false, false); \
    u32x4 w = {r0[0], r1[0], r0[1], r1[1]}; OUT = *reinterpret_cast<bf16x8*>(&w); } while (0)
  PK4(p0, 0, pa0); PK4(p0, 8, pa1); PK4(p1, 0, pa2); PK4(p1, 8, pa3);
#undef PK4
}
template <int NPE>
__device__ __forceinline__ void qkt(f32x16& p0, f32x16& p1, const char* Kn, const char* Kp, const bf16x8* qr, const char* qpe, int r32, int hi) {
  p0 = f32x16{}; p1 = f32x16{};
#pragma unroll
  for (int d0 = 0; d0 < 8; ++d0) { const int cb = (d0 * 16 + hi * 8) * 2;
    bf16x8 b0 = *reinterpret_cast<const bf16x8*>(Kn + KSWZ(r32, cb));
    bf16x8 b1 = *reinterpret_cast<const bf16x8*>(Kn + KSWZ(32 + r32, cb));
    p0 = __builtin_amdgcn_mfma_f32_32x32x16_bf16(b0, qr[d0], p0, 0, 0, 0);
    p1 = __builtin_amdgcn_mfma_f32_32x32x16_bf16(b1, qr[d0], p1, 0, 0, 0); }
#pragma unroll
  for (int d0 = 0; d0 < NPE; ++d0) { const int cb = (d0 * 16 + hi * 8) * 2;
    bf16x8 b0 = *reinterpret_cast<const bf16x8*>(Kp + KPSWZ(r32, cb));
    bf16x8 b1 = *reinterpret_cast<const bf16x8*>(Kp + KPSWZ(32 + r32, cb));
    p0 = __builtin_amdgcn_mfma_f32_32x32x16_bf16(b0, qr[8 + d0], p0, 0, 0, 0);
    p1 = __builtin_amdgcn_mfma_f32_32x32x16_bf16(b1, qr[8 + d0], p1, 0, 0, 0); }
}
typedef int i32x8 __attribute__((ext_vector_type(8))); typedef int i32x4 __attribute__((ext_vector_type(4)));
__device__ __forceinline__ void qkt8(f32x16& p0, f32x16& p1, const char* K8t, const i32x8* q8, int r32, int hi) {
  p0 = f32x16{}; p1 = f32x16{};
#pragma unroll
  for (int s = 0; s < 3; ++s) { const int cb = 64 * s + 32 * hi;
    const i32x4 a0 = *reinterpret_cast<const i32x4*>(K8t + KSWZ(r32, cb)), a1 = *reinterpret_cast<const i32x4*>(K8t + KSWZ(r32, cb + 16));
    const i32x4 c0 = *reinterpret_cast<const i32x4*>(K8t + KSWZ(32 + r32, cb)), c1 = *reinterpret_cast<const i32x4*>(K8t + KSWZ(32 + r32, cb + 16));
    p0 = __builtin_amdgcn_mfma_scale_f32_32x32x64_f8f6f4(__builtin_shufflevector(a0, a1, 0, 1, 2, 3, 4, 5, 6, 7), q8[s], p0, 0, 0, 0, 0, 0, 0);
    p1 = __builtin_amdgcn_mfma_scale_f32_32x32x64_f8f6f4(__builtin_shufflevector(c0, c1, 0, 1, 2, 3, 4, 5, 6, 7), q8[s], p1, 0, 0, 0, 0, 0, 0); }
}
__device__ __forceinline__ int v_st(int k, int c) { const int kk = (k & ~0xC) | ((k & 4) << 1) | ((k & 8) >> 1); return ((kk >> 3) * 4 + (c >> 5)) * 512 + ((kk & 7) * 32 + (c & 31)) * 2; }
__device__ __forceinline__ int v_rd_base(int lane) { return ((lane & 3) << 3) | (((lane >> 2) & 3) << 6) | (((lane >> 4) & 1) << 5) | (((lane >> 5) & 1) << 8); }
constexpr int v_rd_off(int d0, int ks, int half) { return d0 * 512 + ks * 4096 + half * 2048; }
template <int OFF> __device__ __forceinline__ s16x4 tr_read(int vb) {
  s16x4 r; asm volatile("ds_read_b64_tr_b16 %0, %1 offset:%2" : "=&v"(r) : "v"(vb), "i"(OFF) : "memory"); return r;
}
template <int D0> __device__ __forceinline__ void pv_one(f32x16& od, int vb, bf16x8 pa0, bf16x8 pa1, bf16x8 pa2, bf16x8 pa3) {
  const s16x4 l0 = tr_read<v_rd_off(D0, 0, 0)>(vb), h0 = tr_read<v_rd_off(D0, 0, 1)>(vb), l1 = tr_read<v_rd_off(D0, 1, 0)>(vb), h1 = tr_read<v_rd_off(D0, 1, 1)>(vb);
  const s16x4 l2 = tr_read<v_rd_off(D0, 2, 0)>(vb), h2 = tr_read<v_rd_off(D0, 2, 1)>(vb), l3 = tr_read<v_rd_off(D0, 3, 0)>(vb), h3 = tr_read<v_rd_off(D0, 3, 1)>(vb);
  asm volatile("s_waitcnt lgkmcnt(0)" ::: "memory"); SBAR();
#define PK(L, H) (bf16x8){L[0], L[1], L[2], L[3], H[0], H[1], H[2], H[3]}
  od = __builtin_amdgcn_mfma_f32_32x32x16_bf16(pa0, PK(l0, h0), od, 0, 0, 0);
  od = __builtin_amdgcn_mfma_f32_32x32x16_bf16(pa1, PK(l1, h1), od, 0, 0, 0);
  od = __builtin_amdgcn_mfma_f32_32x32x16_bf16(pa2, PK(l2, h2), od, 0, 0, 0);
  od = __builtin_amdgcn_mfma_f32_32x32x16_bf16(pa3, PK(l3, h3), od, 0, 0, 0);
#undef PK
}
__device__ __forceinline__ void pv_d0(f32x16* o, int vb, bf16x8 pa0, bf16x8 pa1, bf16x8 pa2, bf16x8 pa3) {
  pv_one<0>(o[0], vb, pa0, pa1, pa2, pa3); pv_one<1>(o[1], vb, pa0, pa1, pa2, pa3); pv_one<2>(o[2], vb, pa0, pa1, pa2, pa3); pv_one<3>(o[3], vb, pa0, pa1, pa2, pa3);
}
#define RESC(a) do { if (__any((a) < 1.f)) { if (hi == 0) al_l[r32] = (a); asm volatile("s_waitcnt lgkmcnt(0)" ::: "memory"); \
    _Pragma("unroll") for (int d = 0; d < 4; ++d) _Pragma("unroll") for (int r = 0; r < 16; ++r) o[d][r] *= al_l[crow(r, hi)]; } } while (0)

#define LAS3 __attribute__((address_space(3)))
__device__ __forceinline__ void mla_unit(const bf16_t* __restrict__ Qb, const bf16_t* __restrict__ Kh, const bf16_t* __restrict__ Vh, const bf16_t* __restrict__ Kpe,
                                         const bf16_t* __restrict__ Gb, bf16_t* __restrict__ Ob, char* lds, LAS3 unsigned char* ldsl) {
  constexpr int LDQ = 3072, LDK = 4096, LDO = 2048, NT = SEQ / KVBLK; constexpr float QKC = 1.f / (Q8_SC * K8_SC);
  constexpr int STG = 32768, O_V = 0, O_KN = 16384, M_WS = 3 * STG;
  const int tid = opaque_tid(), wid = __builtin_amdgcn_readfirstlane(tid >> 6), lane = tid & 63, r32 = lane & 31, hi = lane >> 5;
  float* ws = (float*)(lds + M_WS) + wid * 64; float* li_l = ws; float* al_l = ws + 32;
  float m_reg = -1e30f, l_reg = 0; f32x16 o[4] = {}; i32x8 q8[3];
  { const unsigned char* Qw = (const unsigned char*)Qb + (long)(wid * QBLK + r32) * LDQ + hi * 32;
#pragma unroll
    for (int s = 0; s < 3; ++s) { const i32x4 a = *reinterpret_cast<const i32x4*>(Qw + 64 * s), b = *reinterpret_cast<const i32x4*>(Qw + 64 * s + 16); q8[s] = __builtin_shufflevector(a, b, 0, 1, 2, 3, 4, 5, 6, 7); } }
  asm volatile("s_waitcnt vmcnt(0)" ::: "memory"); SBAR();
  int vsrc[2], ksrc[2];
#pragma unroll
  for (int i = 0; i < 2; ++i) { const int c = wid + 8 * i;
    { const int sub = c * 2 + (lane >> 5), kk = (sub >> 2) * 8 + ((lane & 31) >> 2), k = (kk & ~0xC) | ((kk & 4) << 1) | ((kk & 8) >> 1); vsrc[i] = k * LDK + (sub & 3) * 32 + (lane & 3) * 8; }
    { const int row = c * 4 + (lane >> 4), colB = ((lane & 15) * 16) ^ ((row & 15) << 4); ksrc[i] = row * 256 + colB; } }
#define DMA16(gptr, ldsoff) __builtin_amdgcn_global_load_lds((const unsigned*)(gptr), (LAS3 unsigned*)(ldsl + (ldsoff)), 16, 0, 0)
#define ISSUE_K(t, s) do { const unsigned char* kb_ = (const unsigned char*)Kh + (long)(t) * (KVBLK * 256); DMA16(kb_ + ksrc[0], (s) * STG + O_KN + wid * 1024); DMA16(kb_ + ksrc[1], (s) * STG + O_KN + (wid + 8) * 1024); } while (0)
#define ISSUE_V(t, s) do { const bf16_t* vb_ = Vh + (long)(t) * (KVBLK * LDK); DMA16(vb_ + vsrc[0], (s) * STG + O_V + wid * 1024); DMA16(vb_ + vsrc[1], (s) * STG + O_V + (wid + 8) * 1024); } while (0)
#define WAITBAR(N) do { asm volatile("s_waitcnt vmcnt(" #N ") lgkmcnt(0)" ::: "memory"); __builtin_amdgcn_s_barrier(); asm volatile("" ::: "memory"); } while (0)
  const int vb0 = (int)(uintptr_t)lds + O_V + v_rd_base(lane);
  f32x16 pA0, pA1, pB0, pB1; float alA, alB; bf16x8 pa0, pa1, pa2, pa3;
  int s0 = 0, s1 = 1, s2 = 2;
#define ROT() do { const int t_ = s0; s0 = s1; s1 = s2; s2 = t_; } while (0)
  ISSUE_K(0, 0); ISSUE_V(0, 0); ISSUE_K(1, 1);
  WAITBAR(2);
  ISSUE_K(2, s2); ISSUE_V(1, s1);
  qkt8(pA0, pA1, lds + s0 * STG + O_KN, q8, r32, hi); partialSM<11>(pA0, pA1, m_reg, alA, QKC);
  WAITBAR(4); ROT();
#define STEP(PX0, PX1, ALX, PY0, PY1, ALY, j_) do { const bool ik_ = (j_) + 2 < NT, iv_ = (j_) + 1 < NT; \
    if (ik_) ISSUE_K((j_) + 2, s2); if (iv_) ISSUE_V((j_) + 1, s1); \
    SBAR(); qkt8(PX0, PX1, lds + s0 * STG + O_KN, q8, r32, hi); \
    finishSM(PY0, PY1, ALY, l_reg, pa0, pa1, pa2, pa3); SBAR(); \
    pv_d0(o, vb0 + s2 * STG, pa0, pa1, pa2, pa3); partialSM<11>(PX0, PX1, m_reg, ALX, QKC); \
    RESC(ALX); \
    if (ik_) WAITBAR(4); else WAITBAR(0); ROT(); } while (0)
  for (int j = 1; j + 1 < NT; j += 2) {
    STEP(pB0, pB1, alB, pA0, pA1, alA, j);
    STEP(pA0, pA1, alA, pB0, pB1, alB, j + 1);
  }
  STEP(pB0, pB1, alB, pA0, pA1, alA, NT - 1);
  finishSM(pB0, pB1, alB, l_reg, pa0, pa1, pa2, pa3); SBAR();
  pv_d0(o, vb0 + s2 * STG, pa0, pa1, pa2, pa3);
  if (hi == 0) li_l[r32] = l_reg; asm volatile("s_waitcnt lgkmcnt(0)" ::: "memory");
  float rli[16];
#pragma unroll
  for (int r = 0; r < 16; ++r) rli[r] = __builtin_amdgcn_rcpf(li_l[crow(r, hi)]);
  __syncthreads();
  const bf16_t* Gw = Gb + (long)(wid * QBLK) * LDP;
  { bf16_t* stg = (bf16_t*)(lds + wid * 8704);
#pragma unroll
    for (int r = 0; r < 16; ++r) { const int orow = crow(r, hi);
#pragma unroll
      for (int d0 = 0; d0 < 4; ++d0) { const float ov = o[d0][r] * rli[r]; stg[orow * 136 + d0 * 32 + r32] = (bf16_t)(cvtpk(ov, ov) & 0xffffu); } }
    asm volatile("s_waitcnt lgkmcnt(0)" ::: "memory");
    int lz = lane; asm volatile("" : "+v"(lz));
#pragma unroll
    for (int i = 0; i < 8; ++i) { const int id = i * 64 + lz, row = id >> 4, c = (id & 15) * 8;
      const u32x4 ov = *(const u32x4*)(stg + row * 136 + c); const u32x4 gv = *(const u32x4*)(Gw + (long)row * LDP + c);
#define PLO(k) (__uint_as_float(ov[k] << 16) * __uint_as_float(gv[k] << 16) * A_SC)
#define PHI(k) (__uint_as_float(ov[k] & 0xffff0000u) * __uint_as_float(gv[k] & 0xffff0000u) * A_SC)
      typedef int i32x2 __attribute__((ext_vector_type(2)));
      *(i32x2*)((unsigned char*)Ob + (long)(wid * QBLK + row) * LDO + c) = (i32x2){pg8::cvt4_fp8(PLO(0), PHI(0), PLO(1), PHI(1)), pg8::cvt4_fp8(PLO(2), PHI(2), PLO(3), PHI(3))}; } }
#undef PLO
#undef PHI
  __syncthreads();
#undef DMA16
#undef ISSUE_K
#undef ISSUE_V
#undef WAITBAR
#undef ROT
#undef STEP
}

__device__ __forceinline__ void dswa_unit(int H, int rs, int qb, const bf16_t* __restrict__ proj, const float* __restrict__ bias2, bf16_t* __restrict__ Od, float* __restrict__ lse, char* lds) {
  const int g = H >> 3, dil = 1 << (2 * g), L = SEQ / dil, Q0 = qb * 256, T0 = Q0 - 64;
  const int tid = opaque_tid(), wid = tid >> 6, lane = tid & 63, r32 = lane & 31, hi = lane >> 5;
  char* V_lds = lds + OFF_V; char* Kn_lds = lds + OFF_KN;
  float* ws = (float*)(lds + OFF_WS) + wid * 64; float* li_l = ws; float* al_l = ws + 32;
  float* bl = (float*)(lds + OFF_BIAS);
  const bf16_t* Qp = proj + C_DQ + H * 128; const bf16_t* Kp = proj + C_DK + H * 128; const bf16_t* Vp = proj + C_DV + H * 128;
  if (tid < 129) bl[tid] = bias2[(g * 8 + (H & 7)) * 129 + tid];
  const int qa = Q0 + wid * QBLK, qi = qa + r32;
  bf16x8 qr[8];
  { const bf16_t* Qw = Qp + (size_t)(qi * dil + rs) * LDP + hi * 8;
#pragma unroll
    for (int d0 = 0; d0 < 8; ++d0) qr[d0] = ld8(Qw + d0 * 16); }
  const int sr = tid >> 4, sc = (tid & 15) * 8, vst0 = v_st(sr, sc), vst1 = v_st(32 + sr, sc);
  const int vb0 = (int)(uintptr_t)V_lds + v_rd_base(lane);
  float m_reg = -1e29f, l_reg = 0.f; f32x16 o[4] = {};
  const int tlo = (Q0 == 0) ? 1 : 0, thi = (Q0 + 256 >= L) ? 5 : 6;
  bf16x8 vs0, vs1, ks0, ks1;
#define DLOAD(t_) do { const int k0_ = T0 + 64 * (t_); int i0 = k0_ + sr, i1 = k0_ + 32 + sr; i0 = i0 < 0 ? 0 : (i0 >= L ? L - 1 : i0); i1 = i1 < 0 ? 0 : (i1 >= L ? L - 1 : i1); \
    const size_t o0 = (size_t)(i0 * dil + rs) * LDP + sc, o1 = (size_t)(i1 * dil + rs) * LDP + sc; vs0 = ld8(Vp + o0); vs1 = ld8(Vp + o1); ks0 = ld8(Kp + o0); ks1 = ld8(Kp + o1); } while (0)
  DLOAD(tlo);
  for (int t = tlo; t < thi; ++t) {
    const int k0 = T0 + 64 * t;
    __syncthreads();
    *(bf16x8*)(V_lds + vst0) = vs0; *(bf16x8*)(V_lds + vst1) = vs1;
    *(bf16x8*)(Kn_lds + KSWZ(sr, sc * 2)) = ks0; *(bf16x8*)(Kn_lds + KSWZ(32 + sr, sc * 2)) = ks1;
    __syncthreads();
    if (t + 1 < thi) DLOAD(t + 1);
    if (k0 > qa + 31 + 64 || k0 + 63 < qa - 64) continue;
    f32x16 p0, p1; qkt<0>(p0, p1, Kn_lds, Kn_lds, qr, Kn_lds, r32, hi);
#pragma unroll
    for (int r = 0; r < 16; ++r) { const int kj = k0 + crow(r, hi), dj = kj - qi; int bi = dj + 64; bi = bi < 0 ? 0 : (bi > 128 ? 128 : bi);
      const int kj1 = kj + 32, dj1 = dj + 32; int bi1 = dj1 + 64; bi1 = bi1 < 0 ? 0 : (bi1 > 128 ? 128 : bi1);
      const bool ok0 = (dj >= -64) && (dj <= 64) && (kj >= 0) && (kj < L), ok1 = (dj1 >= -64) && (dj1 <= 64) && (kj1 >= 0) && (kj1 < L);
      p0[r] = ok0 ? p0[r] + bl[bi] : -1e30f; p1[r] = ok1 ? p1[r] + bl[bi1] : -1e30f; }
    float al; partialSM<0>(p0, p1, m_reg, al);
    bf16x8 pa0, pa1, pa2, pa3; finishSM(p0, p1, al, l_reg, pa0, pa1, pa2, pa3);
    RESC(al);
    SBAR(); pv_d0(o, vb0, pa0, pa1, pa2, pa3);
  }
#undef DLOAD
  if (hi == 0) li_l[r32] = l_reg; asm volatile("s_waitcnt lgkmcnt(0)" ::: "memory");
  float rli[16];
#pragma unroll
  for (int r = 0; r < 16; ++r) rli[r] = __builtin_amdgcn_rcpf(li_l[crow(r, hi)]);
  const int hh = H & 7;
  bf16_t* Og = Od + (size_t)g * SEQ * 1024 + hh * 128;
#pragma unroll
  for (int r = 0; r < 16; ++r) { const size_t pos = (size_t)(qa + crow(r, hi)) * dil + rs;
#pragma unroll
    for (int d0 = 0; d0 < 4; ++d0) { const float ov = o[d0][r] * rli[r]; Og[pos * 1024 + d0 * 32 + r32] = (bf16_t)(cvtpk(ov, ov) & 0xffffu); } }
  if (hi == 0) lse[((size_t)g * SEQ + (size_t)qi * dil + rs) * 8 + hh] = m_reg + __builtin_amdgcn_logf(l_reg);
  __syncthreads();
}
#undef RESC
#undef KSWZ
#undef KPSWZ
#undef SBAR
}

#define LAS __attribute__((address_space(3)))
typedef unsigned short bf16;
typedef unsigned v4u __attribute__((ext_vector_type(4)));
typedef float f32x4 __attribute__((ext_vector_type(4)));
constexpr int NWAVES = 8;
constexpr size_t MiB = 1u << 20;
constexpr size_t WS_RSSQ = 0, WS_RSSKV = 32768, WS_STATS = 65536, WS_BIAS2 = 131072, WS_LSE = 262144;
constexpr size_t WS_ROPE = 2 * MiB;
constexpr size_t WS_WIN = 4 * MiB, WS_WQB = 178 * MiB, WS_WKVB = 184 * MiB, WS_WOMLA = 188 * MiB, WS_WODSWA = 204 * MiB, WS_WOUT = 212 * MiB;
constexpr size_t WS_H = 244 * MiB, WS_PROJ = 308 * MiB, WS_QMLA = 656 * MiB, WS_KVMLA = 704 * MiB, WS_KPE = 768 * MiB, WS_AMLA = 770 * MiB;
constexpr size_t WS_ODSWA = 802 * MiB, WS_BDSWA = 850 * MiB, WS_T = 866 * MiB, WS_K8 = 930 * MiB, WS_END = 962 * MiB;
static_assert(WS_WIN + (size_t)LDP * 4096 * 2 <= WS_WQB && WS_PROJ + (size_t)SEQ * LDP * 2 <= WS_QMLA && WS_LSE + 3 * SEQ * 8 * 4 <= WS_ROPE, "d_ws map");
constexpr int LDS_BYTES = 163840;

__device__ __forceinline__ unsigned f2bf(float f) { unsigned u = __builtin_bit_cast(unsigned, f); return (u + 0x7fffu + ((u >> 16) & 1u)) >> 16; }
__device__ __forceinline__ unsigned pk2(float lo, float hi) { return f2bf(lo) | (f2bf(hi) << 16); }
__device__ __forceinline__ float wave_sum(float v) {
#pragma unroll
    for (int o = 1; o < 64; o <<= 1) v += __shfl_xor(v, o);
    return v;
}
__device__ __forceinline__ void transpose_item(const float* __restrict__ W, int K, int N, bf16* __restrict__ WT, int k0, int n0, int dbase, int dstride, const float* __restrict__ kscale, LAS float* scr, int lane) {
    float wv[32];
#pragma unroll
    for (int i = 0; i < 32; ++i) { const int kk = 2 * i + (lane >> 5); wv[i] = __builtin_nontemporal_load(W + (size_t)(k0 + kk) * N + n0 + (lane & 31)); }
#pragma unroll
    for (int i = 0; i < 32; ++i) { const int kk = 2 * i + (lane >> 5); float w = wv[i]; if (kscale) w *= kscale[k0 + kk]; scr[kk * 33 + (lane & 31)] = w; }
    asm volatile("s_waitcnt lgkmcnt(0)" ::: "memory");
    const int c = lane & 7;
#pragma unroll
    for (int j = 0; j < 4; ++j) { const int n = (lane >> 3) + 8 * j; const LAS float* s = scr + (8 * c) * 33 + n;
        v4u o; o.x = pk2(s[0 * 33], s[1 * 33]); o.y = pk2(s[2 * 33], s[3 * 33]); o.z = pk2(s[4 * 33], s[5 * 33]); o.w = pk2(s[6 * 33], s[7 * 33]);
        *(v4u*)(WT + (size_t)(dbase + dstride * n) * K + k0 + 8 * c) = o; }
    asm volatile("s_waitcnt lgkmcnt(0)" ::: "memory");
}

#define REP0 1
#define REP1 1
#define REP2 1
#define REP3 1
#define REP4 1
#define REP5 1
constexpr float H_SC = 16.f, W_SC = 1024.f;
__device__ __forceinline__ void transpose_item8(const float* __restrict__ W, int K, int N, unsigned char* __restrict__ WT, int k0, int n0, int dbase, int dstride, float wsc, LAS float* scr, int lane) {
    float wv[32];
#pragma unroll
    for (int i = 0; i < 32; ++i) { const int kk = 2 * i + (lane >> 5); wv[i] = __builtin_nontemporal_load(W + (size_t)(k0 + kk) * N + n0 + (lane & 31)); }
#pragma unroll
    for (int i = 0; i < 32; ++i) { const int kk = 2 * i + (lane >> 5); scr[kk * 33 + (lane & 31)] = wv[i] * wsc; }
    asm volatile("s_waitcnt lgkmcnt(0)" ::: "memory");
    const int c = lane & 7;
#pragma unroll
    for (int j = 0; j < 4; ++j) { const int n = (lane >> 3) + 8 * j; const LAS float* s = scr + (8 * c) * 33 + n;
        int d0 = __builtin_amdgcn_cvt_pk_fp8_f32(s[0 * 33], s[1 * 33], 0, false); d0 = __builtin_amdgcn_cvt_pk_fp8_f32(s[2 * 33], s[3 * 33], d0, true);
        int d1 = __builtin_amdgcn_cvt_pk_fp8_f32(s[4 * 33], s[5 * 33], 0, false); d1 = __builtin_amdgcn_cvt_pk_fp8_f32(s[6 * 33], s[7 * 33], d1, true);
        typedef int i32x2 __attribute__((ext_vector_type(2)));
        *(i32x2*)(WT + (size_t)(dbase + dstride * n) * K + k0 + 8 * c) = (i32x2){d0, d1}; }
    asm volatile("s_waitcnt lgkmcnt(0)" ::: "memory");
}
struct Args { const float* in[14]; float* out; unsigned char* ws; };

__global__ void __launch_bounds__(NWAVES * 64, 2) fwd_mega(Args a) {
    extern __shared__ __attribute__((aligned(16))) unsigned char lds[];
    cg::grid_group grid = cg::this_grid();
    const int G = gridDim.x, bx = blockIdx.x, vcu = (G % 8 == 0) ? (bx % 8) * (G / 8) + bx / 8 : bx;
    LAS unsigned char* ldsl = (LAS unsigned char*)lds;
    unsigned char* ws = a.ws;
    const float* x = a.in[0]; const float* emb_g = a.in[1]; const float* emb_b = a.in[2]; const float* rel_bias = a.in[3]; const float* w_in = a.in[4];
    const float* qa_g = a.in[5]; const float* w_qb = a.in[6]; const float* kva_g = a.in[7]; const float* w_kvb = a.in[8]; const float* w_omla = a.in[9];
    const float* w_odswa = a.in[10]; const float* w_out = a.in[11]; const float* ln_g = a.in[12]; const float* ln_b = a.in[13];
    float* rss_q = (float*)(ws + WS_RSSQ); float* rss_kv = (float*)(ws + WS_RSSKV); float* stats = (float*)(ws + WS_STATS); float* bias2 = (float*)(ws + WS_BIAS2);
    float* lse = (float*)(ws + WS_LSE); float* rope = (float*)(ws + WS_ROPE);
    bf16* Win_t = (bf16*)(ws + WS_WIN); bf16* Wqb_t = (bf16*)(ws + WS_WQB); bf16* Wkvb_t = (bf16*)(ws + WS_WKVB); bf16* Womla_t = (bf16*)(ws + WS_WOMLA);
    bf16* Wodswa_t = (bf16*)(ws + WS_WODSWA); bf16* Wout_t = (bf16*)(ws + WS_WOUT);
    bf16* Hb = (bf16*)(ws + WS_H); bf16* proj = (bf16*)(ws + WS_PROJ); bf16* Qmla = (bf16*)(ws + WS_QMLA); bf16* KVmla = (bf16*)(ws + WS_KVMLA); bf16* Kpe = (bf16*)(ws + WS_K8);
    bf16* Amla = (bf16*)(ws + WS_AMLA); bf16* Odswa = (bf16*)(ws + WS_ODSWA); bf16* Bdswa = (bf16*)(ws + WS_BDSWA); bf16* Tm = (bf16*)(ws + WS_T); unsigned char* T8 = ws + WS_H + 32 * MiB;
    const int NGW = G * NWAVES, NGT = G * NWAVES * 64;
#define PHASE_IDS() const int tid = opaque_tid(), lane = tid & 63, wave = __builtin_amdgcn_readfirstlane(tid >> 6), gw = vcu * NWAVES + wave, gt = bx * (NWAVES * 64) + tid; (void)lane; (void)gw; (void)gt

    for (int rep = 0; rep < REP0; ++rep) {
        PHASE_IDS();
        LAS float* scr = (LAS float*)(ldsl + wave * 16384);
        constexpr int I_IN = 64 * 690, I_QB = 16 * 96, I_KVB = 8 * 128, I_OM = 32 * 128, I_OD = 16 * 128, I_OUT = 64 * 128;
        constexpr int NITEMS = I_IN + I_QB + I_KVB + I_OM + I_OD + I_OUT;
        for (int it = gw; it < NITEMS; it += NGW) {
            int r = it;
            if (r < I_IN) { const int kb = r / 690, nb = r % 690; int db, ds; if (nb < 48) { db = nb * 32; ds = 1; } else if (nb == 48) { db = C_KPE; ds = 2; } else if (nb == 49) { db = C_KPE + 1; ds = 2; } else { db = nb * 32 - 64; ds = 1; }
                transpose_item8(w_in, 4096, IN_W, (unsigned char*)Win_t, kb * 64, nb * 32, db, ds, W_SC, scr, lane); continue; } r -= I_IN;
            if (r < I_QB) { const int kb = r / 96, nb = r % 96, hq = nb / 6, bi = nb % 6; int db, ds; if (bi < 4) { db = hq * 192 + bi * 32; ds = 1; } else { db = hq * 192 + 128 + (bi - 4); ds = 2; }
                transpose_item(w_qb, 1024, 3072, Wqb_t, kb * 64, nb * 32, db, ds, qa_g, scr, lane); continue; } r -= I_QB;
            if (r < I_KVB) { const int kb = r / 128, nb = r % 128; transpose_item(w_kvb, 512, 4096, Wkvb_t, kb * 64, nb * 32, nb * 32, 1, kva_g, scr, lane); continue; } r -= I_KVB;
            if (r < I_OM) { const int kb = r / 128, nb = r % 128; transpose_item8(w_omla, 2048, 4096, (unsigned char*)Womla_t, kb * 64, nb * 32, nb * 32, 1, W_OM_SC, scr, lane); continue; } r -= I_OM;
            if (r < I_OD) { const int kb = r / 128, nb = r % 128; transpose_item8(w_odswa, 1024, 4096, (unsigned char*)Wodswa_t, kb * 64, nb * 32, nb * 32, 1, W_OD_SC, scr, lane); continue; } r -= I_OD;
            { const int kb = r / 128, nb = r % 128; transpose_item8(w_out, 4096, 4096, (unsigned char*)Wout_t, kb * 64, nb * 32, nb * 32, 1, W_OUT_SC, scr, lane); }
        }
        for (int m = gw; m < SEQ; m += NGW) {
            const f32x4* xr = (const f32x4*)(x + (size_t)m * DM) + lane;
            f32x4 v[16]; float s = 0.f;
#pragma unroll
            for (int j = 0; j < 16; ++j) { v[j] = xr[64 * j]; s += (v[j].x + v[j].y) + (v[j].z + v[j].w); }
            const float mean = wave_sum(s) * (1.f / DM); float s2 = 0.f;
#pragma unroll
            for (int j = 0; j < 16; ++j) { v[j] = v[j] - mean; s2 += (v[j].x * v[j].x + v[j].y * v[j].y) + (v[j].z * v[j].z + v[j].w * v[j].w); }
            const float rstd = 1.f / sqrtf(wave_sum(s2) * (1.f / DM) + LN_EPS);
            if (lane == 0) { stats[2 * m] = mean; stats[2 * m + 1] = rstd; }
            int* o4 = (int*)((unsigned char*)Hb + (size_t)m * DM) + lane;
#pragma unroll
            for (int j = 0; j < 16; ++j) { const f32x4 gv = ((const f32x4*)emb_g)[64 * j + lane], bv = ((const f32x4*)emb_b)[64 * j + lane]; const f32x4 y = (v[j] * rstd * gv + bv) * H_SC;
                int d = __builtin_amdgcn_cvt_pk_fp8_f32(y.x, y.y, 0, false); d = __builtin_amdgcn_cvt_pk_fp8_f32(y.z, y.w, d, true); o4[64 * j] = d; }
        }
        for (int e = gt; e < SEQ * 32; e += NGT) { const int pos = e >> 5, i = e & 31; const float invf = 1.0f / powf(10000.0f, (float)(2 * i) / 64.0f); const float ang = (float)pos * invf;
            double t = (double)ang * 0.15915494309189535; t -= __builtin_floor(t); const float tf = (float)t;
            rope[2 * e] = __builtin_amdgcn_cosf(tf); rope[2 * e + 1] = __builtin_amdgcn_sinf(tf); }
        for (int e = gt; e < 3 * 8 * 129; e += NGT) { const int j = e % 129 - 64, hh = (e / 129) % 8, g = e / (129 * 8), dil = 1 << (2 * g); const int rel = j * dil, n = rel < 0 ? -rel : rel;
            int bk; if (n < 8) bk = n; else { const float nf = (float)n; int lg = 8 + (int)(logf(nf / 8.f) / 4.852030263919617f * 8.f); bk = lg < 15 ? lg : 15; }
            if (rel > 0) bk += 16;
            bias2[e] = rel_bias[bk * 24 + g * 8 + hh] * LOG2E; }
        for (int e = gt; e < 2 * SEQ; e += NGT) rss_q[e] = 0.f;
    }
    grid.sync();

    for (int rep = 0; rep < REP1; ++rep) {
        pg8::Gemm g{Hb, Win_t, SEQ, LDP, 2048, 2048, 2048}; pg8::StaticOrder S; S.init(SEQ, LDP, G, bx);
        pg8::EpiProj E{proj, Kpe, rep ? nullptr : rss_q, rep ? nullptr : rss_kv, rope, 1.f / (H_SC * W_SC)};
        pg8::gemm_phase<pg8::EpiProj, pg8::StaticOrder, true, true, true>(ldsl, g, S, E);
    }
    grid.sync();

    for (int rep = 0; rep < REP2; ++rep) {
        { pg8::Gemm g{proj + C_QA, Wqb_t, SEQ, 3072, 1024, LDP, 1024}; pg8::StaticOrder S; S.init(SEQ, 3072, G, bx);
          pg8::EpiQ E{Qmla, rss_q, rope}; pg8::gemm_phase<pg8::EpiQ, pg8::StaticOrder, true, true>(ldsl, g, S, E); }
        { pg8::Gemm g{proj + C_CKV, Wkvb_t, SEQ, 4096, 512, LDP, 512}; pg8::StaticOrder S; S.init(SEQ, 4096, G, bx);
          pg8::EpiKV E{KVmla, rss_kv, (unsigned char*)Kpe}; pg8::gemm_phase<pg8::EpiKV, pg8::StaticOrder, true, true>(ldsl, g, S, E); }
        __syncthreads();
        for (int u = vcu; u < 768; u += G) { const int H = u >> 5, rem = u & 31, g = H >> 3, nqb = 32 >> (2 * g); att::dswa_unit(H, rem / nqb, rem % nqb, proj, bias2, Odswa, lse, (char*)lds); }
    }
    grid.sync();

    for (int rep = 0; rep < REP3; ++rep) {
        for (int u = vcu; u < 512; u += G) { const int h = u >> 5, qb = u & 31; const size_t r0 = (size_t)qb * 256;
            att::mla_unit((const bf16*)((const unsigned char*)Qmla + r0 * 3072 + h * 192), (const bf16*)((const unsigned char*)Kpe + (size_t)h * SEQ * 256), KVmla + h * 256 + 128, Kpe, proj + r0 * LDP + C_GMLA + h * 128, (bf16*)((unsigned char*)Amla + r0 * 2048 + h * 128), (char*)lds, ldsl); }
        PHASE_IDS();
        for (int it = gt; it < SEQ * 128; it += NGT) { const int pos = it >> 7, c8 = it & 127, hh = c8 >> 4, col = c8 * 8;
            const float l0 = lse[((size_t)0 * SEQ + pos) * 8 + hh], l1 = lse[((size_t)1 * SEQ + pos) * 8 + hh], l2 = lse[((size_t)2 * SEQ + pos) * 8 + hh];
            const float mx = fmaxf(l0, fmaxf(l1, l2)); float e0 = __builtin_amdgcn_exp2f(l0 - mx), e1 = __builtin_amdgcn_exp2f(l1 - mx), e2 = __builtin_amdgcn_exp2f(l2 - mx);
            const float inv = 1.f / (e0 + e1 + e2); e0 *= inv; e1 *= inv; e2 *= inv;
            const v4u a0 = *(const v4u*)(Odswa + ((size_t)0 * SEQ + pos) * 1024 + col), a1 = *(const v4u*)(Odswa + ((size_t)1 * SEQ + pos) * 1024 + col), a2 = *(const v4u*)(Odswa + ((size_t)2 * SEQ + pos) * 1024 + col);
            const v4u gg = *(const v4u*)(proj + (size_t)pos * LDP + C_GDSWA + col);
#define MLO(k) ((pg8::bflo(a0[k]) * e0 + pg8::bflo(a1[k]) * e1 + pg8::bflo(a2[k]) * e2) * pg8::bflo(gg[k]) * B_SC)
#define MHI(k) ((pg8::bfhi(a0[k]) * e0 + pg8::bfhi(a1[k]) * e1 + pg8::bfhi(a2[k]) * e2) * pg8::bfhi(gg[k]) * B_SC)
            *(pg8::i32x2*)((unsigned char*)Bdswa + (size_t)pos * 1024 + col) = (pg8::i32x2){pg8::cvt4_fp8(MLO(0), MHI(0), MLO(1), MHI(1)), pg8::cvt4_fp8(MLO(2), MHI(2), MLO(3), MHI(3))}; }
#undef MLO
#undef MHI
    }
    grid.sync();

    for (int rep = 0; rep < REP4; ++rep) {
        { pg8::Gemm g{Amla, Womla_t, SEQ, 4096, 1024, 1024, 1024}; pg8::StaticOrder S; S.init(SEQ, 4096, G, bx);
          pg8::EpiY<0> E{Tm, proj + C_RMLA, T8}; pg8::gemm_phase<pg8::EpiY<0>, pg8::StaticOrder, true, true, true>(ldsl, g, S, E); }
        { pg8::Gemm g{Bdswa, Wodswa_t, SEQ, 4096, 512, 512, 512}; pg8::StaticOrder S; S.init(SEQ, 4096, G, bx);
          pg8::EpiY<1> E{Tm, proj + C_RDSWA, T8}; pg8::gemm_phase<pg8::EpiY<1>, pg8::StaticOrder, true, true, true>(ldsl, g, S, E); }
    }
    grid.sync();

    for (int rep = 0; rep < REP5; ++rep) {
        pg8::Gemm g{(const bf16*)T8, Wout_t, SEQ, 4096, 2048, 2048, 2048}; pg8::StaticOrder S; S.init(SEQ, 4096, G, bx);
        pg8::EpiOut E{x, stats, emb_g, emb_b, a.out, 1.f / (T_SC * W_OUT_SC)}; pg8::gemm_phase<pg8::EpiOut, pg8::StaticOrder, true, true, true>(ldsl, g, S, E);
    }
    grid.sync();

    { PHASE_IDS();
    for (int m = gw; m < SEQ; m += NGW) {
        f32x4* xr = (f32x4*)(a.out + (size_t)m * DM) + lane;
        f32x4 v[16]; float s = 0.f;
#pragma unroll
        for (int j = 0; j < 16; ++j) { v[j] = xr[64 * j]; s += (v[j].x + v[j].y) + (v[j].z + v[j].w); }
        const float mean = wave_sum(s) * (1.f / DM); float s2 = 0.f;
#pragma unroll
        for (int j = 0; j < 16; ++j) { v[j] = v[j] - mean; s2 += (v[j].x * v[j].x + v[j].y * v[j].y) + (v[j].z * v[j].z + v[j].w * v[j].w); }
        const float rstd = 1.f / sqrtf(wave_sum(s2) * (1.f / DM) + LN_EPS);
#pragma unroll
        for (int j = 0; j < 16; ++j) { const f32x4 gv = ((const f32x4*)ln_g)[64 * j + lane], bv = ((const f32x4*)ln_b)[64 * j + lane]; xr[64 * j] = v[j] * rstd * gv + bv; }
    } }
}

extern "C" void kernel_launch(void* const* d_in, const int* in_sizes, int n_in, void* d_out, int out_size, void* d_ws, size_t ws_size, hipStream_t stream) {
    static int grid = 0;
    if (grid == 0) {
        if (n_in != 14 || in_sizes[0] != SEQ * DM || out_size != SEQ * DM || ws_size < WS_END) { fprintf(stderr, "kernel_launch: unexpected shapes (n_in %d, in0 %d, out %d, ws %zu < %zu)\n", n_in, n_in > 0 ? in_sizes[0] : -1, out_size, ws_size, (size_t)WS_END); grid = -1; return; }
        int dev = 0, cus = 0, per_cu = 0;
        if (hipGetDevice(&dev) != hipSuccess || hipDeviceGetAttribute(&cus, hipDeviceAttributeMultiprocessorCount, dev) != hipSuccess) { grid = -1; return; }
        if (hipFuncSetAttribute((const void*)fwd_mega, hipFuncAttributeMaxDynamicSharedMemorySize, LDS_BYTES) != hipSuccess) { fprintf(stderr, "kernel_launch: hipFuncSetAttribute failed\n"); grid = -1; return; }
        if (hipOccupancyMaxActiveBlocksPerMultiprocessor(&per_cu, (const void*)fwd_mega, NWAVES * 64, LDS_BYTES) != hipSuccess || per_cu < 1) { fprintf(stderr, "kernel_launch: occupancy query says %d blocks per CU\n", per_cu); per_cu = 1; }
        (void)hipGetLastError();
        grid = cus;
    }
    if (grid < 0) return;
    Args a{};
    for (int i = 0; i < 14; ++i) a.in[i] = (const float*)d_in[i];
    a.out = (float*)d_out; a.ws = (unsigned char*)d_ws;
    void* args[] = {&a};
    hipError_t e = hipLaunchCooperativeKernel((const void*)fwd_mega, dim3(grid), dim3(NWAVES * 64), args, LDS_BYTES, stream);
    if (e != hipSuccess) fprintf(stderr, "kernel_launch: cooperative launch failed: %s (grid %d)\n", hipGetErrorString(e), grid);
}
```

```cpp
#include <hip/hip_runtime.h>
#include <hip/hip_cooperative_groups.h>
#include <cstdio>
#include <cstdint>
#include <cmath>
namespace cg = cooperative_groups;

constexpr int SEQ = 8192, DM = 4096;
constexpr int LDP = 22272;
constexpr int C_QA = 0, C_CKV = 1024, C_DQ = 1536, C_DK = 4608, C_DV = 7680, C_GMLA = 10752, C_GDSWA = 12800, C_RMLA = 13824, C_RDSWA = 17920, C_KPE = 22016;
constexpr int IN_W = 22080;
constexpr float LOG2E = 1.4426950408889634f;
constexpr float QS_D = 0.08838834764831845f * LOG2E;
constexpr float QS_M = 0.07216878364870323f * LOG2E;
constexpr float ALPHA = 1.189207115002721f;
constexpr float LN_EPS = 1e-5f, RMS_EPS = 1e-6f;
constexpr float Q8_SC = 64.f, K8_SC = 16.f, V8_SC = 64.f;
constexpr float A_SC = 256.f, B_SC = 128.f, T_SC = 512.f, W_OM_SC = 1024.f, W_OD_SC = 1024.f, W_OUT_SC = 2048.f;

__device__ __forceinline__ int opaque_tid() { int t = threadIdx.x; asm volatile("" : "+v"(t)); return t; }

namespace pg8 {
#define PG8_LAS __attribute__((address_space(3)))
typedef unsigned short bf16_t;
typedef short bf16x8 __attribute__((ext_vector_type(8)));
typedef float f32x4 __attribute__((ext_vector_type(4)));
typedef unsigned u32x4 __attribute__((ext_vector_type(4)));
constexpr int BM = 256, BK = 64, HALF = 128, HTB = HALF * BK * 2  , STAGE_BYTES = 8 * HTB, NXCD = 8, WGM = 8;

__host__ __device__ __forceinline__ int lds_byte(int r, int c) { const int st = (r >> 4) * 2 + (c >> 5), rr = r & 15, cc = c & 31, ob = rr * 64 + cc * 2; return st * 1024 + (ob ^ (((ob >> 9) & 1) << 5)); }
__host__ __device__ __forceinline__ void stage_rc(int b, int& R, int& C) { const int st = b / 1024, sb = b % 1024, swz = sb ^ (((sb >> 9) & 1) << 5); R = (st >> 1) * 16 + swz / 64; C = (st & 1) * 32 + (swz % 64) / 2; }
__host__ __device__ __forceinline__ int perm32(int rho) { const int n = rho >> 4, i = rho & 15; return 8 * (i >> 2) + 4 * n + (i & 3); }

struct Unit { int pm, pn; };
struct Gemm { const bf16_t* A; const bf16_t* Bt; int M, N, K, lda, ldb; };

struct StaticOrder {
    int nM, nN, nwg, G, c;
    __host__ __device__ void init(int M, int N, int G_, int c_) { nM = M / BM; nN = N / BM; nwg = nM * nN; G = G_; c = c_; }
    __host__ __device__ bool next(int i, Unit& u) const {
        const long L = (long)i * G + c; if (L >= nwg) return false;
        int wgid = (int)L; { const int q = nwg / NXCD, r = nwg % NXCD, xcd = wgid % NXCD, off = wgid / NXCD; wgid = (xcd < r ? xcd * (q + 1) : r * (q + 1) + (xcd - r) * q) + off; }
        const int nig = WGM * nN, gid = wgid / nig, fm = gid * WGM, gsz = (nM - fm) < WGM ? (nM - fm) : WGM;
        u.pm = fm + ((wgid % nig) % gsz); u.pn = (wgid % nig) / gsz; return true;
    }
    __device__ __forceinline__ void a_ready(const Unit&) const {}
    __device__ __forceinline__ void done(const Unit&) const {}
};


typedef float f32x2 __attribute__((ext_vector_type(2))); typedef __bf16 bf16x2_t __attribute__((ext_vector_type(2)));
typedef int i32x4 __attribute__((ext_vector_type(4))); typedef int i32x8 __attribute__((ext_vector_type(8)));
__device__ __forceinline__ i32x8 cat8(bf16x8 a, bf16x8 b) { return __builtin_shufflevector(__builtin_bit_cast(i32x4, a), __builtin_bit_cast(i32x4, b), 0, 1, 2, 3, 4, 5, 6, 7); }
__device__ __forceinline__ unsigned cvt_pk_bf16(float lo, float hi) { f32x2 v = {lo, hi}; bf16x2_t b = __builtin_convertvector(v, bf16x2_t); return __builtin_bit_cast(unsigned, b); }
typedef int i32x2 __attribute__((ext_vector_type(2)));
__device__ __forceinline__ int cvt4_fp8(float a, float b, float c, float d) { a = __builtin_amdgcn_fmed3f(a, -440.f, 440.f); b = __builtin_amdgcn_fmed3f(b, -440.f, 440.f); c = __builtin_amdgcn_fmed3f(c, -440.f, 440.f); d = __builtin_amdgcn_fmed3f(d, -440.f, 440.f);
    int r = __builtin_amdgcn_cvt_pk_fp8_f32(a, b, 0, false); return __builtin_amdgcn_cvt_pk_fp8_f32(c, d, r, true); }
__device__ __forceinline__ float bflo(unsigned w) { return __uint_as_float(w << 16); }
__device__ __forceinline__ float bfhi(unsigned w) { return __uint_as_float(w & 0xffff0000u); }
__device__ __forceinline__ float sigm(float x) { return __builtin_amdgcn_rcpf(1.f + __builtin_amdgcn_exp2f(-x * 1.4426950408889634f)); }
__device__ __forceinline__ u32x4 pack8(const f32x4 v0, const f32x4 v1) { u32x4 w; w.x = cvt_pk_bf16(v0[0], v0[1]); w.y = cvt_pk_bf16(v0[2], v0[3]); w.z = cvt_pk_bf16(v1[0], v1[1]); w.w = cvt_pk_bf16(v1[2], v1[3]); return w; }
__device__ __forceinline__ void rope8(f32x4& v0, f32x4& v1, const f32x4 cs0, const f32x4 cs1) {
    const float a0 = v0[0] * cs0[0] - v0[1] * cs0[1], b0 = v0[1] * cs0[0] + v0[0] * cs0[1];
    const float a1 = v0[2] * cs0[2] - v0[3] * cs0[3], b1 = v0[3] * cs0[2] + v0[2] * cs0[3];
    const float a2 = v1[0] * cs1[0] - v1[1] * cs1[1], b2 = v1[1] * cs1[0] + v1[0] * cs1[1];
    const float a3 = v1[2] * cs1[2] - v1[3] * cs1[3], b3 = v1[3] * cs1[2] + v1[2] * cs1[3];
    v0 = (f32x4){a0, b0, a1, b1}; v1 = (f32x4){a2, b2, a3, b3};
}

struct EpiProj {
    static constexpr bool PERM = true, AFTER_DRAIN = false;
    bf16_t* proj; bf16_t* kpe; float* rss_q; float* rss_kv; const float* rope; float osc;
    template <int ACT> __device__ __forceinline__ void body(const f32x4 (&acc)[2][2][4][2], const Unit& u, int wr, int wc, int fr, int fq, float sc, float* rss) const {
        const int row0 = u.pm * BM + wr * 64 + fr, col0 = u.pn * BM + wc * 32 + 8 * fq;
#pragma unroll
        for (int ai = 0; ai < 2; ++ai)
#pragma unroll
            for (int m = 0; m < 4; ++m) { const int row = row0 + ai * HALF + m * 16; bf16_t* rowp = proj + (size_t)row * LDP + col0; float ss = 0.f;
#pragma unroll
                for (int bj = 0; bj < 2; ++bj) { f32x4 v0 = acc[ai][bj][m][0] * sc, v1 = acc[ai][bj][m][1] * sc;
                    if (ACT == 1) {
#pragma unroll
                        for (int e = 0; e < 4; ++e) { v0[e] = v0[e] * sigm(v0[e]); v1[e] = v1[e] * sigm(v1[e]); } }
                    if (ACT == 2) {
#pragma unroll
                        for (int e = 0; e < 4; ++e) { v0[e] = sigm(v0[e]); v1[e] = sigm(v1[e]); } }
                    if (ACT == 3) { ss += (v0[0] * v0[0] + v0[1] * v0[1]) + (v0[2] * v0[2] + v0[3] * v0[3]) + (v1[0] * v1[0] + v1[1] * v1[1]) + (v1[2] * v1[2] + v1[3] * v1[3]); }
                    *(u32x4*)(rowp + bj * HALF) = pack8(v0, v1); }
                if (ACT == 3) { ss += __shfl_xor(ss, 16); ss += __shfl_xor(ss, 32); if (fq == 0 && rss) atomicAdd(rss + row, ss); } }
    }
    __device__ __forceinline__ void operator()(const f32x4 (&acc)[2][2][4][2], const Unit& u, int wr, int wc, int fr, int fq) const {
        const int pn = u.pn;
        if (pn < 4) body<3>(acc, u, wr, wc, fr, fq, osc, rss_q);
        else if (pn < 6) body<3>(acc, u, wr, wc, fr, fq, osc, rss_kv);
        else if (pn < 42) body<0>(acc, u, wr, wc, fr, fq, pn < 18 ? QS_D * osc : osc, nullptr);
        else if (pn < 54) body<1>(acc, u, wr, wc, fr, fq, osc, nullptr);
        else if (pn < 86) body<2>(acc, u, wr, wc, fr, fq, osc, nullptr);
        else if (wc < 2) {
            const int row0 = u.pm * BM + wr * 64 + fr, c0 = wc * 32 + 8 * fq;
#pragma unroll
            for (int ai = 0; ai < 2; ++ai)
#pragma unroll
                for (int m = 0; m < 4; ++m) { const int row = row0 + ai * HALF + m * 16; f32x4 v0 = acc[ai][0][m][0] * osc, v1 = acc[ai][0][m][1] * osc;
                    const f32x4* cs = (const f32x4*)(rope + (size_t)row * 64 + c0); rope8(v0, v1, cs[0], cs[1]);
                    v0 = v0 * K8_SC; v1 = v1 * K8_SC; const i32x2 w8 = {cvt4_fp8(v0[0], v0[1], v0[2], v0[3]), cvt4_fp8(v1[0], v1[1], v1[2], v1[3])};
#pragma unroll
                    for (int hh = 0; hh < 16; ++hh) *(i32x2*)((unsigned char*)kpe + ((size_t)hh * SEQ + row) * 256 + 128 + c0) = w8; }
        }
    }
};
struct EpiQ {
    static constexpr bool PERM = true, AFTER_DRAIN = false;
    bf16_t* q; const float* rss; const float* rope;
    __device__ __forceinline__ void operator()(const f32x4 (&acc)[2][2][4][2], const Unit& u, int wr, int wc, int fr, int fq) const {
        const int row0 = u.pm * BM + wr * 64 + fr, col0 = u.pn * BM + wc * 32 + 8 * fq;
        const int cw0 = col0 % 192, cw1 = (col0 + HALF) % 192;
#pragma unroll
        for (int ai = 0; ai < 2; ++ai)
#pragma unroll
            for (int m = 0; m < 4; ++m) { const int row = row0 + ai * HALF + m * 16; const float sc = QS_M / sqrtf(rss[row] * (1.f / 1024.f) + RMS_EPS);
#pragma unroll
                for (int bj = 0; bj < 2; ++bj) { f32x4 v0 = acc[ai][bj][m][0] * sc, v1 = acc[ai][bj][m][1] * sc; const int cw = bj ? cw1 : cw0;
                    if (cw >= 128) { const f32x4* cs = (const f32x4*)(rope + (size_t)row * 64 + (cw - 128)); rope8(v0, v1, cs[0], cs[1]); }
                    v0 = v0 * Q8_SC; v1 = v1 * Q8_SC; *(i32x2*)((unsigned char*)q + (size_t)row * 3072 + col0 + bj * HALF) = (i32x2){cvt4_fp8(v0[0], v0[1], v0[2], v0[3]), cvt4_fp8(v1[0], v1[1], v1[2], v1[3])}; } }
    }
};
struct EpiKV {
    static constexpr bool PERM = true, AFTER_DRAIN = false;
    unsigned char* vt8; const float* rss; unsigned char* k8;
    __device__ __forceinline__ void operator()(const f32x4 (&acc)[2][2][4][2], const Unit& u, int wr, int wc, int fr, int fq) const {
        const int row0 = u.pm * BM + wr * 64 + fr, dl = wc * 32 + 8 * fq;
#pragma unroll
        for (int ai = 0; ai < 2; ++ai)
#pragma unroll
            for (int m = 0; m < 4; ++m) { const int row = row0 + ai * HALF + m * 16; const float sc = 1.f / sqrtf(rss[row] * (1.f / 512.f) + RMS_EPS);
                { const f32x4 k0v = acc[ai][0][m][0] * (sc * K8_SC), k1v = acc[ai][0][m][1] * (sc * K8_SC);
                  *(i32x2*)(k8 + ((size_t)u.pn * SEQ + row) * 256 + dl) = (i32x2){cvt4_fp8(k0v[0], k0v[1], k0v[2], k0v[3]), cvt4_fp8(k1v[0], k1v[1], k1v[2], k1v[3])}; }
                const f32x4 v0 = acc[ai][1][m][0] * (sc * V8_SC), v1 = acc[ai][1][m][1] * (sc * V8_SC);
                const unsigned w0 = (unsigned)cvt4_fp8(v0[0], v0[1], v0[2], v0[3]), w1 = (unsigned)cvt4_fp8(v1[0], v1[1], v1[2], v1[3]);
                const int kt = m * 16 + fr, kk = kt & 31, pi = ((kk >> 2) & 1) * 32 + (kk & 3) + 4 * (kk >> 3) + 16 * (kt >> 5);
                unsigned char* vp = vt8 + ((size_t)u.pn * 128 + dl) * SEQ + (row & ~63) + pi;
#pragma unroll
                for (int e2 = 0; e2 < 4; ++e2) { vp[(size_t)e2 * SEQ] = (unsigned char)(w0 >> (8 * e2)); vp[(size_t)(4 + e2) * SEQ] = (unsigned char)(w1 >> (8 * e2)); } }
    }
};
template <int PASS> struct EpiY {
    static constexpr bool PERM = true, AFTER_DRAIN = false;
    bf16_t* T; const bf16_t* gate; unsigned char* T8;
    __device__ __forceinline__ void operator()(const f32x4 (&acc)[2][2][4][2], const Unit& u, int wr, int wc, int fr, int fq) const {
        const int row0 = u.pm * BM + wr * 64 + fr, col0 = u.pn * BM + wc * 32 + 8 * fq;
        constexpr float osc = PASS == 0 ? 1.f / (A_SC * W_OM_SC) : 1.f / (B_SC * W_OD_SC), tsc = T_SC;
#pragma unroll
        for (int ai = 0; ai < 2; ++ai)
#pragma unroll
            for (int m = 0; m < 4; ++m) { const int row = row0 + ai * HALF + m * 16;
#pragma unroll
                for (int bj = 0; bj < 2; ++bj) { const u32x4 gw = *(const u32x4*)(gate + (size_t)row * LDP + col0 + bj * HALF); bf16_t* tp = T + (size_t)row * 4096 + col0 + bj * HALF;
                    f32x4 v0 = acc[ai][bj][m][0] * osc, v1 = acc[ai][bj][m][1] * osc;
                    v0 = v0 * (f32x4){bflo(gw.x), bfhi(gw.x), bflo(gw.y), bfhi(gw.y)}; v1 = v1 * (f32x4){bflo(gw.z), bfhi(gw.z), bflo(gw.w), bfhi(gw.w)};
                    if (PASS == 0) { *(u32x4*)tp = pack8(v0, v1); }
                    else { const u32x4 tw = *(const u32x4*)tp; v0 = (v0 + (f32x4){bflo(tw.x), bfhi(tw.x), bflo(tw.y), bfhi(tw.y)}) * tsc; v1 = (v1 + (f32x4){bflo(tw.z), bfhi(tw.z), bflo(tw.w), bfhi(tw.w)}) * tsc;
                        *(i32x2*)(T8 + (size_t)row * 4096 + col0 + bj * HALF) = (i32x2){cvt4_fp8(v0[0], v0[1], v0[2], v0[3]), cvt4_fp8(v1[0], v1[1], v1[2], v1[3])}; } } }
    }
};
struct EpiOut {
    static constexpr bool PERM = false, AFTER_DRAIN = false;
    const float* x; const float* stats; const float* g; const float* b; float* out; float osc;
    __device__ __forceinline__ void operator()(const f32x4 (&acc)[2][2][4][2], const Unit& u, int wr, int wc, int fr, int fq) const {
        const int row0 = u.pm * BM + wr * 64 + fr, col0 = u.pn * BM + wc * 32 + 4 * fq;
#pragma unroll
        for (int bj = 0; bj < 2; ++bj)
#pragma unroll
            for (int n = 0; n < 2; ++n) { const int col = col0 + bj * HALF + n * 16; const f32x4 gv = *(const f32x4*)(g + col) * ALPHA, bv = *(const f32x4*)(b + col) * ALPHA;
#pragma unroll
                for (int ai = 0; ai < 2; ++ai)
#pragma unroll
                    for (int m = 0; m < 4; ++m) { const int row = row0 + ai * HALF + m * 16; const f32x2 st = *(const f32x2*)(stats + 2 * row);
                        const size_t off = (size_t)row * 4096 + col; const f32x4 xv = *(const f32x4*)(x + off);
                        *(f32x4*)(out + off) = ((xv - st.x) * st.y) * gv + bv + acc[ai][bj][m][n] * osc; } }
    }
};

template <class Epi, class Sched, bool ALIGN_EPI = false, bool SP2 = false, bool FP8 = false>
__device__ __forceinline__ void gemm_phase(PG8_LAS unsigned char* lds, const Gemm g, const Sched S, const Epi E) {
    const int tid = opaque_tid(), wid = __builtin_amdgcn_readfirstlane(tid >> 6), lane = tid & 63, wr = wid >> 2, wc = wid & 3, fr = lane & 15, fq = lane >> 4;
    const int K = g.K, nt = K / BK;
    unsigned voffA[2], voffB[2];
#pragma unroll
    for (int i = 0; i < 2; ++i) { int R, C; stage_rc(tid * 16 + i * 8192, R, C); const int Rb = Epi::PERM ? ((R & ~31) + perm32(R & 31)) : R;
        voffA[i] = (unsigned)(R * g.lda + C) * 2u; voffB[i] = (unsigned)(Rb * g.ldb + C) * 2u; }
    const size_t kstep = (size_t)(BK * 2);
    const size_t hstepA = (size_t)HALF * g.lda * 2, hstepB = (size_t)HALF * g.ldb * 2;
    const size_t tstepA = 2 * hstepA, tstepB = 2 * hstepB;
    const unsigned ldsw = (unsigned)wid * 1024u;
    const int aoff = lds_byte(wr * 64 + fr, fq * 8), boff = lds_byte(wc * 32 + fr, fq * 8);
#define PG8_SA(b, h) (((b) * 2 + (h)) * HTB)
#define PG8_SB(b, h) ((4 + (b) * 2 + (h)) * HTB)
#define PG8_STAGE(bufoff, gbase, voff) do { _Pragma("unroll") for (int _i = 0; _i < 2; ++_i) \
        __builtin_amdgcn_global_load_lds((const unsigned*)((const char*)(gbase) + (voff)[_i]), (PG8_LAS unsigned*)(lds + (bufoff) + ldsw + _i * 8192), 16, 0, 0); } while (0)
#define PG8_LDA(dst, b, h) do { if constexpr (FP8) { _Pragma("unroll") for (int m = 0; m < 4; ++m) dst##8[m] = cat8(*(const PG8_LAS bf16x8*)(lds + PG8_SA(b, h) + aoff + m * 2048), *(const PG8_LAS bf16x8*)(lds + PG8_SA(b, h) + aoff + m * 2048 + 1024)); } \
    else { _Pragma("unroll") for (int m = 0; m < 4; ++m) _Pragma("unroll") for (int k = 0; k < 2; ++k) dst[m][k] = *(const PG8_LAS bf16x8*)(lds + PG8_SA(b, h) + aoff + m * 2048 + k * 1024); } } while (0)
#define PG8_LDB(dst, b, h) do { if constexpr (FP8) { _Pragma("unroll") for (int n = 0; n < 2; ++n) dst##8[n] = cat8(*(const PG8_LAS bf16x8*)(lds + PG8_SB(b, h) + boff + n * 2048), *(const PG8_LAS bf16x8*)(lds + PG8_SB(b, h) + boff + n * 2048 + 1024)); } \
    else { _Pragma("unroll") for (int n = 0; n < 2; ++n) _Pragma("unroll") for (int k = 0; k < 2; ++k) dst[n][k] = *(const PG8_LAS bf16x8*)(lds + PG8_SB(b, h) + boff + n * 2048 + k * 1024); } } while (0)
#define PG8_MMA(ai, bj, At, Bt) do { __builtin_amdgcn_s_setprio(1); if constexpr (FP8) { _Pragma("unroll") for (int m = 0; m < 4; ++m) _Pragma("unroll") for (int n = 0; n < 2; ++n) \
        asm volatile("v_mfma_f32_16x16x128_f8f6f4 %0, %1, %2, %0" : "+v"(acc[ai][bj][m][n]) : "v"(Bt##8[n]), "v"(At##8[m])); } else { \
        _Pragma("unroll") for (int m = 0; m < 4; ++m) _Pragma("unroll") for (int n = 0; n < 2; ++n) _Pragma("unroll") for (int k = 0; k < 2; ++k) \
        acc[ai][bj][m][n] = __builtin_amdgcn_mfma_f32_16x16x32_bf16(Bt[n][k], At[m][k], acc[ai][bj][m][n], 0, 0, 0); } __builtin_amdgcn_s_setprio(0); } while (0)
#define PG8_WAIT_V(n) asm volatile("s_waitcnt vmcnt(" #n ")" ::: "memory")
#define PG8_WAIT_L(n) asm volatile("s_waitcnt lgkmcnt(" #n ")" ::: "memory")
#define PG8_BAR __builtin_amdgcn_s_barrier()
#define PG8_SCHED __builtin_amdgcn_sched_barrier(0)
    Unit cur, nxt; int ui = 0;
    if (!S.next(0, cur)) return;
    f32x4 acc[2][2][4][2];
#pragma unroll
    for (int a = 0; a < 2; ++a)
#pragma unroll
        for (int b = 0; b < 2; ++b)
#pragma unroll
            for (int m = 0; m < 4; ++m)
#pragma unroll
                for (int n = 0; n < 2; ++n) acc[a][b][m][n] = (f32x4){0.f, 0.f, 0.f, 0.f};
    bf16x8 At[4][2], B0[2][2], B1[2][2]; i32x8 At8[4], B08[2], B18[2];
    const char* cA = (const char*)g.A + (size_t)cur.pm * tstepA; const char* cB = (const char*)g.Bt + (size_t)cur.pn * tstepB;
    S.a_ready(cur);
    if constexpr (SP2) {
        PG8_STAGE(PG8_SB(0, 0), cB, voffB); PG8_STAGE(PG8_SB(0, 1), cB + hstepB, voffB); PG8_STAGE(PG8_SA(0, 0), cA, voffA); PG8_STAGE(PG8_SA(0, 1), cA + hstepA, voffA);
        if (wr == 1) PG8_BAR;
        PG8_WAIT_V(2); PG8_BAR;
        PG8_STAGE(PG8_SB(1, 0), cB + kstep, voffB); PG8_STAGE(PG8_SA(1, 0), cA + kstep, voffA); PG8_STAGE(PG8_SB(1, 1), cB + hstepB + kstep, voffB);
        PG8_WAIT_V(6); PG8_BAR;
    } else {
        PG8_STAGE(PG8_SB(0, 0), cB, voffB); PG8_STAGE(PG8_SA(0, 0), cA, voffA); PG8_STAGE(PG8_SB(0, 1), cB + hstepB, voffB); PG8_STAGE(PG8_SA(0, 1), cA + hstepA, voffA);
        if (wr == 1) PG8_BAR;
        PG8_WAIT_V(4); PG8_BAR;
        PG8_STAGE(PG8_SB(1, 0), cB + kstep, voffB); PG8_STAGE(PG8_SA(1, 0), cA + kstep, voffA); PG8_STAGE(PG8_SB(1, 1), cB + hstepB + kstep, voffB);
        PG8_WAIT_V(6); PG8_BAR;
    }
    for (;;) {
        const bool has_next = S.next(ui + 1, nxt);
        const char* nA = has_next ? (const char*)g.A + (size_t)nxt.pm * tstepA : cA; const char* nB = has_next ? (const char*)g.Bt + (size_t)nxt.pn * tstepB : cB;
        for (int t = 0; t < nt; t += 2) {
            const bool last = (t == nt - 2);
            const char* a1 = cA + (size_t)(t + 1) * kstep;
            const char* a2 = last ? nA : cA + (size_t)(t + 2) * kstep; const char* b2 = last ? nB : cB + (size_t)(t + 2) * kstep;
            const char* a3 = a2 + kstep; const char* b3 = b2 + kstep;
            if (last && has_next) S.a_ready(nxt);
            if constexpr (SP2) {
            PG8_LDB(B0, 0, 0); PG8_LDB(B1, 0, 1); PG8_SCHED; PG8_LDA(At, 0, 0); PG8_STAGE(PG8_SA(1, 1), a1 + hstepA, voffA);
            PG8_WAIT_V(8); PG8_WAIT_L(0); PG8_BAR; PG8_MMA(0, 0, At, B0); PG8_MMA(0, 1, At, B1); PG8_BAR; PG8_SCHED;
            PG8_LDA(At, 0, 1); PG8_STAGE(PG8_SB(0, 0), b2, voffB); PG8_STAGE(PG8_SB(0, 1), b2 + hstepB, voffB); PG8_STAGE(PG8_SA(0, 0), a2, voffA);
            PG8_WAIT_V(8); PG8_WAIT_L(0); PG8_BAR; PG8_MMA(1, 0, At, B0); PG8_MMA(1, 1, At, B1); PG8_BAR; PG8_SCHED;
            PG8_LDB(B0, 1, 0); PG8_LDB(B1, 1, 1); PG8_SCHED; PG8_LDA(At, 1, 0); PG8_STAGE(PG8_SA(0, 1), a2 + hstepA, voffA);
            PG8_WAIT_V(8); PG8_WAIT_L(0); PG8_BAR; PG8_MMA(0, 0, At, B0); PG8_MMA(0, 1, At, B1); PG8_BAR; PG8_SCHED;
            PG8_LDA(At, 1, 1); PG8_STAGE(PG8_SB(1, 0), b3, voffB); PG8_STAGE(PG8_SB(1, 1), b3 + hstepB, voffB); PG8_STAGE(PG8_SA(1, 0), a3, voffA);
            PG8_WAIT_V(8); PG8_WAIT_L(0); PG8_BAR; PG8_MMA(1, 0, At, B0); PG8_MMA(1, 1, At, B1); PG8_BAR; PG8_SCHED;
            } else {
            PG8_LDB(B0, 0, 0); PG8_SCHED; PG8_LDA(At, 0, 0); PG8_STAGE(PG8_SA(1, 1), a1 + hstepA, voffA);
            PG8_WAIT_L(8); PG8_BAR; PG8_WAIT_L(0); PG8_MMA(0, 0, At, B0); PG8_BAR; PG8_SCHED;
            PG8_LDB(B1, 0, 1); PG8_STAGE(PG8_SB(0, 0), b2, voffB);
            PG8_BAR; PG8_WAIT_L(0); PG8_MMA(0, 1, At, B1); PG8_BAR;
            PG8_LDA(At, 0, 1); PG8_STAGE(PG8_SA(0, 0), a2, voffA);
            PG8_BAR; PG8_WAIT_L(0); PG8_MMA(1, 0, At, B0); PG8_BAR; PG8_SCHED;
            PG8_STAGE(PG8_SB(0, 1), b2 + hstepB, voffB);
            PG8_WAIT_V(6); PG8_BAR; PG8_MMA(1, 1, At, B1); PG8_BAR;
            PG8_LDB(B0, 1, 0); PG8_SCHED; PG8_LDA(At, 1, 0); PG8_STAGE(PG8_SA(0, 1), a2 + hstepA, voffA);
            PG8_WAIT_L(8); PG8_BAR; PG8_WAIT_L(0); PG8_MMA(0, 0, At, B0); PG8_BAR; PG8_SCHED;
            PG8_LDB(B1, 1, 1); PG8_STAGE(PG8_SB(1, 0), b3, voffB);
            PG8_BAR; PG8_WAIT_L(0); PG8_MMA(0, 1, At, B1); PG8_BAR;
            PG8_LDA(At, 1, 1); PG8_STAGE(PG8_SA(1, 0), a3, voffA);
            PG8_BAR; PG8_WAIT_L(0); PG8_MMA(1, 0, At, B0); PG8_BAR; PG8_SCHED;
            PG8_STAGE(PG8_SB(1, 1), b3 + hstepB, voffB);
            PG8_WAIT_V(6); PG8_BAR; PG8_MMA(1, 1, At, B1); PG8_BAR;
            }
        }
        if constexpr (ALIGN_EPI) { if (wr == 0) PG8_BAR; }
        if constexpr (FP8) asm volatile("s_nop 15\n\ts_nop 15" ::: "memory");
        if constexpr (!Epi::AFTER_DRAIN) { E(acc, cur, wr, wc, fr, fq); S.done(cur); }
        if (!has_next) break;
#pragma unroll
        for (int a = 0; a < 2; ++a)
#pragma unroll
            for (int b = 0; b < 2; ++b)
#pragma unroll
                for (int m = 0; m < 4; ++m)
#pragma unroll
                    for (int n = 0; n < 2; ++n) acc[a][b][m][n] = (f32x4){0.f, 0.f, 0.f, 0.f};
        cur = nxt; cA = nA; cB = nB; ++ui;
        if constexpr (ALIGN_EPI) { if (wr == 1) PG8_BAR; }
    }
    PG8_WAIT_V(0);
    if constexpr (!ALIGN_EPI) { if (wr == 0) PG8_BAR; }
    PG8_BAR;
    if constexpr (Epi::AFTER_DRAIN) { E.fused(acc, cur, wr, wc, fr, fq, lds, wid, lane); S.done(cur); }
#undef PG8_SA
#undef PG8_SB
#undef PG8_STAGE
#undef PG8_LDA
#undef PG8_LDB
#undef PG8_MMA
#undef PG8_WAIT_V
#undef PG8_WAIT_L
#undef PG8_BAR
#undef PG8_SCHED
}
}

namespace att {
typedef unsigned short bf16_t;
using bf16x8 = __attribute__((ext_vector_type(8))) short;
using s16x4  = __attribute__((ext_vector_type(4))) short;
using f32x16 = __attribute__((ext_vector_type(16))) float;
using u32x4  = __attribute__((ext_vector_type(4))) unsigned;
constexpr int NW = 8, QBLK = 32, KVBLK = 64;
constexpr int SHM_V = 16384, SHM_KN = 16384, SHM_KP = 8192;
constexpr int OFF_V = 0, OFF_KN = 2 * SHM_V, OFF_KP = OFF_KN + 2 * SHM_KN, OFF_WS = OFF_KP + 2 * SHM_KP, OFF_BIAS = OFF_WS + NW * 64 * 4, OFF_QPE = OFF_BIAS + 1024, ATT_LDS = OFF_QPE + NW * 4096, M_QPE = 3 * 40960 + 2048;
#define KSWZ(row, colB) ((row) * 256 + ((colB) ^ (((row) & 15) << 4)))
#define KPSWZ(row, colB) ((row) * 128 + ((colB) ^ ((((row) >> 1) & 7) << 4)))
#define SBAR() __builtin_amdgcn_sched_barrier(0)
__device__ __forceinline__ int crow(int r, int hi) { return (r & 3) + 8 * (r >> 2) + 4 * hi; }
typedef float f32x2_t __attribute__((ext_vector_type(2))); typedef __bf16 bf16x2_t __attribute__((ext_vector_type(2)));
__device__ __forceinline__ unsigned cvtpk(float lo, float hi) { f32x2_t v = {lo, hi}; bf16x2_t b = __builtin_convertvector(v, bf16x2_t); return __builtin_bit_cast(unsigned, b); }
__device__ __forceinline__ bf16x8 ld8(const bf16_t* p) { return *reinterpret_cast<const bf16x8*>(p); }

template <int THR2>
__device__ __forceinline__ void partialSM(f32x16& p0, f32x16& p1, float& m_reg, float& alpha, const float C = 1.f) {
  float pmax = p0[0];
#pragma unroll
  for (int r = 1; r < 16; ++r) pmax = fmaxf(pmax, p0[r]);
#pragma unroll
  for (int r = 0; r < 16; ++r) pmax = fmaxf(pmax, p1[r]);
  { auto rr = __builtin_amdgcn_permlane32_swap(__float_as_uint(pmax), __float_as_uint(pmax), false, false);
    pmax = fmaxf(__uint_as_float(rr[0]), __uint_as_float(rr[1])) * C; }
  float mn;
  if (THR2 > 0 && __builtin_expect(__all(pmax - m_reg <= (float)THR2), 1)) { mn = m_reg; alpha = 1.f; }
  else { mn = fmaxf(m_reg, pmax); alpha = __builtin_amdgcn_exp2f(m_reg - mn); m_reg = mn; }
#pragma unroll
  for (int r = 0; r < 16; ++r) p0[r] = fmaf(p0[r], C, -mn);
#pragma unroll
  for (int r = 0; r < 16; ++r) p1[r] = fmaf(p1[r], C, -mn);
#pragma unroll
  for (int r = 0; r < 16; ++r) p0[r] = __builtin_amdgcn_exp2f(p0[r]);
}
__device__ __forceinline__ void finishSM(f32x16& p0, f32x16& p1, float alpha, float& l_reg, bf16x8& pa0, bf16x8& pa1, bf16x8& pa2, bf16x8& pa3) {
#pragma unroll
  for (int r = 0; r < 16; ++r) p1[r] = __builtin_amdgcn_exp2f(p1[r]);
  float ps = 0;
#pragma unroll
  for (int r = 0; r < 16; ++r) ps += p0[r];
#pragma unroll
  for (int r = 0; r < 16; ++r) ps += p1[r];
  { auto rr = __builtin_amdgcn_permlane32_swap(__float_as_uint(ps), __float_as_uint(ps), false, false);
    ps = __uint_as_float(rr[0]) + __uint_as_float(rr[1]); }
  l_reg = l_reg * alpha + ps;
#define PK4(P, BASE, OUT) do { unsigned a0 = cvtpk(P[BASE + 0], P[BASE + 1]), a1 = cvtpk(P[BASE + 2], P[BASE + 3]);   \
    unsigned b0 = cvtpk(P[BASE + 4], P[BASE + 5]), b1 = cvtpk(P[BASE + 6], P[BASE + 7]);                              \
    auto r0 = __builtin_amdgcn_permlane32_swap(a0, b0, false, false); auto r1 = __builtin_amdgcn_permlane32_swap(a1, b1, false, false); \
    u32x4 w = {r0[0], r1[0], r0[1], r1[1]}; OUT = *reinterpret_cast<bf16x8*>(&w); } while (0)
  PK4(p0, 0, pa0); PK4(p0, 8, pa1); PK4(p1, 0, pa2); PK4(p1, 8, pa3);
#undef PK4
}
template <int NPE>
__device__ __forceinline__ void qkt(f32x16& p0, f32x16& p1, const char* Kn, const char* Kp, const bf16x8* qr, const char* qpe, int r32, int hi) {
  p0 = f32x16{}; p1 = f32x16{};
#pragma unroll
  for (int d0 = 0; d0 < 8; ++d0) { const int cb = (d0 * 16 + hi * 8) * 2;
    bf16x8 b0 = *reinterpret_cast<const bf16x8*>(Kn + KSWZ(r32, cb));
    bf16x8 b1 = *reinterpret_cast<const bf16x8*>(Kn + KSWZ(32 + r32, cb));
    p0 = __builtin_amdgcn_mfma_f32_32x32x16_bf16(b0, qr[d0], p0, 0, 0, 0);
    p1 = __builtin_amdgcn_mfma_f32_32x32x16_bf16(b1, qr[d0], p1, 0, 0, 0); }
#pragma unroll
  for (int d0 = 0; d0 < NPE; ++d0) { const int cb = (d0 * 16 + hi * 8) * 2;
    bf16x8 b0 = *reinterpret_cast<const bf16x8*>(Kp + KPSWZ(r32, cb));
    bf16x8 b1 = *reinterpret_cast<const bf16x8*>(Kp + KPSWZ(32 + r32, cb));
    p0 = __builtin_amdgcn_mfma_f32_32x32x16_bf16(b0, qr[8 + d0], p0, 0, 0, 0);
    p1 = __builtin_amdgcn_mfma_f32_32x32x16_bf16(b1, qr[8 + d0], p1, 0, 0, 0); }
}
typedef int i32x8 __attribute__((ext_vector_type(8))); typedef int i32x4 __attribute__((ext_vector_type(4)));
__device__ __forceinline__ void qkt8(f32x16& p0, f32x16& p1, const char* K8t, const i32x8* q8, int r32, int hi) {
  p0 = f32x16{}; p1 = f32x16{};
#pragma unroll
  for (int s = 0; s < 3; ++s) { const int cb = 64 * s + 32 * hi;
    const i32x4 a0 = *reinterpret_cast<const i32x4*>(K8t + KSWZ(r32, cb)), a1 = *reinterpret_cast<const i32x4*>(K8t + KSWZ(r32, cb + 16));
    const i32x4 c0 = *reinterpret_cast<const i32x4*>(K8t + KSWZ(32 + r32, cb)), c1 = *reinterpret_cast<const i32x4*>(K8t + KSWZ(32 + r32, cb + 16));
    p0 = __builtin_amdgcn_mfma_scale_f32_32x32x64_f8f6f4(__builtin_shufflevector(a0, a1, 0, 1, 2, 3, 4, 5, 6, 7), q8[s], p0, 0, 0, 0, 0, 0, 0);
    p1 = __builtin_amdgcn_mfma_scale_f32_32x32x64_f8f6f4(__builtin_shufflevector(c0, c1, 0, 1, 2, 3, 4, 5, 6, 7), q8[s], p1, 0, 0, 0, 0, 0, 0); }
}
__device__ __forceinline__ int cvt4nc(float a, float b, float c, float d) { const int r = __builtin_amdgcn_cvt_pk_fp8_f32(a, b, 0, false); return __builtin_amdgcn_cvt_pk_fp8_f32(c, d, r, true); }
__device__ __forceinline__ void finishSM8(f32x16& p0, f32x16& p1, float alpha, float& l_reg, i32x8& pa) {
#pragma unroll
  for (int r = 0; r < 16; ++r) p1[r] = __builtin_amdgcn_exp2f(p1[r]);
  float ps = 0;
#pragma unroll
  for (int r = 0; r < 16; ++r) ps += p0[r];
#pragma unroll
  for (int r = 0; r < 16; ++r) ps += p1[r];
  { auto rr = __builtin_amdgcn_permlane32_swap(__float_as_uint(ps), __float_as_uint(ps), false, false);
    ps = __uint_as_float(rr[0]) + __uint_as_float(rr[1]); }
  l_reg = l_reg * alpha + ps;
#pragma unroll
  for (int i = 0; i < 4; ++i) { pa[i] = cvt4nc(p0[4 * i], p0[4 * i + 1], p0[4 * i + 2], p0[4 * i + 3]); pa[4 + i] = cvt4nc(p1[4 * i], p1[4 * i + 1], p1[4 * i + 2], p1[4 * i + 3]); }
}
__device__ __forceinline__ void pv8(f32x16* o, const char* VT, const i32x8 pa, int r32, int hi) {
  const int f = (r32 >> 2) & 3; const char* b = VT + r32 * 64; const int c0 = ((2 * hi) ^ f) * 16, c1 = ((2 * hi + 1) ^ f) * 16;
#pragma unroll
  for (int d0 = 0; d0 < 4; ++d0) { const i32x4 x = *reinterpret_cast<const i32x4*>(b + d0 * 2048 + c0), y = *reinterpret_cast<const i32x4*>(b + d0 * 2048 + c1);
    o[d0] = __builtin_amdgcn_mfma_scale_f32_32x32x64_f8f6f4(pa, __builtin_shufflevector(x, y, 0, 1, 2, 3, 4, 5, 6, 7), o[d0], 0, 0, 0, 0, 0, 0); }
}
__device__ __forceinline__ int v_st(int k, int c) { const int kk = (k & ~0xC) | ((k & 4) << 1) | ((k & 8) >> 1); return ((kk >> 3) * 4 + (c >> 5)) * 512 + ((kk & 7) * 32 + (c & 31)) * 2; }
__device__ __forceinline__ int v_rd_base(int lane) { return ((lane & 3) << 3) | (((lane >> 2) & 3) << 6) | (((lane >> 4) & 1) << 5) | (((lane >> 5) & 1) << 8); }
constexpr int v_rd_off(int d0, int ks, int half) { return d0 * 512 + ks * 4096 + half * 2048; }
template <int OFF> __device__ __forceinline__ s16x4 tr_read(int vb) {
  s16x4 r; asm volatile("ds_read_b64_tr_b16 %0, %1 offset:%2" : "=&v"(r) : "v"(vb), "i"(OFF) : "memory"); return r;
}
template <int D0> __device__ __forceinline__ void pv_one(f32x16& od, int vb, bf16x8 pa0, bf16x8 pa1, bf16x8 pa2, bf16x8 pa3) {
  const s16x4 l0 = tr_read<v_rd_off(D0, 0, 0)>(vb), h0 = tr_read<v_rd_off(D0, 0, 1)>(vb), l1 = tr_read<v_rd_off(D0, 1, 0)>(vb), h1 = tr_read<v_rd_off(D0, 1, 1)>(vb);
  const s16x4 l2 = tr_read<v_rd_off(D0, 2, 0)>(vb), h2 = tr_read<v_rd_off(D0, 2, 1)>(vb), l3 = tr_read<v_rd_off(D0, 3, 0)>(vb), h3 = tr_read<v_rd_off(D0, 3, 1)>(vb);
  asm volatile("s_waitcnt lgkmcnt(0)" ::: "memory"); SBAR();
#define PK(L, H) (bf16x8){L[0], L[1], L[2], L[3], H[0], H[1], H[2], H[3]}
  od = __builtin_amdgcn_mfma_f32_32x32x16_bf16(pa0, PK(l0, h0), od, 0, 0, 0);
  od = __builtin_amdgcn_mfma_f32_32x32x16_bf16(pa1, PK(l1, h1), od, 0, 0, 0);
  od = __builtin_amdgcn_mfma_f32_32x32x16_bf16(pa2, PK(l2, h2), od, 0, 0, 0);
  od = __builtin_amdgcn_mfma_f32_32x32x16_bf16(pa3, PK(l3, h3), od, 0, 0, 0);
#undef PK
}
__device__ __forceinline__ void pv_d0(f32x16* o, int vb, bf16x8 pa0, bf16x8 pa1, bf16x8 pa2, bf16x8 pa3) {
  pv_one<0>(o[0], vb, pa0, pa1, pa2, pa3); pv_one<1>(o[1], vb, pa0, pa1, pa2, pa3); pv_one<2>(o[2], vb, pa0, pa1, pa2, pa3); pv_one<3>(o[3], vb, pa0, pa1, pa2, pa3);
}
#define RESC(a) do { if (__any((a) < 1.f)) { if (hi == 0) al_l[r32] = (a); asm volatile("s_waitcnt lgkmcnt(0)" ::: "memory"); \
    _Pragma("unroll") for (int d = 0; d < 4; ++d) _Pragma("unroll") for (int r = 0; r < 16; ++r) o[d][r] *= al_l[crow(r, hi)]; } } while (0)

#define LAS3 __attribute__((address_space(3)))
__device__ __forceinline__ void mla_unit(const bf16_t* __restrict__ Qb, const bf16_t* __restrict__ Kh, const bf16_t* __restrict__ Vh, const bf16_t* __restrict__ Kpe,
                                         const bf16_t* __restrict__ Gb, bf16_t* __restrict__ Ob, char* lds, LAS3 unsigned char* ldsl) {
  constexpr int LDQ = 3072, LDK = 4096, LDO = 2048, NT = SEQ / KVBLK; constexpr float QKC = 1.f / (Q8_SC * K8_SC);
  constexpr int STG = 24576, O_V = 0, O_KN = 8192, M_WS = 3 * STG;
  const int tid = opaque_tid(), wid = __builtin_amdgcn_readfirstlane(tid >> 6), lane = tid & 63, r32 = lane & 31, hi = lane >> 5;
  float* ws = (float*)(lds + M_WS) + wid * 64; float* li_l = ws; float* al_l = ws + 32;
  float m_reg = -1e30f, l_reg = 0; f32x16 o[4] = {}; i32x8 q8[3];
  { const unsigned char* Qw = (const unsigned char*)Qb + (long)(wid * QBLK + r32) * LDQ + hi * 32;
#pragma unroll
    for (int s = 0; s < 3; ++s) { const i32x4 a = *reinterpret_cast<const i32x4*>(Qw + 64 * s), b = *reinterpret_cast<const i32x4*>(Qw + 64 * s + 16); q8[s] = __builtin_shufflevector(a, b, 0, 1, 2, 3, 4, 5, 6, 7); } }
  asm volatile("s_waitcnt vmcnt(0)" ::: "memory"); SBAR();
  int vsrc, ksrc[2];
#pragma unroll
  for (int i = 0; i < 2; ++i) { const int c = wid + 8 * i;
    { const int row = c * 4 + (lane >> 4), colB = ((lane & 15) * 16) ^ ((row & 15) << 4); ksrc[i] = row * 256 + colB; } }
  { const int row = wid * 16 + (lane >> 2), ch = (lane & 3) ^ ((row >> 2) & 3); vsrc = row * SEQ + ch * 16; }
#define DMA16(gptr, ldsoff) __builtin_amdgcn_global_load_lds((const unsigned*)(gptr), (LAS3 unsigned*)(ldsl + (ldsoff)), 16, 0, 0)
#define ISSUE_K(t, s) do { const unsigned char* kb_ = (const unsigned char*)Kh + (long)(t) * (KVBLK * 256); DMA16(kb_ + ksrc[0], (s) * STG + O_KN + wid * 1024); DMA16(kb_ + ksrc[1], (s) * STG + O_KN + (wid + 8) * 1024); } while (0)
#define ISSUE_V(t, s) do { DMA16((const unsigned char*)Vh + (long)(t) * KVBLK + vsrc, (s) * STG + O_V + wid * 1024); } while (0)
#define WAITBAR(N) do { asm volatile("s_waitcnt vmcnt(" #N ") lgkmcnt(0)" ::: "memory"); __builtin_amdgcn_s_barrier(); asm volatile("" ::: "memory"); } while (0)
  f32x16 pA0, pA1, pB0, pB1; float alA, alB; i32x8 pa;
  int s0 = 0, s1 = 1, s2 = 2;
#define ROT() do { const int t_ = s0; s0 = s1; s1 = s2; s2 = t_; } while (0)
  ISSUE_K(0, 0); ISSUE_V(0, 0); ISSUE_K(1, 1);
  WAITBAR(2);
  ISSUE_K(2, s2); ISSUE_V(1, s1);
  qkt8(pA0, pA1, lds + s0 * STG + O_KN, q8, r32, hi); partialSM<8>(pA0, pA1, m_reg, alA, QKC);
  WAITBAR(3); ROT();
#define STEP(PX0, PX1, ALX, PY0, PY1, ALY, j_) do { const bool ik_ = (j_) + 2 < NT, iv_ = (j_) + 1 < NT; \
    if (ik_) ISSUE_K((j_) + 2, s2); if (iv_) ISSUE_V((j_) + 1, s1); \
    SBAR(); qkt8(PX0, PX1, lds + s0 * STG + O_KN, q8, r32, hi); \
    finishSM8(PY0, PY1, ALY, l_reg, pa); SBAR(); \
    pv8(o, lds + s2 * STG + O_V, pa, r32, hi); partialSM<8>(PX0, PX1, m_reg, ALX, QKC); \
    RESC(ALX); \
    if (ik_) WAITBAR(3); else WAITBAR(0); ROT(); } while (0)
  for (int j = 1; j + 1 < NT; j += 2) {
    STEP(pB0, pB1, alB, pA0, pA1, alA, j);
    STEP(pA0, pA1, alA, pB0, pB1, alB, j + 1);
  }
  STEP(pB0, pB1, alB, pA0, pA1, alA, NT - 1);
  finishSM8(pB0, pB1, alB, l_reg, pa); SBAR();
  pv8(o, lds + s2 * STG + O_V, pa, r32, hi);
  if (hi == 0) li_l[r32] = l_reg; asm volatile("s_waitcnt lgkmcnt(0)" ::: "memory");
  float rli[16];
#pragma unroll
  for (int r = 0; r < 16; ++r) rli[r] = __builtin_amdgcn_rcpf(li_l[crow(r, hi)]) * (1.f / V8_SC);
  __syncthreads();
  const bf16_t* Gw = Gb + (long)(wid * QBLK) * LDP;
  { bf16_t* stg = (bf16_t*)(lds + wid * 8704);
#pragma unroll
    for (int r = 0; r < 16; ++r) { const int orow = crow(r, hi);
#pragma unroll
      for (int d0 = 0; d0 < 4; ++d0) { const float ov = o[d0][r] * rli[r]; stg[orow * 136 + d0 * 32 + r32] = (bf16_t)(cvtpk(ov, ov) & 0xffffu); } }
    asm volatile("s_waitcnt lgkmcnt(0)" ::: "memory");
    int lz = lane; asm volatile("" : "+v"(lz));
#pragma unroll
    for (int i = 0; i < 8; ++i) { const int id = i * 64 + lz, row = id >> 4, c = (id & 15) * 8;
      const u32x4 ov = *(const u32x4*)(stg + row * 136 + c); const u32x4 gv = *(const u32x4*)(Gw + (long)row * LDP + c);
#define PLO(k) (__uint_as_float(ov[k] << 16) * __uint_as_float(gv[k] << 16) * A_SC)
#define PHI(k) (__uint_as_float(ov[k] & 0xffff0000u) * __uint_as_float(gv[k] & 0xffff0000u) * A_SC)
      typedef int i32x2 __attribute__((ext_vector_type(2)));
      *(i32x2*)((unsigned char*)Ob + (long)(wid * QBLK + row) * LDO + c) = (i32x2){pg8::cvt4_fp8(PLO(0), PHI(0), PLO(1), PHI(1)), pg8::cvt4_fp8(PLO(2), PHI(2), PLO(3), PHI(3))}; } }
#undef PLO
#undef PHI
  __syncthreads();
#undef DMA16
#undef ISSUE_K
#undef ISSUE_V
#undef WAITBAR
#undef ROT
#undef STEP
}

__device__ __forceinline__ void dswa_unit(int H, int rs, int qb, const bf16_t* __restrict__ proj, const float* __restrict__ bias2, bf16_t* __restrict__ Od, float* __restrict__ lse, char* lds) {
  const int g = H >> 3, dil = 1 << (2 * g), L = SEQ / dil, Q0 = qb * 256, T0 = Q0 - 64;
  const int tid = opaque_tid(), wid = tid >> 6, lane = tid & 63, r32 = lane & 31, hi = lane >> 5;
  char* V_lds = lds + OFF_V; char* Kn_lds = lds + OFF_KN;
  float* ws = (float*)(lds + OFF_WS) + wid * 64; float* li_l = ws; float* al_l = ws + 32;
  float* bl = (float*)(lds + OFF_BIAS);
  const bf16_t* Qp = proj + C_DQ + H * 128; const bf16_t* Kp = proj + C_DK + H * 128; const bf16_t* Vp = proj + C_DV + H * 128;
  if (tid < 129) bl[tid] = bias2[(g * 8 + (H & 7)) * 129 + tid];
  const int qa = Q0 + wid * QBLK, qi = qa + r32;
  bf16x8 qr[8];
  { const bf16_t* Qw = Qp + (size_t)(qi * dil + rs) * LDP + hi * 8;
#pragma unroll
    for (int d0 = 0; d0 < 8; ++d0) qr[d0] = ld8(Qw + d0 * 16); }
  const int sr = tid >> 4, sc = (tid & 15) * 8, vst0 = v_st(sr, sc), vst1 = v_st(32 + sr, sc);
  const int vb0 = (int)(uintptr_t)V_lds + v_rd_base(lane);
  float m_reg = -1e29f, l_reg = 0.f; f32x16 o[4] = {};
  const int tlo = (Q0 == 0) ? 1 : 0, thi = (Q0 + 256 >= L) ? 5 : 6;
  bf16x8 vs0, vs1, ks0, ks1;
#define DLOAD(t_) do { const int k0_ = T0 + 64 * (t_); int i0 = k0_ + sr, i1 = k0_ + 32 + sr; i0 = i0 < 0 ? 0 : (i0 >= L ? L - 1 : i0); i1 = i1 < 0 ? 0 : (i1 >= L ? L - 1 : i1); \
    const size_t o0 = (size_t)(i0 * dil + rs) * LDP + sc, o1 = (size_t)(i1 * dil + rs) * LDP + sc; vs0 = ld8(Vp + o0); vs1 = ld8(Vp + o1); ks0 = ld8(Kp + o0); ks1 = ld8(Kp + o1); } while (0)
  DLOAD(tlo);
  for (int t = tlo; t < thi; ++t) {
    const int k0 = T0 + 64 * t;
    __syncthreads();
    *(bf16x8*)(V_lds + vst0) = vs0; *(bf16x8*)(V_lds + vst1) = vs1;
    *(bf16x8*)(Kn_lds + KSWZ(sr, sc * 2)) = ks0; *(bf16x8*)(Kn_lds + KSWZ(32 + sr, sc * 2)) = ks1;
    __syncthreads();
    if (t + 1 < thi) DLOAD(t + 1);
    if (k0 > qa + 31 + 64 || k0 + 63 < qa - 64) continue;
    f32x16 p0, p1; qkt<0>(p0, p1, Kn_lds, Kn_lds, qr, Kn_lds, r32, hi);
#pragma unroll
    for (int r = 0; r < 16; ++r) { const int kj = k0 + crow(r, hi), dj = kj - qi; int bi = dj + 64; bi = bi < 0 ? 0 : (bi > 128 ? 128 : bi);
      const int kj1 = kj + 32, dj1 = dj + 32; int bi1 = dj1 + 64; bi1 = bi1 < 0 ? 0 : (bi1 > 128 ? 128 : bi1);
      const bool ok0 = (dj >= -64) && (dj <= 64) && (kj >= 0) && (kj < L), ok1 = (dj1 >= -64) && (dj1 <= 64) && (kj1 >= 0) && (kj1 < L);
      p0[r] = ok0 ? p0[r] + bl[bi] : -1e30f; p1[r] = ok1 ? p1[r] + bl[bi1] : -1e30f; }
    float al; partialSM<0>(p0, p1, m_reg, al);
    bf16x8 pa0, pa1, pa2, pa3; finishSM(p0, p1, al, l_reg, pa0, pa1, pa2, pa3);
    RESC(al);
    SBAR(); pv_d0(o, vb0, pa0, pa1, pa2, pa3);
  }
#undef DLOAD
  if (hi == 0) li_l[r32] = l_reg; asm volatile("s_waitcnt lgkmcnt(0)" ::: "memory");
  float rli[16];
#pragma unroll
  for (int r = 0; r < 16; ++r) rli[r] = __builtin_amdgcn_rcpf(li_l[crow(r, hi)]);
  const int hh = H & 7;
  bf16_t* Og = Od + (size_t)g * SEQ * 1024 + hh * 128;
#pragma unroll
  for (int r = 0; r < 16; ++r) { const size_t pos = (size_t)(qa + crow(r, hi)) * dil + rs;
#pragma unroll
    for (int d0 = 0; d0 < 4; ++d0) { const float ov = o[d0][r] * rli[r]; Og[pos * 1024 + d0 * 32 + r32] = (bf16_t)(cvtpk(ov, ov) & 0xffffu); } }
  if (hi == 0) lse[((size_t)g * SEQ + (size_t)qi * dil + rs) * 8 + hh] = m_reg + __builtin_amdgcn_logf(l_reg);
  __syncthreads();
}
#undef RESC
#undef KSWZ
#undef KPSWZ
#undef SBAR
}

#define LAS __attribute__((address_space(3)))
typedef unsigned short bf16;
typedef unsigned v4u __attribute__((ext_vector_type(4)));
typedef float f32x4 __attribute__((ext_vector_type(4)));
constexpr int NWAVES = 8;
constexpr size_t MiB = 1u << 20;
constexpr size_t WS_RSSQ = 0, WS_RSSKV = 32768, WS_STATS = 65536, WS_BIAS2 = 131072, WS_LSE = 262144;
constexpr size_t WS_ROPE = 2 * MiB;
constexpr size_t WS_WIN = 4 * MiB, WS_WQB = 178 * MiB, WS_WKVB = 184 * MiB, WS_WOMLA = 188 * MiB, WS_WODSWA = 204 * MiB, WS_WOUT = 212 * MiB;
constexpr size_t WS_H = 244 * MiB, WS_PROJ = 308 * MiB, WS_QMLA = 656 * MiB, WS_KVMLA = 704 * MiB, WS_KPE = 768 * MiB, WS_AMLA = 770 * MiB;
constexpr size_t WS_ODSWA = 802 * MiB, WS_BDSWA = 850 * MiB, WS_T = 866 * MiB, WS_K8 = 930 * MiB, WS_END = 962 * MiB;
static_assert(WS_WIN + (size_t)LDP * 4096 * 2 <= WS_WQB && WS_PROJ + (size_t)SEQ * LDP * 2 <= WS_QMLA && WS_LSE + 3 * SEQ * 8 * 4 <= WS_ROPE, "d_ws map");
constexpr int LDS_BYTES = 163840;

__device__ __forceinline__ unsigned f2bf(float f) { unsigned u = __builtin_bit_cast(unsigned, f); return (u + 0x7fffu + ((u >> 16) & 1u)) >> 16; }
__device__ __forceinline__ unsigned pk2(float lo, float hi) { return f2bf(lo) | (f2bf(hi) << 16); }
__device__ __forceinline__ float wave_sum(float v) {
#pragma unroll
    for (int o = 1; o < 64; o <<= 1) v += __shfl_xor(v, o);
    return v;
}
__device__ __forceinline__ void transpose_item(const float* __restrict__ W, int K, int N, bf16* __restrict__ WT, int k0, int n0, int dbase, int dstride, const float* __restrict__ kscale, LAS float* scr, int lane) {
    float wv[32];
#pragma unroll
    for (int i = 0; i < 32; ++i) { const int kk = 2 * i + (lane >> 5); wv[i] = __builtin_nontemporal_load(W + (size_t)(k0 + kk) * N + n0 + (lane & 31)); }
#pragma unroll
    for (int i = 0; i < 32; ++i) { const int kk = 2 * i + (lane >> 5); float w = wv[i]; if (kscale) w *= kscale[k0 + kk]; scr[kk * 33 + (lane & 31)] = w; }
    asm volatile("s_waitcnt lgkmcnt(0)" ::: "memory");
    const int c = lane & 7;
#pragma unroll
    for (int j = 0; j < 4; ++j) { const int n = (lane >> 3) + 8 * j; const LAS float* s = scr + (8 * c) * 33 + n;
        v4u o; o.x = pk2(s[0 * 33], s[1 * 33]); o.y = pk2(s[2 * 33], s[3 * 33]); o.z = pk2(s[4 * 33], s[5 * 33]); o.w = pk2(s[6 * 33], s[7 * 33]);
        *(v4u*)(WT + (size_t)(dbase + dstride * n) * K + k0 + 8 * c) = o; }
    asm volatile("s_waitcnt lgkmcnt(0)" ::: "memory");
}

#define REP0 1
#define REP1 1
#define REP2 1
#define REP3 1
#define REP4 1
#define REP5 1
constexpr float H_SC = 16.f, W_SC = 1024.f;
__device__ __forceinline__ void transpose_item8(const float* __restrict__ W, int K, int N, unsigned char* __restrict__ WT, int k0, int n0, int dbase, int dstride, float wsc, LAS float* scr, int lane) {
    float wv[32];
#pragma unroll
    for (int i = 0; i < 32; ++i) { const int kk = 2 * i + (lane >> 5); wv[i] = __builtin_nontemporal_load(W + (size_t)(k0 + kk) * N + n0 + (lane & 31)); }
#pragma unroll
    for (int i = 0; i < 32; ++i) { const int kk = 2 * i + (lane >> 5); scr[kk * 33 + (lane & 31)] = wv[i] * wsc; }
    asm volatile("s_waitcnt lgkmcnt(0)" ::: "memory");
    const int c = lane & 7;
#pragma unroll
    for (int j = 0; j < 4; ++j) { const int n = (lane >> 3) + 8 * j; const LAS float* s = scr + (8 * c) * 33 + n;
        int d0 = __builtin_amdgcn_cvt_pk_fp8_f32(s[0 * 33], s[1 * 33], 0, false); d0 = __builtin_amdgcn_cvt_pk_fp8_f32(s[2 * 33], s[3 * 33], d0, true);
        int d1 = __builtin_amdgcn_cvt_pk_fp8_f32(s[4 * 33], s[5 * 33], 0, false); d1 = __builtin_amdgcn_cvt_pk_fp8_f32(s[6 * 33], s[7 * 33], d1, true);
        typedef int i32x2 __attribute__((ext_vector_type(2)));
        *(i32x2*)(WT + (size_t)(dbase + dstride * n) * K + k0 + 8 * c) = (i32x2){d0, d1}; }
    asm volatile("s_waitcnt lgkmcnt(0)" ::: "memory");
}
struct Args { const float* in[14]; float* out; unsigned char* ws; };

__global__ void __launch_bounds__(NWAVES * 64, 2) fwd_mega(Args a) {
    extern __shared__ __attribute__((aligned(16))) unsigned char lds[];
    cg::grid_group grid = cg::this_grid();
    const int G = gridDim.x, bx = blockIdx.x, vcu = (G % 8 == 0) ? (bx % 8) * (G / 8) + bx / 8 : bx;
    LAS unsigned char* ldsl = (LAS unsigned char*)lds;
    unsigned char* ws = a.ws;
    const float* x = a.in[0]; const float* emb_g = a.in[1]; const float* emb_b = a.in[2]; const float* rel_bias = a.in[3]; const float* w_in = a.in[4];
    const float* qa_g = a.in[5]; const float* w_qb = a.in[6]; const float* kva_g = a.in[7]; const float* w_kvb = a.in[8]; const float* w_omla = a.in[9];
    const float* w_odswa = a.in[10]; const float* w_out = a.in[11]; const float* ln_g = a.in[12]; const float* ln_b = a.in[13];
    float* rss_q = (float*)(ws + WS_RSSQ); float* rss_kv = (float*)(ws + WS_RSSKV); float* stats = (float*)(ws + WS_STATS); float* bias2 = (float*)(ws + WS_BIAS2);
    float* lse = (float*)(ws + WS_LSE); float* rope = (float*)(ws + WS_ROPE);
    bf16* Win_t = (bf16*)(ws + WS_WIN); bf16* Wqb_t = (bf16*)(ws + WS_WQB); bf16* Wkvb_t = (bf16*)(ws + WS_WKVB); bf16* Womla_t = (bf16*)(ws + WS_WOMLA);
    bf16* Wodswa_t = (bf16*)(ws + WS_WODSWA); bf16* Wout_t = (bf16*)(ws + WS_WOUT);
    bf16* Hb = (bf16*)(ws + WS_H); bf16* proj = (bf16*)(ws + WS_PROJ); bf16* Qmla = (bf16*)(ws + WS_QMLA); bf16* KVmla = (bf16*)(ws + WS_KVMLA); bf16* Kpe = (bf16*)(ws + WS_K8);
    bf16* Amla = (bf16*)(ws + WS_AMLA); bf16* Odswa = (bf16*)(ws + WS_ODSWA); bf16* Bdswa = (bf16*)(ws + WS_BDSWA); bf16* Tm = (bf16*)(ws + WS_T); unsigned char* T8 = ws + WS_H + 32 * MiB;
    const int NGW = G * NWAVES, NGT = G * NWAVES * 64;
#define PHASE_IDS() const int tid = opaque_tid(), lane = tid & 63, wave = __builtin_amdgcn_readfirstlane(tid >> 6), gw = vcu * NWAVES + wave, gt = bx * (NWAVES * 64) + tid; (void)lane; (void)gw; (void)gt

    for (int rep = 0; rep < REP0; ++rep) {
        PHASE_IDS();
        LAS float* scr = (LAS float*)(ldsl + wave * 16384);
        constexpr int I_IN = 64 * 690, I_QB = 16 * 96, I_KVB = 8 * 128, I_OM = 32 * 128, I_OD = 16 * 128, I_OUT = 64 * 128;
        constexpr int NITEMS = I_IN + I_QB + I_KVB + I_OM + I_OD + I_OUT;
        for (int it = gw; it < NITEMS; it += NGW) {
            int r = it;
            if (r < I_IN) { const int kb = r / 690, nb = r % 690; int db, ds; if (nb < 48) { db = nb * 32; ds = 1; } else if (nb == 48) { db = C_KPE; ds = 2; } else if (nb == 49) { db = C_KPE + 1; ds = 2; } else { db = nb * 32 - 64; ds = 1; }
                transpose_item8(w_in, 4096, IN_W, (unsigned char*)Win_t, kb * 64, nb * 32, db, ds, W_SC, scr, lane); continue; } r -= I_IN;
            if (r < I_QB) { const int kb = r / 96, nb = r % 96, hq = nb / 6, bi = nb % 6; int db, ds; if (bi < 4) { db = hq * 192 + bi * 32; ds = 1; } else { db = hq * 192 + 128 + (bi - 4); ds = 2; }
                transpose_item(w_qb, 1024, 3072, Wqb_t, kb * 64, nb * 32, db, ds, qa_g, scr, lane); continue; } r -= I_QB;
            if (r < I_KVB) { const int kb = r / 128, nb = r % 128; transpose_item(w_kvb, 512, 4096, Wkvb_t, kb * 64, nb * 32, nb * 32, 1, kva_g, scr, lane); continue; } r -= I_KVB;
            if (r < I_OM) { const int kb = r / 128, nb = r % 128; transpose_item8(w_omla, 2048, 4096, (unsigned char*)Womla_t, kb * 64, nb * 32, nb * 32, 1, W_OM_SC, scr, lane); continue; } r -= I_OM;
            if (r < I_OD) { const int kb = r / 128, nb = r % 128; transpose_item8(w_odswa, 1024, 4096, (unsigned char*)Wodswa_t, kb * 64, nb * 32, nb * 32, 1, W_OD_SC, scr, lane); continue; } r -= I_OD;
            { const int kb = r / 128, nb = r % 128; transpose_item8(w_out, 4096, 4096, (unsigned char*)Wout_t, kb * 64, nb * 32, nb * 32, 1, W_OUT_SC, scr, lane); }
        }
        for (int m = gw; m < SEQ; m += NGW) {
            const f32x4* xr = (const f32x4*)(x + (size_t)m * DM) + lane;
            f32x4 v[16]; float s = 0.f;
#pragma unroll
            for (int j = 0; j < 16; ++j) { v[j] = xr[64 * j]; s += (v[j].x + v[j].y) + (v[j].z + v[j].w); }
            const float mean = wave_sum(s) * (1.f / DM); float s2 = 0.f;
#pragma unroll
            for (int j = 0; j < 16; ++j) { v[j] = v[j] - mean; s2 += (v[j].x * v[j].x + v[j].y * v[j].y) + (v[j].z * v[j].z + v[j].w * v[j].w); }
            const float rstd = 1.f / sqrtf(wave_sum(s2) * (1.f / DM) + LN_EPS);
            if (lane == 0) { stats[2 * m] = mean; stats[2 * m + 1] = rstd; }
            int* o4 = (int*)((unsigned char*)Hb + (size_t)m * DM) + lane;
#pragma unroll
            for (int j = 0; j < 16; ++j) { const f32x4 gv = ((const f32x4*)emb_g)[64 * j + lane], bv = ((const f32x4*)emb_b)[64 * j + lane]; const f32x4 y = (v[j] * rstd * gv + bv) * H_SC;
                int d = __builtin_amdgcn_cvt_pk_fp8_f32(y.x, y.y, 0, false); d = __builtin_amdgcn_cvt_pk_fp8_f32(y.z, y.w, d, true); o4[64 * j] = d; }
        }
        for (int e = gt; e < SEQ * 32; e += NGT) { const int pos = e >> 5, i = e & 31; const float invf = 1.0f / powf(10000.0f, (float)(2 * i) / 64.0f); const float ang = (float)pos * invf;
            double t = (double)ang * 0.15915494309189535; t -= __builtin_floor(t); const float tf = (float)t;
            rope[2 * e] = __builtin_amdgcn_cosf(tf); rope[2 * e + 1] = __builtin_amdgcn_sinf(tf); }
        for (int e = gt; e < 3 * 8 * 129; e += NGT) { const int j = e % 129 - 64, hh = (e / 129) % 8, g = e / (129 * 8), dil = 1 << (2 * g); const int rel = j * dil, n = rel < 0 ? -rel : rel;
            int bk; if (n < 8) bk = n; else { const float nf = (float)n; int lg = 8 + (int)(logf(nf / 8.f) / 4.852030263919617f * 8.f); bk = lg < 15 ? lg : 15; }
            if (rel > 0) bk += 16;
            bias2[e] = rel_bias[bk * 24 + g * 8 + hh] * LOG2E; }
        for (int e = gt; e < 2 * SEQ; e += NGT) rss_q[e] = 0.f;
    }
    grid.sync();

    for (int rep = 0; rep < REP1; ++rep) {
        pg8::Gemm g{Hb, Win_t, SEQ, LDP, 2048, 2048, 2048}; pg8::StaticOrder S; S.init(SEQ, LDP, G, bx);
        pg8::EpiProj E{proj, Kpe, rep ? nullptr : rss_q, rep ? nullptr : rss_kv, rope, 1.f / (H_SC * W_SC)};
        pg8::gemm_phase<pg8::EpiProj, pg8::StaticOrder, true, true, true>(ldsl, g, S, E);
    }
    grid.sync();

    for (int rep = 0; rep < REP2; ++rep) {
        { pg8::Gemm g{proj + C_QA, Wqb_t, SEQ, 3072, 1024, LDP, 1024}; pg8::StaticOrder S; S.init(SEQ, 3072, G, bx);
          pg8::EpiQ E{Qmla, rss_q, rope}; pg8::gemm_phase<pg8::EpiQ, pg8::StaticOrder, true, true>(ldsl, g, S, E); }
        { pg8::Gemm g{proj + C_CKV, Wkvb_t, SEQ, 4096, 512, LDP, 512}; pg8::StaticOrder S; S.init(SEQ, 4096, G, bx);
          pg8::EpiKV E{(unsigned char*)KVmla  , rss_kv, (unsigned char*)Kpe}; pg8::gemm_phase<pg8::EpiKV, pg8::StaticOrder, true, true>(ldsl, g, S, E); }
        __syncthreads();
        for (int u = vcu; u < 768; u += G) { const int H = u >> 5, rem = u & 31, g = H >> 3, nqb = 32 >> (2 * g); att::dswa_unit(H, rem / nqb, rem % nqb, proj, bias2, Odswa, lse, (char*)lds); }
    }
    grid.sync();

    for (int rep = 0; rep < REP3; ++rep) {
        for (int u = vcu; u < 512; u += G) { const int h = u >> 5, qb = u & 31; const size_t r0 = (size_t)qb * 256;
            att::mla_unit((const bf16*)((const unsigned char*)Qmla + r0 * 3072 + h * 192), (const bf16*)((const unsigned char*)Kpe + (size_t)h * SEQ * 256), (const bf16*)((const unsigned char*)KVmla + (size_t)h * 128 * SEQ), Kpe, proj + r0 * LDP + C_GMLA + h * 128, (bf16*)((unsigned char*)Amla + r0 * 2048 + h * 128), (char*)lds, ldsl); }
        PHASE_IDS();
        for (int it = gt; it < SEQ * 128; it += NGT) { const int pos = it >> 7, c8 = it & 127, hh = c8 >> 4, col = c8 * 8;
            const float l0 = lse[((size_t)0 * SEQ + pos) * 8 + hh], l1 = lse[((size_t)1 * SEQ + pos) * 8 + hh], l2 = lse[((size_t)2 * SEQ + pos) * 8 + hh];
            const float mx = fmaxf(l0, fmaxf(l1, l2)); float e0 = __builtin_amdgcn_exp2f(l0 - mx), e1 = __builtin_amdgcn_exp2f(l1 - mx), e2 = __builtin_amdgcn_exp2f(l2 - mx);
            const float inv = 1.f / (e0 + e1 + e2); e0 *= inv; e1 *= inv; e2 *= inv;
            const v4u a0 = *(const v4u*)(Odswa + ((size_t)0 * SEQ + pos) * 1024 + col), a1 = *(const v4u*)(Odswa + ((size_t)1 * SEQ + pos) * 1024 + col), a2 = *(const v4u*)(Odswa + ((size_t)2 * SEQ + pos) * 1024 + col);
            const v4u gg = *(const v4u*)(proj + (size_t)pos * LDP + C_GDSWA + col);
#define MLO(k) ((pg8::bflo(a0[k]) * e0 + pg8::bflo(a1[k]) * e1 + pg8::bflo(a2[k]) * e2) * pg8::bflo(gg[k]) * B_SC)
#define MHI(k) ((pg8::bfhi(a0[k]) * e0 + pg8::bfhi(a1[k]) * e1 + pg8::bfhi(a2[k]) * e2) * pg8::bfhi(gg[k]) * B_SC)
            *(pg8::i32x2*)((unsigned char*)Bdswa + (size_t)pos * 1024 + col) = (pg8::i32x2){pg8::cvt4_fp8(MLO(0), MHI(0), MLO(1), MHI(1)), pg8::cvt4_fp8(MLO(2), MHI(2), MLO(3), MHI(3))}; }
#undef MLO
#undef MHI
    }
    grid.sync();

    for (int rep = 0; rep < REP4; ++rep) {
        { pg8::Gemm g{Amla, Womla_t, SEQ, 4096, 1024, 1024, 1024}; pg8::StaticOrder S; S.init(SEQ, 4096, G, bx);
          pg8::EpiY<0> E{Tm, proj + C_RMLA, T8}; pg8::gemm_phase<pg8::EpiY<0>, pg8::StaticOrder, true, true, true>(ldsl, g, S, E); }
        { pg8::Gemm g{Bdswa, Wodswa_t, SEQ, 4096, 512, 512, 512}; pg8::StaticOrder S; S.init(SEQ, 4096, G, bx);
          pg8::EpiY<1> E{Tm, proj + C_RDSWA, T8}; pg8::gemm_phase<pg8::EpiY<1>, pg8::StaticOrder, true, true, true>(ldsl, g, S, E); }
    }
    grid.sync();

    for (int rep = 0; rep < REP5; ++rep) {
        pg8::Gemm g{(const bf16*)T8, Wout_t, SEQ, 4096, 2048, 2048, 2048}; pg8::StaticOrder S; S.init(SEQ, 4096, G, bx);
        pg8::EpiOut E{x, stats, emb_g, emb_b, a.out, 1.f / (T_SC * W_OUT_SC)}; pg8::gemm_phase<pg8::EpiOut, pg8::StaticOrder, true, true, true>(ldsl, g, S, E);
    }
    grid.sync();

    { PHASE_IDS();
    for (int m = gw; m < SEQ; m += NGW) {
        f32x4* xr = (f32x4*)(a.out + (size_t)m * DM) + lane;
        f32x4 v[16]; float s = 0.f;
#pragma unroll
        for (int j = 0; j < 16; ++j) { v[j] = xr[64 * j]; s += (v[j].x + v[j].y) + (v[j].z + v[j].w); }
        const float mean = wave_sum(s) * (1.f / DM); float s2 = 0.f;
#pragma unroll
        for (int j = 0; j < 16; ++j) { v[j] = v[j] - mean; s2 += (v[j].x * v[j].x + v[j].y * v[j].y) + (v[j].z * v[j].z + v[j].w * v[j].w); }
        const float rstd = 1.f / sqrtf(wave_sum(s2) * (1.f / DM) + LN_EPS);
#pragma unroll
        for (int j = 0; j < 16; ++j) { const f32x4 gv = ((const f32x4*)ln_g)[64 * j + lane], bv = ((const f32x4*)ln_b)[64 * j + lane]; xr[64 * j] = v[j] * rstd * gv + bv; }
    } }
}

extern "C" void kernel_launch(void* const* d_in, const int* in_sizes, int n_in, void* d_out, int out_size, void* d_ws, size_t ws_size, hipStream_t stream) {
    static int grid = 0;
    if (grid == 0) {
        if (n_in != 14 || in_sizes[0] != SEQ * DM || out_size != SEQ * DM || ws_size < WS_END) { fprintf(stderr, "kernel_launch: unexpected shapes (n_in %d, in0 %d, out %d, ws %zu < %zu)\n", n_in, n_in > 0 ? in_sizes[0] : -1, out_size, ws_size, (size_t)WS_END); grid = -1; return; }
        int dev = 0, cus = 0, per_cu = 0;
        if (hipGetDevice(&dev) != hipSuccess || hipDeviceGetAttribute(&cus, hipDeviceAttributeMultiprocessorCount, dev) != hipSuccess) { grid = -1; return; }
        if (hipFuncSetAttribute((const void*)fwd_mega, hipFuncAttributeMaxDynamicSharedMemorySize, LDS_BYTES) != hipSuccess) { fprintf(stderr, "kernel_launch: hipFuncSetAttribute failed\n"); grid = -1; return; }
        if (hipOccupancyMaxActiveBlocksPerMultiprocessor(&per_cu, (const void*)fwd_mega, NWAVES * 64, LDS_BYTES) != hipSuccess || per_cu < 1) { fprintf(stderr, "kernel_launch: occupancy query says %d blocks per CU\n", per_cu); per_cu = 1; }
        (void)hipGetLastError();
        grid = cus;
    }
    if (grid < 0) return;
    Args a{};
    for (int i = 0; i < 14; ++i) a.in[i] = (const float*)d_in[i];
    a.out = (float*)d_out; a.ws = (unsigned char*)d_ws;
    void* args[] = {&a};
    hipError_t e = hipLaunchCooperativeKernel((const void*)fwd_mega, dim3(grid), dim3(NWAVES * 64), args, LDS_BYTES, stream);
    if (e != hipSuccess) fprintf(stderr, "kernel_launch: cooperative launch failed: %s (grid %d)\n", hipGetErrorString(e), grid);
}
```

```cpp
#include <hip/hip_runtime.h>
#include <hip/hip_cooperative_groups.h>
#include <cstdio>
#include <cstdint>
#include <cmath>
namespace cg = cooperative_groups;

constexpr int SEQ = 8192, DM = 4096;
constexpr int LDP = 22272;
constexpr int C_QA = 0, C_CKV = 1024, C_DQ = 1536, C_DK = 4608, C_DV = 7680, C_GMLA = 10752, C_GDSWA = 12800, C_RMLA = 13824, C_RDSWA = 17920, C_KPE = 22016;
constexpr int IN_W = 22080;
constexpr float LOG2E = 1.4426950408889634f;
constexpr float QS_D = 0.08838834764831845f * LOG2E;
constexpr float QS_M = 0.07216878364870323f * LOG2E;
constexpr float ALPHA = 1.189207115002721f;
constexpr float LN_EPS = 1e-5f, RMS_EPS = 1e-6f;
constexpr float Q8_SC = 64.f, K8_SC = 16.f, V8_SC = 64.f;
constexpr float A_SC = 256.f, B_SC = 128.f, T_SC = 512.f, W_OM_SC = 1024.f, W_OD_SC = 1024.f, W_OUT_SC = 2048.f;

__device__ __forceinline__ int opaque_tid() { int t = threadIdx.x; asm volatile("" : "+v"(t)); return t; }

namespace pg8 {
#define PG8_LAS __attribute__((address_space(3)))
typedef unsigned short bf16_t;
typedef short bf16x8 __attribute__((ext_vector_type(8)));
typedef float f32x4 __attribute__((ext_vector_type(4)));
typedef unsigned u32x4 __attribute__((ext_vector_type(4)));
constexpr int BM = 256, BK = 64, HALF = 128, HTB = HALF * BK * 2  , STAGE_BYTES = 8 * HTB, NXCD = 8, WGM = 8;

__host__ __device__ __forceinline__ int lds_byte(int r, int c) { const int st = (r >> 4) * 2 + (c >> 5), rr = r & 15, cc = c & 31, ob = rr * 64 + cc * 2; return st * 1024 + (ob ^ (((ob >> 9) & 1) << 5)); }
__host__ __device__ __forceinline__ void stage_rc(int b, int& R, int& C) { const int st = b / 1024, sb = b % 1024, swz = sb ^ (((sb >> 9) & 1) << 5); R = (st >> 1) * 16 + swz / 64; C = (st & 1) * 32 + (swz % 64) / 2; }
__host__ __device__ __forceinline__ int perm32(int rho) { const int n = rho >> 4, i = rho & 15; return 8 * (i >> 2) + 4 * n + (i & 3); }

struct Unit { int pm, pn; };
struct Gemm { const bf16_t* A; const bf16_t* Bt; int M, N, K, lda, ldb; };

struct StaticOrder {
    int nM, nN, nwg, G, c;
    __host__ __device__ void init(int M, int N, int G_, int c_) { nM = M / BM; nN = N / BM; nwg = nM * nN; G = G_; c = c_; }
    __host__ __device__ bool next(int i, Unit& u) const {
        const long L = (long)i * G + c; if (L >= nwg) return false;
        int wgid = (int)L; { const int q = nwg / NXCD, r = nwg % NXCD, xcd = wgid % NXCD, off = wgid / NXCD; wgid = (xcd < r ? xcd * (q + 1) : r * (q + 1) + (xcd - r) * q) + off; }
        const int nig = WGM * nN, gid = wgid / nig, fm = gid * WGM, gsz = (nM - fm) < WGM ? (nM - fm) : WGM;
        u.pm = fm + ((wgid % nig) % gsz); u.pn = (wgid % nig) / gsz; return true;
    }
    __device__ __forceinline__ void a_ready(const Unit&) const {}
    __device__ __forceinline__ void done(const Unit&) const {}
};


typedef float f32x2 __attribute__((ext_vector_type(2))); typedef __bf16 bf16x2_t __attribute__((ext_vector_type(2)));
typedef int i32x4 __attribute__((ext_vector_type(4))); typedef int i32x8 __attribute__((ext_vector_type(8)));
__device__ __forceinline__ i32x8 cat8(bf16x8 a, bf16x8 b) { return __builtin_shufflevector(__builtin_bit_cast(i32x4, a), __builtin_bit_cast(i32x4, b), 0, 1, 2, 3, 4, 5, 6, 7); }
__device__ __forceinline__ unsigned cvt_pk_bf16(float lo, float hi) { f32x2 v = {lo, hi}; bf16x2_t b = __builtin_convertvector(v, bf16x2_t); return __builtin_bit_cast(unsigned, b); }
typedef int i32x2 __attribute__((ext_vector_type(2)));
__device__ __forceinline__ int cvt4_fp8(float a, float b, float c, float d) { a = __builtin_amdgcn_fmed3f(a, -440.f, 440.f); b = __builtin_amdgcn_fmed3f(b, -440.f, 440.f); c = __builtin_amdgcn_fmed3f(c, -440.f, 440.f); d = __builtin_amdgcn_fmed3f(d, -440.f, 440.f);
    int r = __builtin_amdgcn_cvt_pk_fp8_f32(a, b, 0, false); return __builtin_amdgcn_cvt_pk_fp8_f32(c, d, r, true); }
__device__ __forceinline__ float bflo(unsigned w) { return __uint_as_float(w << 16); }
__device__ __forceinline__ float bfhi(unsigned w) { return __uint_as_float(w & 0xffff0000u); }
__device__ __forceinline__ float sigm(float x) { return __builtin_amdgcn_rcpf(1.f + __builtin_amdgcn_exp2f(-x * 1.4426950408889634f)); }
__device__ __forceinline__ u32x4 pack8(const f32x4 v0, const f32x4 v1) { u32x4 w; w.x = cvt_pk_bf16(v0[0], v0[1]); w.y = cvt_pk_bf16(v0[2], v0[3]); w.z = cvt_pk_bf16(v1[0], v1[1]); w.w = cvt_pk_bf16(v1[2], v1[3]); return w; }
__device__ __forceinline__ void rope8(f32x4& v0, f32x4& v1, const f32x4 cs0, const f32x4 cs1) {
    const float a0 = v0[0] * cs0[0] - v0[1] * cs0[1], b0 = v0[1] * cs0[0] + v0[0] * cs0[1];
    const float a1 = v0[2] * cs0[2] - v0[3] * cs0[3], b1 = v0[3] * cs0[2] + v0[2] * cs0[3];
    const float a2 = v1[0] * cs1[0] - v1[1] * cs1[1], b2 = v1[1] * cs1[0] + v1[0] * cs1[1];
    const float a3 = v1[2] * cs1[2] - v1[3] * cs1[3], b3 = v1[3] * cs1[2] + v1[2] * cs1[3];
    v0 = (f32x4){a0, b0, a1, b1}; v1 = (f32x4){a2, b2, a3, b3};
}

struct EpiProj {
    static constexpr bool PERM = true, AFTER_DRAIN = false;
    bf16_t* proj; bf16_t* kpe; float* rss_q; float* rss_kv; const float* rope; float osc;
    template <int ACT> __device__ __forceinline__ void body(const f32x4 (&acc)[2][2][4][2], const Unit& u, int wr, int wc, int fr, int fq, float sc, float* rss) const {
        const int row0 = u.pm * BM + wr * 64 + fr, col0 = u.pn * BM + wc * 32 + 8 * fq;
#pragma unroll
        for (int ai = 0; ai < 2; ++ai)
#pragma unroll
            for (int m = 0; m < 4; ++m) { const int row = row0 + ai * HALF + m * 16; bf16_t* rowp = proj + (size_t)row * LDP + col0; float ss = 0.f;
#pragma unroll
                for (int bj = 0; bj < 2; ++bj) { f32x4 v0 = acc[ai][bj][m][0] * sc, v1 = acc[ai][bj][m][1] * sc;
                    if (ACT == 1) {
#pragma unroll
                        for (int e = 0; e < 4; ++e) { v0[e] = v0[e] * sigm(v0[e]); v1[e] = v1[e] * sigm(v1[e]); } }
                    if (ACT == 2) {
#pragma unroll
                        for (int e = 0; e < 4; ++e) { v0[e] = sigm(v0[e]); v1[e] = sigm(v1[e]); } }
                    if (ACT == 3) { ss += (v0[0] * v0[0] + v0[1] * v0[1]) + (v0[2] * v0[2] + v0[3] * v0[3]) + (v1[0] * v1[0] + v1[1] * v1[1]) + (v1[2] * v1[2] + v1[3] * v1[3]); }
                    *(u32x4*)(rowp + bj * HALF) = pack8(v0, v1); }
                if (ACT == 3) { ss += __shfl_xor(ss, 16); ss += __shfl_xor(ss, 32); if (fq == 0 && rss) atomicAdd(rss + row, ss); } }
    }
    __device__ __forceinline__ void operator()(const f32x4 (&acc)[2][2][4][2], const Unit& u, int wr, int wc, int fr, int fq) const {
        const int pn = u.pn;
        if (pn < 4) body<3>(acc, u, wr, wc, fr, fq, osc, rss_q);
        else if (pn < 6) body<3>(acc, u, wr, wc, fr, fq, osc, rss_kv);
        else if (pn < 42) body<0>(acc, u, wr, wc, fr, fq, pn < 18 ? QS_D * osc : osc, nullptr);
        else if (pn < 54) body<1>(acc, u, wr, wc, fr, fq, osc, nullptr);
        else if (pn < 86) body<2>(acc, u, wr, wc, fr, fq, osc, nullptr);
        else if (wc < 2) {
            const int row0 = u.pm * BM + wr * 64 + fr, c0 = wc * 32 + 8 * fq;
#pragma unroll
            for (int ai = 0; ai < 2; ++ai)
#pragma unroll
                for (int m = 0; m < 4; ++m) { const int row = row0 + ai * HALF + m * 16; f32x4 v0 = acc[ai][0][m][0] * osc, v1 = acc[ai][0][m][1] * osc;
                    const f32x4* cs = (const f32x4*)(rope + (size_t)row * 64 + c0); rope8(v0, v1, cs[0], cs[1]);
                    v0 = v0 * K8_SC; v1 = v1 * K8_SC; const i32x2 w8 = {cvt4_fp8(v0[0], v0[1], v0[2], v0[3]), cvt4_fp8(v1[0], v1[1], v1[2], v1[3])};
#pragma unroll
                    for (int hh = 0; hh < 16; ++hh) *(i32x2*)((unsigned char*)kpe + ((size_t)hh * SEQ + row) * 256 + 128 + c0) = w8; }
        }
    }
};
struct EpiQ {
    static constexpr bool PERM = true, AFTER_DRAIN = false;
    bf16_t* q; const float* rss; const float* rope;
    __device__ __forceinline__ void operator()(const f32x4 (&acc)[2][2][4][2], const Unit& u, int wr, int wc, int fr, int fq) const {
        const int row0 = u.pm * BM + wr * 64 + fr, col0 = u.pn * BM + wc * 32 + 8 * fq;
        const int cw0 = col0 % 192, cw1 = (col0 + HALF) % 192;
#pragma unroll
        for (int ai = 0; ai < 2; ++ai)
#pragma unroll
            for (int m = 0; m < 4; ++m) { const int row = row0 + ai * HALF + m * 16; const float sc = QS_M / sqrtf(rss[row] * (1.f / 1024.f) + RMS_EPS);
#pragma unroll
                for (int bj = 0; bj < 2; ++bj) { f32x4 v0 = acc[ai][bj][m][0] * sc, v1 = acc[ai][bj][m][1] * sc; const int cw = bj ? cw1 : cw0;
                    if (cw >= 128) { const f32x4* cs = (const f32x4*)(rope + (size_t)row * 64 + (cw - 128)); rope8(v0, v1, cs[0], cs[1]); }
                    v0 = v0 * Q8_SC; v1 = v1 * Q8_SC; *(i32x2*)((unsigned char*)q + (size_t)row * 3072 + col0 + bj * HALF) = (i32x2){cvt4_fp8(v0[0], v0[1], v0[2], v0[3]), cvt4_fp8(v1[0], v1[1], v1[2], v1[3])}; } }
    }
};
struct EpiKV {
    static constexpr bool PERM = true, AFTER_DRAIN = false;
    unsigned char* vt8; const float* rss; unsigned char* k8;
    __device__ __forceinline__ void operator()(const f32x4 (&acc)[2][2][4][2], const Unit& u, int wr, int wc, int fr, int fq) const {
        const int row0 = u.pm * BM + wr * 64 + fr, dl = wc * 32 + 8 * fq;
#pragma unroll
        for (int ai = 0; ai < 2; ++ai)
#pragma unroll
            for (int m = 0; m < 4; ++m) { const int row = row0 + ai * HALF + m * 16; const float sc = 1.f / sqrtf(rss[row] * (1.f / 512.f) + RMS_EPS);
                { const f32x4 k0v = acc[ai][0][m][0] * (sc * K8_SC), k1v = acc[ai][0][m][1] * (sc * K8_SC);
                  *(i32x2*)(k8 + ((size_t)u.pn * SEQ + row) * 256 + dl) = (i32x2){cvt4_fp8(k0v[0], k0v[1], k0v[2], k0v[3]), cvt4_fp8(k1v[0], k1v[1], k1v[2], k1v[3])}; }
                const f32x4 v0 = acc[ai][1][m][0] * (sc * V8_SC), v1 = acc[ai][1][m][1] * (sc * V8_SC);
                const unsigned w0 = (unsigned)cvt4_fp8(v0[0], v0[1], v0[2], v0[3]), w1 = (unsigned)cvt4_fp8(v1[0], v1[1], v1[2], v1[3]);
                const int kt = m * 16 + fr, kk = kt & 31, pi = ((kk >> 2) & 1) * 32 + (kk & 3) + 4 * (kk >> 3) + 16 * (kt >> 5);
                unsigned char* vp = vt8 + ((size_t)u.pn * 128 + dl) * SEQ + (row & ~63) + pi;
#pragma unroll
                for (int e2 = 0; e2 < 4; ++e2) { vp[(size_t)e2 * SEQ] = (unsigned char)(w0 >> (8 * e2)); vp[(size_t)(4 + e2) * SEQ] = (unsigned char)(w1 >> (8 * e2)); } }
    }
};
template <int PASS> struct EpiY {
    static constexpr bool PERM = true, AFTER_DRAIN = false;
    bf16_t* T; const bf16_t* gate; unsigned char* T8;
    __device__ __forceinline__ void operator()(const f32x4 (&acc)[2][2][4][2], const Unit& u, int wr, int wc, int fr, int fq) const {
        const int row0 = u.pm * BM + wr * 64 + fr, col0 = u.pn * BM + wc * 32 + 8 * fq;
        constexpr float osc = PASS == 0 ? 1.f / (A_SC * W_OM_SC) : 1.f / (B_SC * W_OD_SC), tsc = T_SC;
#pragma unroll
        for (int ai = 0; ai < 2; ++ai)
#pragma unroll
            for (int m = 0; m < 4; ++m) { const int row = row0 + ai * HALF + m * 16;
#pragma unroll
                for (int bj = 0; bj < 2; ++bj) { const u32x4 gw = *(const u32x4*)(gate + (size_t)row * LDP + col0 + bj * HALF); bf16_t* tp = T + (size_t)row * 4096 + col0 + bj * HALF;
                    f32x4 v0 = acc[ai][bj][m][0] * osc, v1 = acc[ai][bj][m][1] * osc;
                    v0 = v0 * (f32x4){bflo(gw.x), bfhi(gw.x), bflo(gw.y), bfhi(gw.y)}; v1 = v1 * (f32x4){bflo(gw.z), bfhi(gw.z), bflo(gw.w), bfhi(gw.w)};
                    if (PASS == 0) { *(u32x4*)tp = pack8(v0, v1); }
                    else { const u32x4 tw = *(const u32x4*)tp; v0 = (v0 + (f32x4){bflo(tw.x), bfhi(tw.x), bflo(tw.y), bfhi(tw.y)}) * tsc; v1 = (v1 + (f32x4){bflo(tw.z), bfhi(tw.z), bflo(tw.w), bfhi(tw.w)}) * tsc;
                        *(i32x2*)(T8 + (size_t)row * 4096 + col0 + bj * HALF) = (i32x2){cvt4_fp8(v0[0], v0[1], v0[2], v0[3]), cvt4_fp8(v1[0], v1[1], v1[2], v1[3])}; } } }
    }
};
struct EpiOut {
    static constexpr bool PERM = false, AFTER_DRAIN = false;
    const float* x; const float* stats; const float* g; const float* b; float* out; float osc;
    __device__ __forceinline__ void operator()(const f32x4 (&acc)[2][2][4][2], const Unit& u, int wr, int wc, int fr, int fq) const {
        const int row0 = u.pm * BM + wr * 64 + fr, col0 = u.pn * BM + wc * 32 + 4 * fq;
#pragma unroll
        for (int bj = 0; bj < 2; ++bj)
#pragma unroll
            for (int n = 0; n < 2; ++n) { const int col = col0 + bj * HALF + n * 16; const f32x4 gv = *(const f32x4*)(g + col) * ALPHA, bv = *(const f32x4*)(b + col) * ALPHA;
#pragma unroll
                for (int ai = 0; ai < 2; ++ai)
#pragma unroll
                    for (int m = 0; m < 4; ++m) { const int row = row0 + ai * HALF + m * 16; const f32x2 st = *(const f32x2*)(stats + 2 * row);
                        const size_t off = (size_t)row * 4096 + col; const f32x4 xv = *(const f32x4*)(x + off);
                        *(f32x4*)(out + off) = ((xv - st.x) * st.y) * gv + bv + acc[ai][bj][m][n] * osc; } }
    }
};

template <class Epi, class Sched, bool ALIGN_EPI = false, bool SP2 = false, bool FP8 = false>
__device__ __forceinline__ void gemm_phase(PG8_LAS unsigned char* lds, const Gemm g, const Sched S, const Epi E) {
    const int tid = opaque_tid(), wid = __builtin_amdgcn_readfirstlane(tid >> 6), lane = tid & 63, wr = wid >> 2, wc = wid & 3, fr = lane & 15, fq = lane >> 4;
    const int K = g.K, nt = K / BK;
    unsigned voffA[2], voffB[2];
#pragma unroll
    for (int i = 0; i < 2; ++i) { int R, C; stage_rc(tid * 16 + i * 8192, R, C); const int Rb = Epi::PERM ? ((R & ~31) + perm32(R & 31)) : R;
        voffA[i] = (unsigned)(R * g.lda + C) * 2u; voffB[i] = (unsigned)(Rb * g.ldb + C) * 2u; }
    const size_t kstep = (size_t)(BK * 2);
    const size_t hstepA = (size_t)HALF * g.lda * 2, hstepB = (size_t)HALF * g.ldb * 2;
    const size_t tstepA = 2 * hstepA, tstepB = 2 * hstepB;
    const unsigned ldsw = (unsigned)wid * 1024u;
    const int aoff = lds_byte(wr * 64 + fr, fq * 8), boff = lds_byte(wc * 32 + fr, fq * 8);
#define PG8_SA(b, h) (((b) * 2 + (h)) * HTB)
#define PG8_SB(b, h) ((4 + (b) * 2 + (h)) * HTB)
#define PG8_STAGE(bufoff, gbase, voff) do { _Pragma("unroll") for (int _i = 0; _i < 2; ++_i) \
        __builtin_amdgcn_global_load_lds((const unsigned*)((const char*)(gbase) + (voff)[_i]), (PG8_LAS unsigned*)(lds + (bufoff) + ldsw + _i * 8192), 16, 0, 0); } while (0)
#define PG8_LDA(dst, b, h) do { if constexpr (FP8) { _Pragma("unroll") for (int m = 0; m < 4; ++m) dst##8[m] = cat8(*(const PG8_LAS bf16x8*)(lds + PG8_SA(b, h) + aoff + m * 2048), *(const PG8_LAS bf16x8*)(lds + PG8_SA(b, h) + aoff + m * 2048 + 1024)); } \
    else { _Pragma("unroll") for (int m = 0; m < 4; ++m) _Pragma("unroll") for (int k = 0; k < 2; ++k) dst[m][k] = *(const PG8_LAS bf16x8*)(lds + PG8_SA(b, h) + aoff + m * 2048 + k * 1024); } } while (0)
#define PG8_LDB(dst, b, h) do { if constexpr (FP8) { _Pragma("unroll") for (int n = 0; n < 2; ++n) dst##8[n] = cat8(*(const PG8_LAS bf16x8*)(lds + PG8_SB(b, h) + boff + n * 2048), *(const PG8_LAS bf16x8*)(lds + PG8_SB(b, h) + boff + n * 2048 + 1024)); } \
    else { _Pragma("unroll") for (int n = 0; n < 2; ++n) _Pragma("unroll") for (int k = 0; k < 2; ++k) dst[n][k] = *(const PG8_LAS bf16x8*)(lds + PG8_SB(b, h) + boff + n * 2048 + k * 1024); } } while (0)
#define PG8_MMA(ai, bj, At, Bt) do { __builtin_amdgcn_s_setprio(1); if constexpr (FP8) { _Pragma("unroll") for (int m = 0; m < 4; ++m) _Pragma("unroll") for (int n = 0; n < 2; ++n) \
        asm volatile("v_mfma_f32_16x16x128_f8f6f4 %0, %1, %2, %0" : "+v"(acc[ai][bj][m][n]) : "v"(Bt##8[n]), "v"(At##8[m])); } else { \
        _Pragma("unroll") for (int m = 0; m < 4; ++m) _Pragma("unroll") for (int n = 0; n < 2; ++n) _Pragma("unroll") for (int k = 0; k < 2; ++k) \
        acc[ai][bj][m][n] = __builtin_amdgcn_mfma_f32_16x16x32_bf16(Bt[n][k], At[m][k], acc[ai][bj][m][n], 0, 0, 0); } __builtin_amdgcn_s_setprio(0); } while (0)
#define PG8_WAIT_V(n) asm volatile("s_waitcnt vmcnt(" #n ")" ::: "memory")
#define PG8_WAIT_L(n) asm volatile("s_waitcnt lgkmcnt(" #n ")" ::: "memory")
#define PG8_BAR __builtin_amdgcn_s_barrier()
#define PG8_SCHED __builtin_amdgcn_sched_barrier(0)
    Unit cur, nxt; int ui = 0;
    if (!S.next(0, cur)) return;
    f32x4 acc[2][2][4][2];
#pragma unroll
    for (int a = 0; a < 2; ++a)
#pragma unroll
        for (int b = 0; b < 2; ++b)
#pragma unroll
            for (int m = 0; m < 4; ++m)
#pragma unroll
                for (int n = 0; n < 2; ++n) acc[a][b][m][n] = (f32x4){0.f, 0.f, 0.f, 0.f};
    bf16x8 At[4][2], B0[2][2], B1[2][2]; i32x8 At8[4], B08[2], B18[2];
    const char* cA = (const char*)g.A + (size_t)cur.pm * tstepA; const char* cB = (const char*)g.Bt + (size_t)cur.pn * tstepB;
    S.a_ready(cur);
    if constexpr (SP2) {
        PG8_STAGE(PG8_SB(0, 0), cB, voffB); PG8_STAGE(PG8_SB(0, 1), cB + hstepB, voffB); PG8_STAGE(PG8_SA(0, 0), cA, voffA); PG8_STAGE(PG8_SA(0, 1), cA + hstepA, voffA);
        if (wr == 1) PG8_BAR;
        PG8_WAIT_V(2); PG8_BAR;
        PG8_STAGE(PG8_SB(1, 0), cB + kstep, voffB); PG8_STAGE(PG8_SA(1, 0), cA + kstep, voffA); PG8_STAGE(PG8_SB(1, 1), cB + hstepB + kstep, voffB);
        PG8_WAIT_V(6); PG8_BAR;
    } else {
        PG8_STAGE(PG8_SB(0, 0), cB, voffB); PG8_STAGE(PG8_SA(0, 0), cA, voffA); PG8_STAGE(PG8_SB(0, 1), cB + hstepB, voffB); PG8_STAGE(PG8_SA(0, 1), cA + hstepA, voffA);
        if (wr == 1) PG8_BAR;
        PG8_WAIT_V(4); PG8_BAR;
        PG8_STAGE(PG8_SB(1, 0), cB + kstep, voffB); PG8_STAGE(PG8_SA(1, 0), cA + kstep, voffA); PG8_STAGE(PG8_SB(1, 1), cB + hstepB + kstep, voffB);
        PG8_WAIT_V(6); PG8_BAR;
    }
    for (;;) {
        const bool has_next = S.next(ui + 1, nxt);
        const char* nA = has_next ? (const char*)g.A + (size_t)nxt.pm * tstepA : cA; const char* nB = has_next ? (const char*)g.Bt + (size_t)nxt.pn * tstepB : cB;
        for (int t = 0; t < nt; t += 2) {
            const bool last = (t == nt - 2);
            const char* a1 = cA + (size_t)(t + 1) * kstep;
            const char* a2 = last ? nA : cA + (size_t)(t + 2) * kstep; const char* b2 = last ? nB : cB + (size_t)(t + 2) * kstep;
            const char* a3 = a2 + kstep; const char* b3 = b2 + kstep;
            if (last && has_next) S.a_ready(nxt);
            if constexpr (SP2) {
            PG8_LDB(B0, 0, 0); PG8_LDB(B1, 0, 1); PG8_SCHED; PG8_LDA(At, 0, 0); PG8_STAGE(PG8_SA(1, 1), a1 + hstepA, voffA);
            PG8_WAIT_V(8); PG8_WAIT_L(0); PG8_BAR; PG8_MMA(0, 0, At, B0); PG8_MMA(0, 1, At, B1); PG8_BAR; PG8_SCHED;
            PG8_LDA(At, 0, 1); PG8_STAGE(PG8_SB(0, 0), b2, voffB); PG8_STAGE(PG8_SB(0, 1), b2 + hstepB, voffB); PG8_STAGE(PG8_SA(0, 0), a2, voffA);
            PG8_WAIT_V(8); PG8_WAIT_L(0); PG8_BAR; PG8_MMA(1, 0, At, B0); PG8_MMA(1, 1, At, B1); PG8_BAR; PG8_SCHED;
            PG8_LDB(B0, 1, 0); PG8_LDB(B1, 1, 1); PG8_SCHED; PG8_LDA(At, 1, 0); PG8_STAGE(PG8_SA(0, 1), a2 + hstepA, voffA);
            PG8_WAIT_V(8); PG8_WAIT_L(0); PG8_BAR; PG8_MMA(0, 0, At, B0); PG8_MMA(0, 1, At, B1); PG8_BAR; PG8_SCHED;
            PG8_LDA(At, 1, 1); PG8_STAGE(PG8_SB(1, 0), b3, voffB); PG8_STAGE(PG8_SB(1, 1), b3 + hstepB, voffB); PG8_STAGE(PG8_SA(1, 0), a3, voffA);
            PG8_WAIT_V(8); PG8_WAIT_L(0); PG8_BAR; PG8_MMA(1, 0, At, B0); PG8_MMA(1, 1, At, B1); PG8_BAR; PG8_SCHED;
            } else {
            PG8_LDB(B0, 0, 0); PG8_SCHED; PG8_LDA(At, 0, 0); PG8_STAGE(PG8_SA(1, 1), a1 + hstepA, voffA);
            PG8_WAIT_L(8); PG8_BAR; PG8_WAIT_L(0); PG8_MMA(0, 0, At, B0); PG8_BAR; PG8_SCHED;
            PG8_LDB(B1, 0, 1); PG8_STAGE(PG8_SB(0, 0), b2, voffB);
            PG8_BAR; PG8_WAIT_L(0); PG8_MMA(0, 1, At, B1); PG8_BAR;
            PG8_LDA(At, 0, 1); PG8_STAGE(PG8_SA(0, 0), a2, voffA);
            PG8_BAR; PG8_WAIT_L(0); PG8_MMA(1, 0, At, B0); PG8_BAR; PG8_SCHED;
            PG8_STAGE(PG8_SB(0, 1), b2 + hstepB, voffB);
            PG8_WAIT_V(6); PG8_BAR; PG8_MMA(1, 1, At, B1); PG8_BAR;
            PG8_LDB(B0, 1, 0); PG8_SCHED; PG8_LDA(At, 1, 0); PG8_STAGE(PG8_SA(0, 1), a2 + hstepA, voffA);
            PG8_WAIT_L(8); PG8_BAR; PG8_WAIT_L(0); PG8_MMA(0, 0, At, B0); PG8_BAR; PG8_SCHED;
            PG8_LDB(B1, 1, 1); PG8_STAGE(PG8_SB(1, 0), b3, voffB);
            PG8_BAR; PG8_WAIT_L(0); PG8_MMA(0, 1, At, B1); PG8_BAR;
            PG8_LDA(At, 1, 1); PG8_STAGE(PG8_SA(1, 0), a3, voffA);
            PG8_BAR; PG8_WAIT_L(0); PG8_MMA(1, 0, At, B0); PG8_BAR; PG8_SCHED;
            PG8_STAGE(PG8_SB(1, 1), b3 + hstepB, voffB);
            PG8_WAIT_V(6); PG8_BAR; PG8_MMA(1, 1, At, B1); PG8_BAR;
            }
        }
        if constexpr (ALIGN_EPI) { if (wr == 0) PG8_BAR; }
        if constexpr (FP8) asm volatile("s_nop 15\n\ts_nop 15" ::: "memory");
        if constexpr (!Epi::AFTER_DRAIN) { E(acc, cur, wr, wc, fr, fq); S.done(cur); }
        if (!has_next) break;
#pragma unroll
        for (int a = 0; a < 2; ++a)
#pragma unroll
            for (int b = 0; b < 2; ++b)
#pragma unroll
                for (int m = 0; m < 4; ++m)
#pragma unroll
                    for (int n = 0; n < 2; ++n) acc[a][b][m][n] = (f32x4){0.f, 0.f, 0.f, 0.f};
        cur = nxt; cA = nA; cB = nB; ++ui;
        if constexpr (ALIGN_EPI) { if (wr == 1) PG8_BAR; }
    }
    PG8_WAIT_V(0);
    if constexpr (!ALIGN_EPI) { if (wr == 0) PG8_BAR; }
    PG8_BAR;
    if constexpr (Epi::AFTER_DRAIN) { E.fused(acc, cur, wr, wc, fr, fq, lds, wid, lane); S.done(cur); }
#undef PG8_SA
#undef PG8_SB
#undef PG8_STAGE
#undef PG8_LDA
#undef PG8_LDB
#undef PG8_MMA
#undef PG8_WAIT_V
#undef PG8_WAIT_L
#undef PG8_BAR
#undef PG8_SCHED
}
}

namespace att {
typedef unsigned short bf16_t;
using bf16x8 = __attribute__((ext_vector_type(8))) short;
using s16x4  = __attribute__((ext_vector_type(4))) short;
using f32x16 = __attribute__((ext_vector_type(16))) float;
using u32x4  = __attribute__((ext_vector_type(4))) unsigned;
constexpr int NW = 8, QBLK = 32, KVBLK = 64;
constexpr int SHM_V = 16384, SHM_KN = 16384, SHM_KP = 8192;
constexpr int OFF_V = 0, OFF_KN = 2 * SHM_V, OFF_KP = OFF_KN + 2 * SHM_KN, OFF_WS = OFF_KP + 2 * SHM_KP, OFF_BIAS = OFF_WS + NW * 64 * 4, OFF_QPE = OFF_BIAS + 1024, ATT_LDS = OFF_QPE + NW * 4096, M_QPE = 3 * 40960 + 2048;
#define KSWZ(row, colB) ((row) * 256 + ((colB) ^ (((row) & 15) << 4)))
#define KPSWZ(row, colB) ((row) * 128 + ((colB) ^ ((((row) >> 1) & 7) << 4)))
#define SBAR() __builtin_amdgcn_sched_barrier(0)
__device__ __forceinline__ int crow(int r, int hi) { return (r & 3) + 8 * (r >> 2) + 4 * hi; }
typedef float f32x2_t __attribute__((ext_vector_type(2))); typedef __bf16 bf16x2_t __attribute__((ext_vector_type(2)));
__device__ __forceinline__ unsigned cvtpk(float lo, float hi) { f32x2_t v = {lo, hi}; bf16x2_t b = __builtin_convertvector(v, bf16x2_t); return __builtin_bit_cast(unsigned, b); }
__device__ __forceinline__ bf16x8 ld8(const bf16_t* p) { return *reinterpret_cast<const bf16x8*>(p); }

template <int THR2>
__device__ __forceinline__ void partialSM(f32x16& p0, f32x16& p1, float& m_reg, float& alpha, const float C = 1.f) {
  float pmax = p0[0];
#pragma unroll
  for (int r = 1; r < 16; ++r) pmax = fmaxf(pmax, p0[r]);
#pragma unroll
  for (int r = 0; r < 16; ++r) pmax = fmaxf(pmax, p1[r]);
  { auto rr = __builtin_amdgcn_permlane32_swap(__float_as_uint(pmax), __float_as_uint(pmax), false, false);
    pmax = fmaxf(__uint_as_float(rr[0]), __uint_as_float(rr[1])) * C; }
  float mn;
  if (THR2 > 0 && __builtin_expect(__all(pmax - m_reg <= (float)THR2), 1)) { mn = m_reg; alpha = 1.f; }
  else { mn = fmaxf(m_reg, pmax); alpha = __builtin_amdgcn_exp2f(m_reg - mn); m_reg = mn; }
#pragma unroll
  for (int r = 0; r < 16; ++r) p0[r] = fmaf(p0[r], C, -mn);
#pragma unroll
  for (int r = 0; r < 16; ++r) p1[r] = fmaf(p1[r], C, -mn);
#pragma unroll
  for (int r = 0; r < 16; ++r) p0[r] = __builtin_amdgcn_exp2f(p0[r]);
}
__device__ __forceinline__ void finishSM(f32x16& p0, f32x16& p1, float alpha, float& l_reg, bf16x8& pa0, bf16x8& pa1, bf16x8& pa2, bf16x8& pa3) {
#pragma unroll
  for (int r = 0; r < 16; ++r) p1[r] = __builtin_amdgcn_exp2f(p1[r]);
  float ps = 0;
#pragma unroll
  for (int r = 0; r < 16; ++r) ps += p0[r];
#pragma unroll
  for (int r = 0; r < 16; ++r) ps += p1[r];
  { auto rr = __builtin_amdgcn_permlane32_swap(__float_as_uint(ps), __float_as_uint(ps), false, false);
    ps = __uint_as_float(rr[0]) + __uint_as_float(rr[1]); }
  l_reg = l_reg * alpha + ps;
#define PK4(P, BASE, OUT) do { unsigned a0 = cvtpk(P[BASE + 0], P[BASE + 1]), a1 = cvtpk(P[BASE + 2], P[BASE + 3]);   \
    unsigned b0 = cvtpk(P[BASE + 4], P[BASE + 5]), b1 = cvtpk(P[BASE + 6], P[BASE + 7]);                              \
    auto r0 = __builtin_amdgcn_permlane32_swap(a0, b0, false, false); auto r1 = __builtin_amdgcn_permlane32_swap(a1, b1, false, false); \
    u32x4 w = {r0[0], r1[0], r0[1], r1[1]}; OUT = *reinterpret_cast<bf16x8*>(&w); } while (0)
  PK4(p0, 0, pa0); PK4(p0, 8, pa1); PK4(p1, 0, pa2); PK4(p1, 8, pa3);
#undef PK4
}
template <int NPE>
__device__ __forceinline__ void qkt(f32x16& p0, f32x16& p1, const char* Kn, const char* Kp, const bf16x8* qr, const char* qpe, int r32, int hi) {
  p0 = f32x16{}; p1 = f32x16{};
#pragma unroll
  for (int d0 = 0; d0 < 8; ++d0) { const int cb = (d0 * 16 + hi * 8) * 2;
    bf16x8 b0 = *reinterpret_cast<const bf16x8*>(Kn + KSWZ(r32, cb));
    bf16x8 b1 = *reinterpret_cast<const bf16x8*>(Kn + KSWZ(32 + r32, cb));
    p0 = __builtin_amdgcn_mfma_f32_32x32x16_bf16(b0, qr[d0], p0, 0, 0, 0);
    p1 = __builtin_amdgcn_mfma_f32_32x32x16_bf16(b1, qr[d0], p1, 0, 0, 0); }
#pragma unroll
  for (int d0 = 0; d0 < NPE; ++d0) { const int cb = (d0 * 16 + hi * 8) * 2;
    bf16x8 b0 = *reinterpret_cast<const bf16x8*>(Kp + KPSWZ(r32, cb));
    bf16x8 b1 = *reinterpret_cast<const bf16x8*>(Kp + KPSWZ(32 + r32, cb));
    p0 = __builtin_amdgcn_mfma_f32_32x32x16_bf16(b0, qr[8 + d0], p0, 0, 0, 0);
    p1 = __builtin_amdgcn_mfma_f32_32x32x16_bf16(b1, qr[8 + d0], p1, 0, 0, 0); }
}
typedef int i32x8 __attribute__((ext_vector_type(8))); typedef int i32x4 __attribute__((ext_vector_type(4)));
__device__ __forceinline__ void qkt8(f32x16& p0, f32x16& p1, const char* K8t, const i32x8* q8, int r32, int hi) {
  p0 = f32x16{}; p1 = f32x16{};
#pragma unroll
  for (int s = 0; s < 3; ++s) { const int cb = 64 * s + 32 * hi;
    const i32x4 a0 = *reinterpret_cast<const i32x4*>(K8t + KSWZ(r32, cb)), a1 = *reinterpret_cast<const i32x4*>(K8t + KSWZ(r32, cb + 16));
    const i32x4 c0 = *reinterpret_cast<const i32x4*>(K8t + KSWZ(32 + r32, cb)), c1 = *reinterpret_cast<const i32x4*>(K8t + KSWZ(32 + r32, cb + 16));
    p0 = __builtin_amdgcn_mfma_scale_f32_32x32x64_f8f6f4(__builtin_shufflevector(a0, a1, 0, 1, 2, 3, 4, 5, 6, 7), q8[s], p0, 0, 0, 0, 0, 0, 0);
    p1 = __builtin_amdgcn_mfma_scale_f32_32x32x64_f8f6f4(__builtin_shufflevector(c0, c1, 0, 1, 2, 3, 4, 5, 6, 7), q8[s], p1, 0, 0, 0, 0, 0, 0); }
}
__device__ __forceinline__ int cvt4nc(float a, float b, float c, float d) { const int r = __builtin_amdgcn_cvt_pk_fp8_f32(a, b, 0, false); return __builtin_amdgcn_cvt_pk_fp8_f32(c, d, r, true); }
__device__ __forceinline__ void finishSM8(f32x16& p0, f32x16& p1, float alpha, float& l_reg, i32x8& pa) {
#pragma unroll
  for (int r = 0; r < 16; ++r) p1[r] = __builtin_amdgcn_exp2f(p1[r]);
  float ps = 0;
#pragma unroll
  for (int r = 0; r < 16; ++r) ps += p0[r];
#pragma unroll
  for (int r = 0; r < 16; ++r) ps += p1[r];
  { auto rr = __builtin_amdgcn_permlane32_swap(__float_as_uint(ps), __float_as_uint(ps), false, false);
    ps = __uint_as_float(rr[0]) + __uint_as_float(rr[1]); }
  l_reg = l_reg * alpha + ps;
#pragma unroll
  for (int i = 0; i < 4; ++i) { pa[i] = cvt4nc(p0[4 * i], p0[4 * i + 1], p0[4 * i + 2], p0[4 * i + 3]); pa[4 + i] = cvt4nc(p1[4 * i], p1[4 * i + 1], p1[4 * i + 2], p1[4 * i + 3]); }
}
__device__ __forceinline__ void pv8(f32x16* o, const char* VT, const i32x8 pa, int r32, int hi) {
  const int f = (r32 >> 2) & 3; const char* b = VT + r32 * 64; const int c0 = ((2 * hi) ^ f) * 16, c1 = ((2 * hi + 1) ^ f) * 16;
#pragma unroll
  for (int d0 = 0; d0 < 4; ++d0) { const i32x4 x = *reinterpret_cast<const i32x4*>(b + d0 * 2048 + c0), y = *reinterpret_cast<const i32x4*>(b + d0 * 2048 + c1);
    o[d0] = __builtin_amdgcn_mfma_scale_f32_32x32x64_f8f6f4(pa, __builtin_shufflevector(x, y, 0, 1, 2, 3, 4, 5, 6, 7), o[d0], 0, 0, 0, 0, 0, 0); }
}
__device__ __forceinline__ int v_st(int k, int c) { const int kk = (k & ~0xC) | ((k & 4) << 1) | ((k & 8) >> 1); return ((kk >> 3) * 4 + (c >> 5)) * 512 + ((kk & 7) * 32 + (c & 31)) * 2; }
__device__ __forceinline__ int v_rd_base(int lane) { return ((lane & 3) << 3) | (((lane >> 2) & 3) << 6) | (((lane >> 4) & 1) << 5) | (((lane >> 5) & 1) << 8); }
constexpr int v_rd_off(int d0, int ks, int half) { return d0 * 512 + ks * 4096 + half * 2048; }
template <int OFF> __device__ __forceinline__ s16x4 tr_read(int vb) {
  s16x4 r; asm volatile("ds_read_b64_tr_b16 %0, %1 offset:%2" : "=&v"(r) : "v"(vb), "i"(OFF) : "memory"); return r;
}
template <int D0> __device__ __forceinline__ void pv_one(f32x16& od, int vb, bf16x8 pa0, bf16x8 pa1, bf16x8 pa2, bf16x8 pa3) {
  const s16x4 l0 = tr_read<v_rd_off(D0, 0, 0)>(vb), h0 = tr_read<v_rd_off(D0, 0, 1)>(vb), l1 = tr_read<v_rd_off(D0, 1, 0)>(vb), h1 = tr_read<v_rd_off(D0, 1, 1)>(vb);
  const s16x4 l2 = tr_read<v_rd_off(D0, 2, 0)>(vb), h2 = tr_read<v_rd_off(D0, 2, 1)>(vb), l3 = tr_read<v_rd_off(D0, 3, 0)>(vb), h3 = tr_read<v_rd_off(D0, 3, 1)>(vb);
  asm volatile("s_waitcnt lgkmcnt(0)" ::: "memory"); SBAR();
#define PK(L, H) (bf16x8){L[0], L[1], L[2], L[3], H[0], H[1], H[2], H[3]}
  od = __builtin_amdgcn_mfma_f32_32x32x16_bf16(pa0, PK(l0, h0), od, 0, 0, 0);
  od = __builtin_amdgcn_mfma_f32_32x32x16_bf16(pa1, PK(l1, h1), od, 0, 0, 0);
  od = __builtin_amdgcn_mfma_f32_32x32x16_bf16(pa2, PK(l2, h2), od, 0, 0, 0);
  od = __builtin_amdgcn_mfma_f32_32x32x16_bf16(pa3, PK(l3, h3), od, 0, 0, 0);
#undef PK
}
__device__ __forceinline__ void pv_d0(f32x16* o, int vb, bf16x8 pa0, bf16x8 pa1, bf16x8 pa2, bf16x8 pa3) {
  pv_one<0>(o[0], vb, pa0, pa1, pa2, pa3); pv_one<1>(o[1], vb, pa0, pa1, pa2, pa3); pv_one<2>(o[2], vb, pa0, pa1, pa2, pa3); pv_one<3>(o[3], vb, pa0, pa1, pa2, pa3);
}
#define RESC(a) do { if (__any((a) < 1.f)) { if (hi == 0) al_l[r32] = (a); asm volatile("s_waitcnt lgkmcnt(0)" ::: "memory"); \
    _Pragma("unroll") for (int d = 0; d < 4; ++d) _Pragma("unroll") for (int r = 0; r < 16; ++r) o[d][r] *= al_l[crow(r, hi)]; } } while (0)

#define LAS3 __attribute__((address_space(3)))
__device__ __forceinline__ void mla_unit(const bf16_t* __restrict__ Qb, const bf16_t* __restrict__ Kh, const bf16_t* __restrict__ Vh, const bf16_t* __restrict__ Kpe,
                                         const bf16_t* __restrict__ Gb, bf16_t* __restrict__ Ob, char* lds, LAS3 unsigned char* ldsl) {
  constexpr int LDQ = 3072, LDK = 4096, LDO = 2048, NT = SEQ / KVBLK; constexpr float QKC = 1.f / (Q8_SC * K8_SC);
  constexpr int STG = 24576, O_V = 0, O_KN = 8192, M_WS = 3 * STG;
  const int tid = opaque_tid(), wid = __builtin_amdgcn_readfirstlane(tid >> 6), lane = tid & 63, r32 = lane & 31, hi = lane >> 5;
  float* ws = (float*)(lds + M_WS) + wid * 64; float* li_l = ws; float* al_l = ws + 32;
  float m_reg = -1e30f, l_reg = 0; f32x16 o[4] = {}; i32x8 q8[3];
  { const unsigned char* Qw = (const unsigned char*)Qb + (long)(wid * QBLK + r32) * LDQ + hi * 32;
#pragma unroll
    for (int s = 0; s < 3; ++s) { const i32x4 a = *reinterpret_cast<const i32x4*>(Qw + 64 * s), b = *reinterpret_cast<const i32x4*>(Qw + 64 * s + 16); q8[s] = __builtin_shufflevector(a, b, 0, 1, 2, 3, 4, 5, 6, 7); } }
  asm volatile("s_waitcnt vmcnt(0)" ::: "memory"); SBAR();
  int vsrc, ksrc[2];
#pragma unroll
  for (int i = 0; i < 2; ++i) { const int c = wid + 8 * i;
    { const int row = c * 4 + (lane >> 4), colB = ((lane & 15) * 16) ^ ((row & 15) << 4); ksrc[i] = row * 256 + colB; } }
  { const int row = wid * 16 + (lane >> 2), ch = (lane & 3) ^ ((row >> 2) & 3); vsrc = row * SEQ + ch * 16; }
#define DMA16(gptr, ldsoff) __builtin_amdgcn_global_load_lds((const unsigned*)(gptr), (LAS3 unsigned*)(ldsl + (ldsoff)), 16, 0, 0)
#define ISSUE_K(t, s) do { const unsigned char* kb_ = (const unsigned char*)Kh + (long)(t) * (KVBLK * 256); DMA16(kb_ + ksrc[0], (s) * STG + O_KN + wid * 1024); DMA16(kb_ + ksrc[1], (s) * STG + O_KN + (wid + 8) * 1024); } while (0)
#define ISSUE_V(t, s) do { DMA16((const unsigned char*)Vh + (long)(t) * KVBLK + vsrc, (s) * STG + O_V + wid * 1024); } while (0)
#define WAITBAR(N) do { asm volatile("s_waitcnt vmcnt(" #N ") lgkmcnt(0)" ::: "memory"); __builtin_amdgcn_s_barrier(); asm volatile("" ::: "memory"); } while (0)
  f32x16 pA0, pA1, pB0, pB1; float alA, alB; i32x8 pa;
  int s0 = 0, s1 = 1, s2 = 2;
#define ROT() do { const int t_ = s0; s0 = s1; s1 = s2; s2 = t_; } while (0)
  ISSUE_K(0, 0); ISSUE_V(0, 0); ISSUE_K(1, 1);
  WAITBAR(2);
  ISSUE_K(2, s2); ISSUE_V(1, s1);
  qkt8(pA0, pA1, lds + s0 * STG + O_KN, q8, r32, hi); partialSM<8>(pA0, pA1, m_reg, alA, QKC);
  WAITBAR(3); ROT();
#define STEP(PX0, PX1, ALX, PY0, PY1, ALY, j_) do { const bool ik_ = (j_) + 2 < NT, iv_ = (j_) + 1 < NT; \
    if (ik_) ISSUE_K((j_) + 2, s2); if (iv_) ISSUE_V((j_) + 1, s1); \
    SBAR(); qkt8(PX0, PX1, lds + s0 * STG + O_KN, q8, r32, hi); \
    finishSM8(PY0, PY1, ALY, l_reg, pa); SBAR(); \
    pv8(o, lds + s2 * STG + O_V, pa, r32, hi); partialSM<8>(PX0, PX1, m_reg, ALX, QKC); \
    RESC(ALX); \
    if (ik_) WAITBAR(3); else WAITBAR(0); ROT(); } while (0)
  for (int j = 1; j + 1 < NT; j += 2) {
    STEP(pB0, pB1, alB, pA0, pA1, alA, j);
    STEP(pA0, pA1, alA, pB0, pB1, alB, j + 1);
  }
  STEP(pB0, pB1, alB, pA0, pA1, alA, NT - 1);
  finishSM8(pB0, pB1, alB, l_reg, pa); SBAR();
  pv8(o, lds + s2 * STG + O_V, pa, r32, hi);
  if (hi == 0) li_l[r32] = l_reg; asm volatile("s_waitcnt lgkmcnt(0)" ::: "memory");
  float rli[16];
#pragma unroll
  for (int r = 0; r < 16; ++r) rli[r] = __builtin_amdgcn_rcpf(li_l[crow(r, hi)]) * (1.f / V8_SC);
  __syncthreads();
  const bf16_t* Gw = Gb + (long)(wid * QBLK) * LDP;
  { bf16_t* stg = (bf16_t*)(lds + wid * 8704);
#pragma unroll
    for (int r = 0; r < 16; ++r) { const int orow = crow(r, hi);
#pragma unroll
      for (int d0 = 0; d0 < 4; ++d0) { const float ov = o[d0][r] * rli[r]; stg[orow * 136 + d0 * 32 + r32] = (bf16_t)(cvtpk(ov, ov) & 0xffffu); } }
    asm volatile("s_waitcnt lgkmcnt(0)" ::: "memory");
    int lz = lane; asm volatile("" : "+v"(lz));
#pragma unroll
    for (int i = 0; i < 8; ++i) { const int id = i * 64 + lz, row = id >> 4, c = (id & 15) * 8;
      const u32x4 ov = *(const u32x4*)(stg + row * 136 + c); const u32x4 gv = *(const u32x4*)(Gw + (long)row * LDP + c);
#define PLO(k) (__uint_as_float(ov[k] << 16) * __uint_as_float(gv[k] << 16) * A_SC)
#define PHI(k) (__uint_as_float(ov[k] & 0xffff0000u) * __uint_as_float(gv[k] & 0xffff0000u) * A_SC)
      typedef int i32x2 __attribute__((ext_vector_type(2)));
      *(i32x2*)((unsigned char*)Ob + (long)(wid * QBLK + row) * LDO + c) = (i32x2){pg8::cvt4_fp8(PLO(0), PHI(0), PLO(1), PHI(1)), pg8::cvt4_fp8(PLO(2), PHI(2), PLO(3), PHI(3))}; } }
#undef PLO
#undef PHI
  __syncthreads();
#undef DMA16
#undef ISSUE_K
#undef ISSUE_V
#undef WAITBAR
#undef ROT
#undef STEP
}

__device__ __forceinline__ void dswa_unit(int H, int rs, int qb, const bf16_t* __restrict__ proj, const float* __restrict__ bias2, bf16_t* __restrict__ Od, float* __restrict__ lse, char* lds) {
  const int g = H >> 3, dil = 1 << (2 * g), L = SEQ / dil, Q0 = qb * 256, T0 = Q0 - 64;
  const int tid = opaque_tid(), wid = tid >> 6, lane = tid & 63, r32 = lane & 31, hi = lane >> 5;
  char* V_lds = lds + OFF_V; char* Kn_lds = lds + OFF_KN;
  float* ws = (float*)(lds + OFF_WS) + wid * 64; float* li_l = ws; float* al_l = ws + 32;
  float* bl = (float*)(lds + OFF_BIAS);
  const bf16_t* Qp = proj + C_DQ + H * 128; const bf16_t* Kp = proj + C_DK + H * 128; const bf16_t* Vp = proj + C_DV + H * 128;
  if (tid < 129) bl[tid] = bias2[(g * 8 + (H & 7)) * 129 + tid];
  const int qa = Q0 + wid * QBLK, qi = qa + r32;
  bf16x8 qr[8];
  { const bf16_t* Qw = Qp + (size_t)(qi * dil + rs) * LDP + hi * 8;
#pragma unroll
    for (int d0 = 0; d0 < 8; ++d0) qr[d0] = ld8(Qw + d0 * 16); }
  const int sr = tid >> 4, sc = (tid & 15) * 8, vst0 = v_st(sr, sc), vst1 = v_st(32 + sr, sc);
  const int vb0 = (int)(uintptr_t)V_lds + v_rd_base(lane);
  float m_reg = -1e29f, l_reg = 0.f; f32x16 o[4] = {};
  const int tlo = (Q0 == 0) ? 1 : 0, thi = (Q0 + 256 >= L) ? 5 : 6;
  bf16x8 vs0, vs1, ks0, ks1;
#define DLOAD(t_) do { const int k0_ = T0 + 64 * (t_); int i0 = k0_ + sr, i1 = k0_ + 32 + sr; i0 = i0 < 0 ? 0 : (i0 >= L ? L - 1 : i0); i1 = i1 < 0 ? 0 : (i1 >= L ? L - 1 : i1); \
    const size_t o0 = (size_t)(i0 * dil + rs) * LDP + sc, o1 = (size_t)(i1 * dil + rs) * LDP + sc; vs0 = ld8(Vp + o0); vs1 = ld8(Vp + o1); ks0 = ld8(Kp + o0); ks1 = ld8(Kp + o1); } while (0)
  DLOAD(tlo);
  for (int t = tlo; t < thi; ++t) {
    const int k0 = T0 + 64 * t;
    __syncthreads();
    *(bf16x8*)(V_lds + vst0) = vs0; *(bf16x8*)(V_lds + vst1) = vs1;
    *(bf16x8*)(Kn_lds + KSWZ(sr, sc * 2)) = ks0; *(bf16x8*)(Kn_lds + KSWZ(32 + sr, sc * 2)) = ks1;
    __syncthreads();
    if (t + 1 < thi) DLOAD(t + 1);
    if (k0 > qa + 31 + 64 || k0 + 63 < qa - 64) continue;
    f32x16 p0, p1; qkt<0>(p0, p1, Kn_lds, Kn_lds, qr, Kn_lds, r32, hi);
#pragma unroll
    for (int r = 0; r < 16; ++r) { const int kj = k0 + crow(r, hi), dj = kj - qi; int bi = dj + 64; bi = bi < 0 ? 0 : (bi > 128 ? 128 : bi);
      const int kj1 = kj + 32, dj1 = dj + 32; int bi1 = dj1 + 64; bi1 = bi1 < 0 ? 0 : (bi1 > 128 ? 128 : bi1);
      const bool ok0 = (dj >= -64) && (dj <= 64) && (kj >= 0) && (kj < L), ok1 = (dj1 >= -64) && (dj1 <= 64) && (kj1 >= 0) && (kj1 < L);
      p0[r] = ok0 ? p0[r] + bl[bi] : -1e30f; p1[r] = ok1 ? p1[r] + bl[bi1] : -1e30f; }
    float al; partialSM<0>(p0, p1, m_reg, al);
    bf16x8 pa0, pa1, pa2, pa3; finishSM(p0, p1, al, l_reg, pa0, pa1, pa2, pa3);
    RESC(al);
    SBAR(); pv_d0(o, vb0, pa0, pa1, pa2, pa3);
  }
#undef DLOAD
  if (hi == 0) li_l[r32] = l_reg; asm volatile("s_waitcnt lgkmcnt(0)" ::: "memory");
  float rli[16];
#pragma unroll
  for (int r = 0; r < 16; ++r) rli[r] = __builtin_amdgcn_rcpf(li_l[crow(r, hi)]);
  const int hh = H & 7;
  bf16_t* Og = Od + (size_t)g * SEQ * 1024 + hh * 128;
#pragma unroll
  for (int r = 0; r < 16; ++r) { const size_t pos = (size_t)(qa + crow(r, hi)) * dil + rs;
#pragma unroll
    for (int d0 = 0; d0 < 4; ++d0) { const float ov = o[d0][r] * rli[r]; Og[pos * 1024 + d0 * 32 + r32] = (bf16_t)(cvtpk(ov, ov) & 0xffffu); } }
  if (hi == 0) lse[((size_t)g * SEQ + (size_t)qi * dil + rs) * 8 + hh] = m_reg + __builtin_amdgcn_logf(l_reg);
  __syncthreads();
}
#undef RESC
#undef KSWZ
#undef KPSWZ
#undef SBAR
}

#define LAS __attribute__((address_space(3)))
typedef unsigned short bf16;
typedef unsigned v4u __attribute__((ext_vector_type(4)));
typedef float f32x4 __attribute__((ext_vector_type(4)));
constexpr int NWAVES = 8;
constexpr size_t MiB = 1u << 20;
constexpr size_t WS_RSSQ = 0, WS_RSSKV = 32768, WS_STATS = 65536, WS_BIAS2 = 131072, WS_LSE = 262144;
constexpr size_t WS_ROPE = 2 * MiB;
constexpr size_t WS_WIN = 4 * MiB, WS_WQB = 178 * MiB, WS_WKVB = 184 * MiB, WS_WOMLA = 188 * MiB, WS_WODSWA = 204 * MiB, WS_WOUT = 212 * MiB;
constexpr size_t WS_H = 244 * MiB, WS_PROJ = 308 * MiB, WS_QMLA = 656 * MiB, WS_KVMLA = 704 * MiB, WS_KPE = 768 * MiB, WS_AMLA = 770 * MiB;
constexpr size_t WS_ODSWA = 802 * MiB, WS_BDSWA = 850 * MiB, WS_T = 866 * MiB, WS_K8 = 930 * MiB, WS_END = 962 * MiB;
static_assert(WS_WIN + (size_t)LDP * 4096 * 2 <= WS_WQB && WS_PROJ + (size_t)SEQ * LDP * 2 <= WS_QMLA && WS_LSE + 3 * SEQ * 8 * 4 <= WS_ROPE, "d_ws map");
constexpr int LDS_BYTES = 163840; constexpr int LDS_XB = 163840 - 64;
constexpr size_t WS_XBAR = 1 * MiB;

__device__ __forceinline__ unsigned f2bf(float f) { unsigned u = __builtin_bit_cast(unsigned, f); return (u + 0x7fffu + ((u >> 16) & 1u)) >> 16; }
__device__ __forceinline__ unsigned pk2(float lo, float hi) { return f2bf(lo) | (f2bf(hi) << 16); }
__device__ __forceinline__ float wave_sum(float v) {
#pragma unroll
    for (int o = 1; o < 64; o <<= 1) v += __shfl_xor(v, o);
    return v;
}
__device__ __forceinline__ void transpose_item(const float* __restrict__ W, int K, int N, bf16* __restrict__ WT, int k0, int n0, int dbase, int dstride, const float* __restrict__ kscale, LAS float* scr, int lane) {
    float wv[32];
#pragma unroll
    for (int i = 0; i < 32; ++i) { const int kk = 2 * i + (lane >> 5); wv[i] = __builtin_nontemporal_load(W + (size_t)(k0 + kk) * N + n0 + (lane & 31)); }
#pragma unroll
    for (int i = 0; i < 32; ++i) { const int kk = 2 * i + (lane >> 5); float w = wv[i]; if (kscale) w *= kscale[k0 + kk]; scr[kk * 33 + (lane & 31)] = w; }
    asm volatile("s_waitcnt lgkmcnt(0)" ::: "memory");
    const int c = lane & 7;
#pragma unroll
    for (int j = 0; j < 4; ++j) { const int n = (lane >> 3) + 8 * j; const LAS float* s = scr + (8 * c) * 33 + n;
        v4u o; o.x = pk2(s[0 * 33], s[1 * 33]); o.y = pk2(s[2 * 33], s[3 * 33]); o.z = pk2(s[4 * 33], s[5 * 33]); o.w = pk2(s[6 * 33], s[7 * 33]);
        *(v4u*)(WT + (size_t)(dbase + dstride * n) * K + k0 + 8 * c) = o; }
    asm volatile("s_waitcnt lgkmcnt(0)" ::: "memory");
}

#define XB_TMO      128
#define XB_XCNT(j)  (256  + 64 * (j))
#define XB_XSUB(j)  (1280 + 64 * (j))
#define XB_XGEN(j)  (2304 + 64 * (j))
#define XB_TOP      3328
#define XB_TOPGEN   3392
#define XCD_BAR_WORDS 3456
#define XB_SPIN_CAP (1u << 18)

__device__ __forceinline__ unsigned xb_ld(unsigned* p)              { return __hip_atomic_load(p, __ATOMIC_RELAXED, __HIP_MEMORY_SCOPE_AGENT); }
__device__ __forceinline__ unsigned xb_add(unsigned* p, unsigned v) { return __hip_atomic_fetch_add(p, v, __ATOMIC_RELAXED, __HIP_MEMORY_SCOPE_AGENT); }
__device__ __forceinline__ unsigned xb_xcc_id() { return (unsigned)__builtin_amdgcn_s_getreg((3 << 11) | 20) & 0xFu; }
#define XB_SPIN(cond, bar) do { unsigned _sp = 0; while (cond) { __builtin_amdgcn_s_sleep(1); \
    if ((++_sp & 255u) == 0u) { if (xb_ld(&(bar)[XB_TMO])) break; if (_sp > XB_SPIN_CAP) { atomicAdd(&(bar)[XB_TMO], 1u); break; } } } } while (0)

struct XcdBarrier {
    unsigned* bar; unsigned x;
    volatile LAS unsigned* st;
};

__device__ __forceinline__ XcdBarrier xcd_barrier_post(unsigned* bar, volatile LAS unsigned* st) {
    XcdBarrier b; b.bar = bar; b.x = xb_xcc_id(); b.st = st;
    if (threadIdx.x == 0) (void)xb_add(&bar[XB_XCNT(b.x)], 1u);
    return b;
}
__device__ __forceinline__ void xcd_barrier_complete(unsigned* bar, unsigned x, unsigned& nloc, unsigned& nx) {
    const unsigned G = gridDim.x * gridDim.y * gridDim.z;
    unsigned sum, cnt, mine, sp = 0u;
    for (;;) {
        sum = 0u; cnt = 0u; mine = 0u;
#pragma unroll
        for (unsigned j = 0; j < 16; ++j) { const unsigned c = xb_ld(&bar[XB_XCNT(j)]); sum += c; cnt += (c > 0u) ? 1u : 0u; mine = (j == x) ? c : mine; }
        if (sum == G) break;
        __builtin_amdgcn_s_sleep(1);
        if ((++sp & 255u) == 0u) { if (xb_ld(&bar[XB_TMO])) break; if (sp > XB_SPIN_CAP) { atomicAdd(&bar[XB_TMO], 1u); break; } }
    }
    nloc = mine > 0u ? mine : 1u; nx = cnt > 0u ? cnt : 1u;
}

__device__ __forceinline__ void xcd_barrier(const XcdBarrier& b) {
    asm volatile("s_waitcnt vmcnt(0)" ::: "memory");
    __syncthreads();
    if (threadIdx.x == 0) {
        unsigned* bar = b.bar;
        __builtin_amdgcn_s_waitcnt(0);
        unsigned nloc = b.st[0], nx = b.st[1];
        if (nloc == 0u) { xcd_barrier_complete(bar, b.x, nloc, nx); b.st[0] = nloc; b.st[1] = nx; }
        const unsigned old = xb_add(&bar[XB_XSUB(b.x)], 1u);
        const unsigned gen = old / nloc;
        if (old + 1u == (gen + 1u) * nloc) {
            __builtin_amdgcn_fence(__ATOMIC_RELEASE, "agent");
            asm volatile("s_waitcnt vmcnt(0)" ::: "memory");
            const unsigned og = xb_add(&bar[XB_TOP], 1u);
            const unsigned tg = og / nx;
            if (og + 1u == (tg + 1u) * nx) xb_add(&bar[XB_TOPGEN], 1u);
            else XB_SPIN(xb_ld(&bar[XB_TOPGEN]) == tg, bar);
            __builtin_amdgcn_fence(__ATOMIC_ACQUIRE, "agent");
            xb_add(&bar[XB_XGEN(b.x)], 1u);
            asm volatile("s_waitcnt vmcnt(0)" ::: "memory");
        } else {
            XB_SPIN(xb_ld(&bar[XB_XGEN(b.x)]) == gen, bar);
            __builtin_amdgcn_fence(__ATOMIC_ACQUIRE, "agent");
            asm volatile("s_waitcnt vmcnt(0)" ::: "memory");
        }
    }
    __syncthreads();
}

#define REP0 1
#define REP1 1
#define REP2 1
#define REP3 1
#define REP4 1
#define REP5 1
constexpr float H_SC = 16.f, W_SC = 1024.f;
__device__ __forceinline__ void transpose_item8(const float* __restrict__ W, int K, int N, unsigned char* __restrict__ WT, int k0, int n0, int dbase, int dstride, float wsc, LAS float* scr, int lane) {
    float wv[32];
#pragma unroll
    for (int i = 0; i < 32; ++i) { const int kk = 2 * i + (lane >> 5); wv[i] = __builtin_nontemporal_load(W + (size_t)(k0 + kk) * N + n0 + (lane & 31)); }
#pragma unroll
    for (int i = 0; i < 32; ++i) { const int kk = 2 * i + (lane >> 5); scr[kk * 33 + (lane & 31)] = wv[i] * wsc; }
    asm volatile("s_waitcnt lgkmcnt(0)" ::: "memory");
    const int c = lane & 7;
#pragma unroll
    for (int j = 0; j < 4; ++j) { const int n = (lane >> 3) + 8 * j; const LAS float* s = scr + (8 * c) * 33 + n;
        int d0 = __builtin_amdgcn_cvt_pk_fp8_f32(s[0 * 33], s[1 * 33], 0, false); d0 = __builtin_amdgcn_cvt_pk_fp8_f32(s[2 * 33], s[3 * 33], d0, true);
        int d1 = __builtin_amdgcn_cvt_pk_fp8_f32(s[4 * 33], s[5 * 33], 0, false); d1 = __builtin_amdgcn_cvt_pk_fp8_f32(s[6 * 33], s[7 * 33], d1, true);
        typedef int i32x2 __attribute__((ext_vector_type(2)));
        *(i32x2*)(WT + (size_t)(dbase + dstride * n) * K + k0 + 8 * c) = (i32x2){d0, d1}; }
    asm volatile("s_waitcnt lgkmcnt(0)" ::: "memory");
}
struct Args { const float* in[14]; float* out; unsigned char* ws; };

__global__ void __launch_bounds__(NWAVES * 64, 2) fwd_mega(Args a) {
    extern __shared__ __attribute__((aligned(16))) unsigned char lds[];
    cg::grid_group grid = cg::this_grid();
    const int G = gridDim.x, bx = blockIdx.x, vcu = (G % 8 == 0) ? (bx % 8) * (G / 8) + bx / 8 : bx;
    LAS unsigned char* ldsl = (LAS unsigned char*)lds;
    unsigned char* ws = a.ws;
    const float* x = a.in[0]; const float* emb_g = a.in[1]; const float* emb_b = a.in[2]; const float* rel_bias = a.in[3]; const float* w_in = a.in[4];
    const float* qa_g = a.in[5]; const float* w_qb = a.in[6]; const float* kva_g = a.in[7]; const float* w_kvb = a.in[8]; const float* w_omla = a.in[9];
    const float* w_odswa = a.in[10]; const float* w_out = a.in[11]; const float* ln_g = a.in[12]; const float* ln_b = a.in[13];
    float* rss_q = (float*)(ws + WS_RSSQ); float* rss_kv = (float*)(ws + WS_RSSKV); float* stats = (float*)(ws + WS_STATS); float* bias2 = (float*)(ws + WS_BIAS2);
    float* lse = (float*)(ws + WS_LSE); float* rope = (float*)(ws + WS_ROPE);
    bf16* Win_t = (bf16*)(ws + WS_WIN); bf16* Wqb_t = (bf16*)(ws + WS_WQB); bf16* Wkvb_t = (bf16*)(ws + WS_WKVB); bf16* Womla_t = (bf16*)(ws + WS_WOMLA);
    bf16* Wodswa_t = (bf16*)(ws + WS_WODSWA); bf16* Wout_t = (bf16*)(ws + WS_WOUT);
    bf16* Hb = (bf16*)(ws + WS_H); bf16* proj = (bf16*)(ws + WS_PROJ); bf16* Qmla = (bf16*)(ws + WS_QMLA); bf16* KVmla = (bf16*)(ws + WS_KVMLA); bf16* Kpe = (bf16*)(ws + WS_K8);
    bf16* Amla = (bf16*)(ws + WS_AMLA); bf16* Odswa = (bf16*)(ws + WS_ODSWA); bf16* Bdswa = (bf16*)(ws + WS_BDSWA); bf16* Tm = (bf16*)(ws + WS_T); unsigned char* T8 = ws + WS_H + 32 * MiB;
    const int NGW = G * NWAVES, NGT = G * NWAVES * 64;
    volatile LAS unsigned* xb_st = (volatile LAS unsigned*)(ldsl + LDS_XB);
    if (threadIdx.x < 2) xb_st[threadIdx.x] = 0u;
    __syncthreads();
    const XcdBarrier xbar = xcd_barrier_post((unsigned*)(ws + WS_XBAR), xb_st);
#define PHASE_IDS() const int tid = opaque_tid(), lane = tid & 63, wave = __builtin_amdgcn_readfirstlane(tid >> 6), gw = vcu * NWAVES + wave, gt = bx * (NWAVES * 64) + tid; (void)lane; (void)gw; (void)gt

    for (int rep = 0; rep < REP0; ++rep) {
        PHASE_IDS();
        LAS float* scr = (LAS float*)(ldsl + wave * 16384);
        constexpr int I_IN = 64 * 690, I_QB = 16 * 96, I_KVB = 8 * 128, I_OM = 32 * 128, I_OD = 16 * 128, I_OUT = 64 * 128;
        constexpr int NITEMS = I_IN + I_QB + I_KVB + I_OM + I_OD + I_OUT;
        for (int it = gw; it < NITEMS; it += NGW) {
            int r = it;
            if (r < I_IN) { const int kb = r / 690, nb = r % 690; int db, ds; if (nb < 48) { db = nb * 32; ds = 1; } else if (nb == 48) { db = C_KPE; ds = 2; } else if (nb == 49) { db = C_KPE + 1; ds = 2; } else { db = nb * 32 - 64; ds = 1; }
                transpose_item8(w_in, 4096, IN_W, (unsigned char*)Win_t, kb * 64, nb * 32, db, ds, W_SC, scr, lane); continue; } r -= I_IN;
            if (r < I_QB) { const int kb = r / 96, nb = r % 96, hq = nb / 6, bi = nb % 6; int db, ds; if (bi < 4) { db = hq * 192 + bi * 32; ds = 1; } else { db = hq * 192 + 128 + (bi - 4); ds = 2; }
                transpose_item(w_qb, 1024, 3072, Wqb_t, kb * 64, nb * 32, db, ds, qa_g, scr, lane); continue; } r -= I_QB;
            if (r < I_KVB) { const int kb = r / 128, nb = r % 128; transpose_item(w_kvb, 512, 4096, Wkvb_t, kb * 64, nb * 32, nb * 32, 1, kva_g, scr, lane); continue; } r -= I_KVB;
            if (r < I_OM) { const int kb = r / 128, nb = r % 128; transpose_item8(w_omla, 2048, 4096, (unsigned char*)Womla_t, kb * 64, nb * 32, nb * 32, 1, W_OM_SC, scr, lane); continue; } r -= I_OM;
            if (r < I_OD) { const int kb = r / 128, nb = r % 128; transpose_item8(w_odswa, 1024, 4096, (unsigned char*)Wodswa_t, kb * 64, nb * 32, nb * 32, 1, W_OD_SC, scr, lane); continue; } r -= I_OD;
            { const int kb = r / 128, nb = r % 128; transpose_item8(w_out, 4096, 4096, (unsigned char*)Wout_t, kb * 64, nb * 32, nb * 32, 1, W_OUT_SC, scr, lane); }
        }
        for (int m = gw; m < SEQ; m += NGW) {
            const f32x4* xr = (const f32x4*)(x + (size_t)m * DM) + lane;
            f32x4 v[16]; float s = 0.f;
#pragma unroll
            for (int j = 0; j < 16; ++j) { v[j] = xr[64 * j]; s += (v[j].x + v[j].y) + (v[j].z + v[j].w); }
            const float mean = wave_sum(s) * (1.f / DM); float s2 = 0.f;
#pragma unroll
            for (int j = 0; j < 16; ++j) { v[j] = v[j] - mean; s2 += (v[j].x * v[j].x + v[j].y * v[j].y) + (v[j].z * v[j].z + v[j].w * v[j].w); }
            const float rstd = 1.f / sqrtf(wave_sum(s2) * (1.f / DM) + LN_EPS);
            if (lane == 0) { stats[2 * m] = mean; stats[2 * m + 1] = rstd; }
            int* o4 = (int*)((unsigned char*)Hb + (size_t)m * DM) + lane;
#pragma unroll
            for (int j = 0; j < 16; ++j) { const f32x4 gv = ((const f32x4*)emb_g)[64 * j + lane], bv = ((const f32x4*)emb_b)[64 * j + lane]; const f32x4 y = (v[j] * rstd * gv + bv) * H_SC;
                int d = __builtin_amdgcn_cvt_pk_fp8_f32(y.x, y.y, 0, false); d = __builtin_amdgcn_cvt_pk_fp8_f32(y.z, y.w, d, true); o4[64 * j] = d; }
        }
        for (int e = gt; e < SEQ * 32; e += NGT) { const int pos = e >> 5, i = e & 31; const float invf = 1.0f / powf(10000.0f, (float)(2 * i) / 64.0f); const float ang = (float)pos * invf;
            double t = (double)ang * 0.15915494309189535; t -= __builtin_floor(t); const float tf = (float)t;
            rope[2 * e] = __builtin_amdgcn_cosf(tf); rope[2 * e + 1] = __builtin_amdgcn_sinf(tf); }
        for (int e = gt; e < 3 * 8 * 129; e += NGT) { const int j = e % 129 - 64, hh = (e / 129) % 8, g = e / (129 * 8), dil = 1 << (2 * g); const int rel = j * dil, n = rel < 0 ? -rel : rel;
            int bk; if (n < 8) bk = n; else { const float nf = (float)n; int lg = 8 + (int)(logf(nf / 8.f) / 4.852030263919617f * 8.f); bk = lg < 15 ? lg : 15; }
            if (rel > 0) bk += 16;
            bias2[e] = rel_bias[bk * 24 + g * 8 + hh] * LOG2E; }
        for (int e = gt; e < 2 * SEQ; e += NGT) rss_q[e] = 0.f;
    }
    grid.sync();

    for (int rep = 0; rep < REP1; ++rep) {
        pg8::Gemm g{Hb, Win_t, SEQ, LDP, 2048, 2048, 2048}; pg8::StaticOrder S; S.init(SEQ, LDP, G, bx);
        pg8::EpiProj E{proj, Kpe, rep ? nullptr : rss_q, rep ? nullptr : rss_kv, rope, 1.f / (H_SC * W_SC)};
        pg8::gemm_phase<pg8::EpiProj, pg8::StaticOrder, true, true, true>(ldsl, g, S, E);
    }
    xcd_barrier(xbar);

    for (int rep = 0; rep < REP2; ++rep) {
        { pg8::Gemm g{proj + C_QA, Wqb_t, SEQ, 3072, 1024, LDP, 1024}; pg8::StaticOrder S; S.init(SEQ, 3072, G, bx);
          pg8::EpiQ E{Qmla, rss_q, rope}; pg8::gemm_phase<pg8::EpiQ, pg8::StaticOrder, true, true>(ldsl, g, S, E); }
        { pg8::Gemm g{proj + C_CKV, Wkvb_t, SEQ, 4096, 512, LDP, 512}; pg8::StaticOrder S; S.init(SEQ, 4096, G, bx);
          pg8::EpiKV E{(unsigned char*)KVmla  , rss_kv, (unsigned char*)Kpe}; pg8::gemm_phase<pg8::EpiKV, pg8::StaticOrder, true, true>(ldsl, g, S, E); }
        __syncthreads();
        for (int u = vcu; u < 768; u += G) { const int H = u >> 5, rem = u & 31, g = H >> 3, nqb = 32 >> (2 * g); att::dswa_unit(H, rem / nqb, rem % nqb, proj, bias2, Odswa, lse, (char*)lds); }
    }
    xcd_barrier(xbar);

    for (int rep = 0; rep < REP3; ++rep) {
        for (int u = vcu; u < 512; u += G) { const int h = u >> 5, qb = u & 31; const size_t r0 = (size_t)qb * 256;
            att::mla_unit((const bf16*)((const unsigned char*)Qmla + r0 * 3072 + h * 192), (const bf16*)((const unsigned char*)Kpe + (size_t)h * SEQ * 256), (const bf16*)((const unsigned char*)KVmla + (size_t)h * 128 * SEQ), Kpe, proj + r0 * LDP + C_GMLA + h * 128, (bf16*)((unsigned char*)Amla + r0 * 2048 + h * 128), (char*)lds, ldsl); }
        PHASE_IDS();
        for (int it = gt; it < SEQ * 128; it += NGT) { const int pos = it >> 7, c8 = it & 127, hh = c8 >> 4, col = c8 * 8;
            const float l0 = lse[((size_t)0 * SEQ + pos) * 8 + hh], l1 = lse[((size_t)1 * SEQ + pos) * 8 + hh], l2 = lse[((size_t)2 * SEQ + pos) * 8 + hh];
            const float mx = fmaxf(l0, fmaxf(l1, l2)); float e0 = __builtin_amdgcn_exp2f(l0 - mx), e1 = __builtin_amdgcn_exp2f(l1 - mx), e2 = __builtin_amdgcn_exp2f(l2 - mx);
            const float inv = 1.f / (e0 + e1 + e2); e0 *= inv; e1 *= inv; e2 *= inv;
            const v4u a0 = *(const v4u*)(Odswa + ((size_t)0 * SEQ + pos) * 1024 + col), a1 = *(const v4u*)(Odswa + ((size_t)1 * SEQ + pos) * 1024 + col), a2 = *(const v4u*)(Odswa + ((size_t)2 * SEQ + pos) * 1024 + col);
            const v4u gg = *(const v4u*)(proj + (size_t)pos * LDP + C_GDSWA + col);
#define MLO(k) ((pg8::bflo(a0[k]) * e0 + pg8::bflo(a1[k]) * e1 + pg8::bflo(a2[k]) * e2) * pg8::bflo(gg[k]) * B_SC)
#define MHI(k) ((pg8::bfhi(a0[k]) * e0 + pg8::bfhi(a1[k]) * e1 + pg8::bfhi(a2[k]) * e2) * pg8::bfhi(gg[k]) * B_SC)
            *(pg8::i32x2*)((unsigned char*)Bdswa + (size_t)pos * 1024 + col) = (pg8::i32x2){pg8::cvt4_fp8(MLO(0), MHI(0), MLO(1), MHI(1)), pg8::cvt4_fp8(MLO(2), MHI(2), MLO(3), MHI(3))}; }
#undef MLO
#undef MHI
    }
    xcd_barrier(xbar);

    for (int rep = 0; rep < REP4; ++rep) {
        { pg8::Gemm g{Amla, Womla_t, SEQ, 4096, 1024, 1024, 1024}; pg8::StaticOrder S; S.init(SEQ, 4096, G, bx);
          pg8::EpiY<0> E{Tm, proj + C_RMLA, T8}; pg8::gemm_phase<pg8::EpiY<0>, pg8::StaticOrder, true, true, true>(ldsl, g, S, E); }
        { pg8::Gemm g{Bdswa, Wodswa_t, SEQ, 4096, 512, 512, 512}; pg8::StaticOrder S; S.init(SEQ, 4096, G, bx);
          pg8::EpiY<1> E{Tm, proj + C_RDSWA, T8}; pg8::gemm_phase<pg8::EpiY<1>, pg8::StaticOrder, true, true, true>(ldsl, g, S, E); }
    }
    xcd_barrier(xbar);

    for (int rep = 0; rep < REP5; ++rep) {
        pg8::Gemm g{(const bf16*)T8, Wout_t, SEQ, 4096, 2048, 2048, 2048}; pg8::StaticOrder S; S.init(SEQ, 4096, G, bx);
        pg8::EpiOut E{x, stats, emb_g, emb_b, a.out, 1.f / (T_SC * W_OUT_SC)}; pg8::gemm_phase<pg8::EpiOut, pg8::StaticOrder, true, true, true>(ldsl, g, S, E);
    }
    xcd_barrier(xbar);

    { PHASE_IDS();
    for (int m = gw; m < SEQ; m += NGW) {
        f32x4* xr = (f32x4*)(a.out + (size_t)m * DM) + lane;
        f32x4 v[16]; float s = 0.f;
#pragma unroll
        for (int j = 0; j < 16; ++j) { v[j] = xr[64 * j]; s += (v[j].x + v[j].y) + (v[j].z + v[j].w); }
        const float mean = wave_sum(s) * (1.f / DM); float s2 = 0.f;
#pragma unroll
        for (int j = 0; j < 16; ++j) { v[j] = v[j] - mean; s2 += (v[j].x * v[j].x + v[j].y * v[j].y) + (v[j].z * v[j].z + v[j].w * v[j].w); }
        const float rstd = 1.f / sqrtf(wave_sum(s2) * (1.f / DM) + LN_EPS);
#pragma unroll
        for (int j = 0; j < 16; ++j) { const f32x4 gv = ((const f32x4*)ln_g)[64 * j + lane], bv = ((const f32x4*)ln_b)[64 * j + lane]; xr[64 * j] = v[j] * rstd * gv + bv; }
    } }
}

extern "C" void kernel_launch(void* const* d_in, const int* in_sizes, int n_in, void* d_out, int out_size, void* d_ws, size_t ws_size, hipStream_t stream) {
    static int grid = 0;
    if (grid == 0) {
        if (n_in != 14 || in_sizes[0] != SEQ * DM || out_size != SEQ * DM || ws_size < WS_END) { fprintf(stderr, "kernel_launch: unexpected shapes (n_in %d, in0 %d, out %d, ws %zu < %zu)\n", n_in, n_in > 0 ? in_sizes[0] : -1, out_size, ws_size, (size_t)WS_END); grid = -1; return; }
        int dev = 0, cus = 0, per_cu = 0;
        if (hipGetDevice(&dev) != hipSuccess || hipDeviceGetAttribute(&cus, hipDeviceAttributeMultiprocessorCount, dev) != hipSuccess) { grid = -1; return; }
        if (hipFuncSetAttribute((const void*)fwd_mega, hipFuncAttributeMaxDynamicSharedMemorySize, LDS_BYTES) != hipSuccess) { fprintf(stderr, "kernel_launch: hipFuncSetAttribute failed\n"); grid = -1; return; }
        if (hipOccupancyMaxActiveBlocksPerMultiprocessor(&per_cu, (const void*)fwd_mega, NWAVES * 64, LDS_BYTES) != hipSuccess || per_cu < 1) { fprintf(stderr, "kernel_launch: occupancy query says %d blocks per CU\n", per_cu); per_cu = 1; }
        (void)hipGetLastError();
        grid = cus;
    }
    if (grid < 0) return;
    Args a{};
    for (int i = 0; i < 14; ++i) a.in[i] = (const float*)d_in[i];
    a.out = (float*)d_out; a.ws = (unsigned char*)d_ws;
    if (hipMemsetAsync((char*)d_ws + WS_XBAR, 0, 16384, stream) != hipSuccess) { fprintf(stderr, "kernel_launch: hipMemsetAsync of the barrier words failed\n"); return; }
    void* args[] = {&a};
    hipError_t e = hipLaunchCooperativeKernel((const void*)fwd_mega, dim3(grid), dim3(NWAVES * 64), args, LDS_BYTES, stream);
    if (e != hipSuccess) fprintf(stderr, "kernel_launch: cooperative launch failed: %s (grid %d)\n", hipGetErrorString(e), grid);
}
```

```cpp
#include <hip/hip_runtime.h>
#include <hip/hip_cooperative_groups.h>
#include <cstdio>
#include <cstdint>
#include <cmath>
namespace cg = cooperative_groups;

constexpr int SEQ = 8192, DM = 4096;
constexpr int LDP = 22272;
constexpr int C_QA = 0, C_CKV = 1024, C_DQ = 1536, C_DK = 4608, C_DV = 7680, C_GMLA = 10752, C_GDSWA = 12800, C_RMLA = 13824, C_RDSWA = 17920, C_KPE = 22016;
constexpr int IN_W = 22080;
constexpr float LOG2E = 1.4426950408889634f;
constexpr float QS_D = 0.08838834764831845f * LOG2E;
constexpr float QS_M = 0.07216878364870323f * LOG2E;
constexpr float ALPHA = 1.189207115002721f;
constexpr float LN_EPS = 1e-5f, RMS_EPS = 1e-6f;
constexpr float H_SC = 16.f, W_SC = 1024.f;
constexpr float QA_SC = 16.f, WQ_SC = 512.f, WKV_SC = 512.f;
constexpr float Q8_SC = 64.f, K8_SC = 16.f, V8_SC = 64.f;
constexpr float A_SC = 256.f, B_SC = 128.f, T_SC = 512.f, W_OM_SC = 1024.f, W_OD_SC = 1024.f, W_OUT_SC = 2048.f;

__device__ __forceinline__ int opaque_tid() { int t = threadIdx.x; asm volatile("" : "+v"(t)); return t; }

namespace pg8 {
#define PG8_LAS __attribute__((address_space(3)))
typedef unsigned short bf16_t;
typedef short bf16x8 __attribute__((ext_vector_type(8)));
typedef float f32x4 __attribute__((ext_vector_type(4)));
typedef unsigned u32x4 __attribute__((ext_vector_type(4)));
constexpr int BM = 256, BK = 64, HALF = 128, HTB = HALF * BK * 2  , STAGE_BYTES = 8 * HTB, NXCD = 8, WGM = 8;

__host__ __device__ __forceinline__ int lds_byte(int r, int c) { const int st = (r >> 4) * 2 + (c >> 5), rr = r & 15, cc = c & 31, ob = rr * 64 + cc * 2; return st * 1024 + (ob ^ (((ob >> 9) & 1) << 5)); }
__host__ __device__ __forceinline__ void stage_rc(int b, int& R, int& C) { const int st = b / 1024, sb = b % 1024, swz = sb ^ (((sb >> 9) & 1) << 5); R = (st >> 1) * 16 + swz / 64; C = (st & 1) * 32 + (swz % 64) / 2; }
__host__ __device__ __forceinline__ int perm32(int rho) { const int n = rho >> 4, i = rho & 15; return 8 * (i >> 2) + 4 * n + (i & 3); }

struct Unit { int pm, pn; };
struct Gemm { const bf16_t* A; const bf16_t* Bt; int M, N, K, lda, ldb; };

struct StaticOrder {
    int nM, nN, nwg, G, c;
    __host__ __device__ void init(int M, int N, int G_, int c_) { nM = M / BM; nN = N / BM; nwg = nM * nN; G = G_; c = c_; }
    __host__ __device__ bool next(int i, Unit& u) const {
        const long L = (long)i * G + c; if (L >= nwg) return false;
        int wgid = (int)L; { const int q = nwg / NXCD, r = nwg % NXCD, xcd = wgid % NXCD, off = wgid / NXCD; wgid = (xcd < r ? xcd * (q + 1) : r * (q + 1) + (xcd - r) * q) + off; }
        const int nig = WGM * nN, gid = wgid / nig, fm = gid * WGM, gsz = (nM - fm) < WGM ? (nM - fm) : WGM;
        u.pm = fm + ((wgid % nig) % gsz); u.pn = (wgid % nig) / gsz; return true;
    }
    __device__ __forceinline__ void a_ready(const Unit&) const {}
    __device__ __forceinline__ void done(const Unit&) const {}
};


typedef float f32x2 __attribute__((ext_vector_type(2))); typedef __bf16 bf16x2_t __attribute__((ext_vector_type(2)));
typedef int i32x4 __attribute__((ext_vector_type(4))); typedef int i32x8 __attribute__((ext_vector_type(8)));
__device__ __forceinline__ i32x8 cat8(bf16x8 a, bf16x8 b) { return __builtin_shufflevector(__builtin_bit_cast(i32x4, a), __builtin_bit_cast(i32x4, b), 0, 1, 2, 3, 4, 5, 6, 7); }
__device__ __forceinline__ unsigned cvt_pk_bf16(float lo, float hi) { f32x2 v = {lo, hi}; bf16x2_t b = __builtin_convertvector(v, bf16x2_t); return __builtin_bit_cast(unsigned, b); }
typedef int i32x2 __attribute__((ext_vector_type(2)));
__device__ __forceinline__ int cvt4_fp8(float a, float b, float c, float d) { a = __builtin_amdgcn_fmed3f(a, -440.f, 440.f); b = __builtin_amdgcn_fmed3f(b, -440.f, 440.f); c = __builtin_amdgcn_fmed3f(c, -440.f, 440.f); d = __builtin_amdgcn_fmed3f(d, -440.f, 440.f);
    int r = __builtin_amdgcn_cvt_pk_fp8_f32(a, b, 0, false); return __builtin_amdgcn_cvt_pk_fp8_f32(c, d, r, true); }
__device__ __forceinline__ float bflo(unsigned w) { return __uint_as_float(w << 16); }
__device__ __forceinline__ float bfhi(unsigned w) { return __uint_as_float(w & 0xffff0000u); }
__device__ __forceinline__ float sigm(float x) { return __builtin_amdgcn_rcpf(1.f + __builtin_amdgcn_exp2f(-x * 1.4426950408889634f)); }
__device__ __forceinline__ u32x4 pack8(const f32x4 v0, const f32x4 v1) { u32x4 w; w.x = cvt_pk_bf16(v0[0], v0[1]); w.y = cvt_pk_bf16(v0[2], v0[3]); w.z = cvt_pk_bf16(v1[0], v1[1]); w.w = cvt_pk_bf16(v1[2], v1[3]); return w; }
__device__ __forceinline__ void rope8(f32x4& v0, f32x4& v1, const f32x4 cs0, const f32x4 cs1) {
    const float a0 = v0[0] * cs0[0] - v0[1] * cs0[1], b0 = v0[1] * cs0[0] + v0[0] * cs0[1];
    const float a1 = v0[2] * cs0[2] - v0[3] * cs0[3], b1 = v0[3] * cs0[2] + v0[2] * cs0[3];
    const float a2 = v1[0] * cs1[0] - v1[1] * cs1[1], b2 = v1[1] * cs1[0] + v1[0] * cs1[1];
    const float a3 = v1[2] * cs1[2] - v1[3] * cs1[3], b3 = v1[3] * cs1[2] + v1[2] * cs1[3];
    v0 = (f32x4){a0, b0, a1, b1}; v1 = (f32x4){a2, b2, a3, b3};
}

struct EpiProj {
    static constexpr bool PERM = true, AFTER_DRAIN = false;
    bf16_t* proj; bf16_t* kpe; float* rss_q; float* rss_kv; const float* rope; unsigned char* qa8; static constexpr float osc = 1.f / (H_SC * W_SC);
    template <int ACT> __device__ __forceinline__ void body(const f32x4 (&acc)[2][2][4][2], const Unit& u, int wr, int wc, int fr, int fq, float sc, float* rss) const {
        const int row0 = u.pm * BM + wr * 64 + fr, col0 = u.pn * BM + wc * 32 + 8 * fq;
#pragma unroll
        for (int ai = 0; ai < 2; ++ai)
#pragma unroll
            for (int m = 0; m < 4; ++m) { const int row = row0 + ai * HALF + m * 16; bf16_t* rowp = proj + (size_t)row * LDP + col0; float ss = 0.f;
#pragma unroll
                for (int bj = 0; bj < 2; ++bj) { f32x4 v0 = acc[ai][bj][m][0] * sc, v1 = acc[ai][bj][m][1] * sc;
                    if (ACT == 1) {
#pragma unroll
                        for (int e = 0; e < 4; ++e) { v0[e] = v0[e] * sigm(v0[e]); v1[e] = v1[e] * sigm(v1[e]); } }
                    if (ACT == 2) {
#pragma unroll
                        for (int e = 0; e < 4; ++e) { v0[e] = sigm(v0[e]); v1[e] = sigm(v1[e]); } }
                    if (ACT == 3) { ss += (v0[0] * v0[0] + v0[1] * v0[1]) + (v0[2] * v0[2] + v0[3] * v0[3]) + (v1[0] * v1[0] + v1[1] * v1[1]) + (v1[2] * v1[2] + v1[3] * v1[3]); }
                    if (ACT == 3) { const f32x4 a0 = v0 * QA_SC, a1 = v1 * QA_SC; *(i32x2*)(qa8 + (size_t)row * 1536 + col0 + bj * HALF) = (i32x2){cvt4_fp8(a0[0], a0[1], a0[2], a0[3]), cvt4_fp8(a1[0], a1[1], a1[2], a1[3])}; }
                    else *(u32x4*)(rowp + bj * HALF) = pack8(v0, v1); }
                if (ACT == 3) { ss += __shfl_xor(ss, 16); ss += __shfl_xor(ss, 32); if (fq == 0 && rss) atomicAdd(rss + row, ss); } }
    }
    __device__ __forceinline__ void operator()(const f32x4 (&acc)[2][2][4][2], const Unit& u, int wr, int wc, int fr, int fq) const {
        const int pn = u.pn;
        if (pn < 4) body<3>(acc, u, wr, wc, fr, fq, osc, rss_q);
        else if (pn < 6) body<3>(acc, u, wr, wc, fr, fq, osc, rss_kv);
        else if (pn < 42) body<0>(acc, u, wr, wc, fr, fq, pn < 18 ? QS_D * osc : osc, nullptr);
        else if (pn < 54) body<1>(acc, u, wr, wc, fr, fq, osc, nullptr);
        else if (pn < 86) body<2>(acc, u, wr, wc, fr, fq, osc, nullptr);
        else if (wc < 2) {
            const int row0 = u.pm * BM + wr * 64 + fr, c0 = wc * 32 + 8 * fq;
#pragma unroll
            for (int ai = 0; ai < 2; ++ai)
#pragma unroll
                for (int m = 0; m < 4; ++m) { const int row = row0 + ai * HALF + m * 16; f32x4 v0 = acc[ai][0][m][0] * osc, v1 = acc[ai][0][m][1] * osc;
                    const f32x4* cs = (const f32x4*)(rope + (size_t)row * 64 + c0); rope8(v0, v1, cs[0], cs[1]);
                    v0 = v0 * K8_SC; v1 = v1 * K8_SC; const i32x2 w8 = {cvt4_fp8(v0[0], v0[1], v0[2], v0[3]), cvt4_fp8(v1[0], v1[1], v1[2], v1[3])};
#pragma unroll
                    for (int hh = 0; hh < 16; ++hh) *(i32x2*)((unsigned char*)kpe + ((size_t)hh * SEQ + row) * 256 + 128 + c0) = w8; }
        }
    }
};
struct EpiQ {
    static constexpr bool PERM = true, AFTER_DRAIN = false;
    bf16_t* q; const float* rss; const float* rope;
    __device__ __forceinline__ void operator()(const f32x4 (&acc)[2][2][4][2], const Unit& u, int wr, int wc, int fr, int fq) const {
        const int row0 = u.pm * BM + wr * 64 + fr, col0 = u.pn * BM + wc * 32 + 8 * fq;
        const int cw0 = col0 % 192, cw1 = (col0 + HALF) % 192;
#pragma unroll
        for (int ai = 0; ai < 2; ++ai)
#pragma unroll
            for (int m = 0; m < 4; ++m) { const int row = row0 + ai * HALF + m * 16; const float sc = (QS_M / (QA_SC * WQ_SC)) / sqrtf(rss[row] * (1.f / 1024.f) + RMS_EPS);
#pragma unroll
                for (int bj = 0; bj < 2; ++bj) { f32x4 v0 = acc[ai][bj][m][0] * sc, v1 = acc[ai][bj][m][1] * sc; const int cw = bj ? cw1 : cw0;
                    if (cw >= 128) { const f32x4* cs = (const f32x4*)(rope + (size_t)row * 64 + (cw - 128)); rope8(v0, v1, cs[0], cs[1]); }
                    v0 = v0 * Q8_SC; v1 = v1 * Q8_SC; *(i32x2*)((unsigned char*)q + (size_t)row * 3072 + col0 + bj * HALF) = (i32x2){cvt4_fp8(v0[0], v0[1], v0[2], v0[3]), cvt4_fp8(v1[0], v1[1], v1[2], v1[3])}; } }
    }
};
struct EpiKV {
    static constexpr bool PERM = true, AFTER_DRAIN = false;
    unsigned char* vt8; const float* rss; unsigned char* k8;
    __device__ __forceinline__ void operator()(const f32x4 (&acc)[2][2][4][2], const Unit& u, int wr, int wc, int fr, int fq) const {
        const int row0 = u.pm * BM + wr * 64 + fr, dl = wc * 32 + 8 * fq;
#pragma unroll
        for (int ai = 0; ai < 2; ++ai)
#pragma unroll
            for (int m = 0; m < 4; ++m) { const int row = row0 + ai * HALF + m * 16; const float sc = (1.f / (QA_SC * WKV_SC)) / sqrtf(rss[row] * (1.f / 512.f) + RMS_EPS);
                { const f32x4 k0v = acc[ai][0][m][0] * (sc * K8_SC), k1v = acc[ai][0][m][1] * (sc * K8_SC);
                  *(i32x2*)(k8 + ((size_t)u.pn * SEQ + row) * 256 + dl) = (i32x2){cvt4_fp8(k0v[0], k0v[1], k0v[2], k0v[3]), cvt4_fp8(k1v[0], k1v[1], k1v[2], k1v[3])}; }
                const f32x4 v0 = acc[ai][1][m][0] * (sc * V8_SC), v1 = acc[ai][1][m][1] * (sc * V8_SC);
                const unsigned w0 = (unsigned)cvt4_fp8(v0[0], v0[1], v0[2], v0[3]), w1 = (unsigned)cvt4_fp8(v1[0], v1[1], v1[2], v1[3]);
                const int kt = m * 16 + fr, kk = kt & 31, pi = ((kk >> 2) & 1) * 32 + (kk & 3) + 4 * (kk >> 3) + 16 * (kt >> 5);
                unsigned char* vp = vt8 + ((size_t)u.pn * 128 + dl) * SEQ + (row & ~63) + pi;
#pragma unroll
                for (int e2 = 0; e2 < 4; ++e2) { vp[(size_t)e2 * SEQ] = (unsigned char)(w0 >> (8 * e2)); vp[(size_t)(4 + e2) * SEQ] = (unsigned char)(w1 >> (8 * e2)); } }
    }
};
template <int PASS> struct EpiY {
    static constexpr bool PERM = true, AFTER_DRAIN = false;
    bf16_t* T; const bf16_t* gate; unsigned char* T8;
    __device__ __forceinline__ void operator()(const f32x4 (&acc)[2][2][4][2], const Unit& u, int wr, int wc, int fr, int fq) const {
        const int row0 = u.pm * BM + wr * 64 + fr, col0 = u.pn * BM + wc * 32 + 8 * fq;
        constexpr float osc = PASS == 0 ? 1.f / (A_SC * W_OM_SC) : 1.f / (B_SC * W_OD_SC), tsc = T_SC;
#pragma unroll
        for (int ai = 0; ai < 2; ++ai)
#pragma unroll
            for (int m = 0; m < 4; ++m) { const int row = row0 + ai * HALF + m * 16;
#pragma unroll
                for (int bj = 0; bj < 2; ++bj) { const u32x4 gw = *(const u32x4*)(gate + (size_t)row * LDP + col0 + bj * HALF); bf16_t* tp = T + (size_t)row * 4096 + col0 + bj * HALF;
                    f32x4 v0 = acc[ai][bj][m][0] * osc, v1 = acc[ai][bj][m][1] * osc;
                    v0 = v0 * (f32x4){bflo(gw.x), bfhi(gw.x), bflo(gw.y), bfhi(gw.y)}; v1 = v1 * (f32x4){bflo(gw.z), bfhi(gw.z), bflo(gw.w), bfhi(gw.w)};
                    if (PASS == 0) { *(u32x4*)tp = pack8(v0, v1); }
                    else { const u32x4 tw = *(const u32x4*)tp; v0 = (v0 + (f32x4){bflo(tw.x), bfhi(tw.x), bflo(tw.y), bfhi(tw.y)}) * tsc; v1 = (v1 + (f32x4){bflo(tw.z), bfhi(tw.z), bflo(tw.w), bfhi(tw.w)}) * tsc;
                        *(i32x2*)(T8 + (size_t)row * 4096 + col0 + bj * HALF) = (i32x2){cvt4_fp8(v0[0], v0[1], v0[2], v0[3]), cvt4_fp8(v1[0], v1[1], v1[2], v1[3])}; } } }
    }
};
struct EpiOut {
    static constexpr bool PERM = false, AFTER_DRAIN = false;
    const float* x; const float* stats; const float* g; const float* b; float* out; float osc;
    __device__ __forceinline__ void operator()(const f32x4 (&acc)[2][2][4][2], const Unit& u, int wr, int wc, int fr, int fq) const {
        const int row0 = u.pm * BM + wr * 64 + fr, col0 = u.pn * BM + wc * 32 + 4 * fq;
#pragma unroll
        for (int bj = 0; bj < 2; ++bj)
#pragma unroll
            for (int n = 0; n < 2; ++n) { const int col = col0 + bj * HALF + n * 16; const f32x4 gv = *(const f32x4*)(g + col) * ALPHA, bv = *(const f32x4*)(b + col) * ALPHA;
#pragma unroll
                for (int ai = 0; ai < 2; ++ai)
#pragma unroll
                    for (int m = 0; m < 4; ++m) { const int row = row0 + ai * HALF + m * 16; const f32x2 st = *(const f32x2*)(stats + 2 * row);
                        const size_t off = (size_t)row * 4096 + col; const f32x4 xv = *(const f32x4*)(x + off);
                        *(f32x4*)(out + off) = ((xv - st.x) * st.y) * gv + bv + acc[ai][bj][m][n] * osc; } }
    }
};

template <class Epi, class Sched, bool ALIGN_EPI = false, bool SP2 = false, bool FP8 = false>
__device__ __forceinline__ void gemm_phase(PG8_LAS unsigned char* lds, const Gemm g, const Sched S, const Epi E) {
    const int tid = opaque_tid(), wid = __builtin_amdgcn_readfirstlane(tid >> 6), lane = tid & 63, wr = wid >> 2, wc = wid & 3, fr = lane & 15, fq = lane >> 4;
    const int K = g.K, nt = K / BK;
    unsigned voffA[2], voffB[2];
#pragma unroll
    for (int i = 0; i < 2; ++i) { int R, C; stage_rc(tid * 16 + i * 8192, R, C); const int Rb = Epi::PERM ? ((R & ~31) + perm32(R & 31)) : R;
        voffA[i] = (unsigned)(R * g.lda + C) * 2u; voffB[i] = (unsigned)(Rb * g.ldb + C) * 2u; }
    const size_t kstep = (size_t)(BK * 2);
    const size_t hstepA = (size_t)HALF * g.lda * 2, hstepB = (size_t)HALF * g.ldb * 2;
    const size_t tstepA = 2 * hstepA, tstepB = 2 * hstepB;
    const unsigned ldsw = (unsigned)wid * 1024u;
    const int aoff = lds_byte(wr * 64 + fr, fq * 8), boff = lds_byte(wc * 32 + fr, fq * 8);
#define PG8_SA(b, h) (((b) * 2 + (h)) * HTB)
#define PG8_SB(b, h) ((4 + (b) * 2 + (h)) * HTB)
#define PG8_STAGE(bufoff, gbase, voff) do { _Pragma("unroll") for (int _i = 0; _i < 2; ++_i) \
        __builtin_amdgcn_global_load_lds((const unsigned*)((const char*)(gbase) + (voff)[_i]), (PG8_LAS unsigned*)(lds + (bufoff) + ldsw + _i * 8192), 16, 0, 0); } while (0)
#define PG8_LDA(dst, b, h) do { if constexpr (FP8) { _Pragma("unroll") for (int m = 0; m < 4; ++m) dst##8[m] = cat8(*(const PG8_LAS bf16x8*)(lds + PG8_SA(b, h) + aoff + m * 2048), *(const PG8_LAS bf16x8*)(lds + PG8_SA(b, h) + aoff + m * 2048 + 1024)); } \
    else { _Pragma("unroll") for (int m = 0; m < 4; ++m) _Pragma("unroll") for (int k = 0; k < 2; ++k) dst[m][k] = *(const PG8_LAS bf16x8*)(lds + PG8_SA(b, h) + aoff + m * 2048 + k * 1024); } } while (0)
#define PG8_LDB(dst, b, h) do { if constexpr (FP8) { _Pragma("unroll") for (int n = 0; n < 2; ++n) dst##8[n] = cat8(*(const PG8_LAS bf16x8*)(lds + PG8_SB(b, h) + boff + n * 2048), *(const PG8_LAS bf16x8*)(lds + PG8_SB(b, h) + boff + n * 2048 + 1024)); } \
    else { _Pragma("unroll") for (int n = 0; n < 2; ++n) _Pragma("unroll") for (int k = 0; k < 2; ++k) dst[n][k] = *(const PG8_LAS bf16x8*)(lds + PG8_SB(b, h) + boff + n * 2048 + k * 1024); } } while (0)
#define PG8_MMA(ai, bj, At, Bt) do { __builtin_amdgcn_s_setprio(1); if constexpr (FP8) { _Pragma("unroll") for (int m = 0; m < 4; ++m) _Pragma("unroll") for (int n = 0; n < 2; ++n) \
        asm volatile("v_mfma_f32_16x16x128_f8f6f4 %0, %1, %2, %0" : "+v"(acc[ai][bj][m][n]) : "v"(Bt##8[n]), "v"(At##8[m])); } else { \
        _Pragma("unroll") for (int m = 0; m < 4; ++m) _Pragma("unroll") for (int n = 0; n < 2; ++n) _Pragma("unroll") for (int k = 0; k < 2; ++k) \
        acc[ai][bj][m][n] = __builtin_amdgcn_mfma_f32_16x16x32_bf16(Bt[n][k], At[m][k], acc[ai][bj][m][n], 0, 0, 0); } __builtin_amdgcn_s_setprio(0); } while (0)
#define PG8_WAIT_V(n) asm volatile("s_waitcnt vmcnt(" #n ")" ::: "memory")
#define PG8_WAIT_L(n) asm volatile("s_waitcnt lgkmcnt(" #n ")" ::: "memory")
#define PG8_BAR __builtin_amdgcn_s_barrier()
#define PG8_SCHED __builtin_amdgcn_sched_barrier(0)
    Unit cur, nxt; int ui = 0;
    if (!S.next(0, cur)) return;
    f32x4 acc[2][2][4][2];
#pragma unroll
    for (int a = 0; a < 2; ++a)
#pragma unroll
        for (int b = 0; b < 2; ++b)
#pragma unroll
            for (int m = 0; m < 4; ++m)
#pragma unroll
                for (int n = 0; n < 2; ++n) acc[a][b][m][n] = (f32x4){0.f, 0.f, 0.f, 0.f};
    bf16x8 At[4][2], B0[2][2], B1[2][2]; i32x8 At8[4], B08[2], B18[2];
    const char* cA = (const char*)g.A + (size_t)cur.pm * tstepA; const char* cB = (const char*)g.Bt + (size_t)cur.pn * tstepB;
    S.a_ready(cur);
    if constexpr (SP2) {
        PG8_STAGE(PG8_SB(0, 0), cB, voffB); PG8_STAGE(PG8_SB(0, 1), cB + hstepB, voffB); PG8_STAGE(PG8_SA(0, 0), cA, voffA); PG8_STAGE(PG8_SA(0, 1), cA + hstepA, voffA);
        if (wr == 1) PG8_BAR;
        PG8_WAIT_V(2); PG8_BAR;
        PG8_STAGE(PG8_SB(1, 0), cB + kstep, voffB); PG8_STAGE(PG8_SA(1, 0), cA + kstep, voffA); PG8_STAGE(PG8_SB(1, 1), cB + hstepB + kstep, voffB);
        PG8_WAIT_V(6); PG8_BAR;
    } else {
        PG8_STAGE(PG8_SB(0, 0), cB, voffB); PG8_STAGE(PG8_SA(0, 0), cA, voffA); PG8_STAGE(PG8_SB(0, 1), cB + hstepB, voffB); PG8_STAGE(PG8_SA(0, 1), cA + hstepA, voffA);
        if (wr == 1) PG8_BAR;
        PG8_WAIT_V(4); PG8_BAR;
        PG8_STAGE(PG8_SB(1, 0), cB + kstep, voffB); PG8_STAGE(PG8_SA(1, 0), cA + kstep, voffA); PG8_STAGE(PG8_SB(1, 1), cB + hstepB + kstep, voffB);
        PG8_WAIT_V(6); PG8_BAR;
    }
    for (;;) {
        const bool has_next = S.next(ui + 1, nxt);
        const char* nA = has_next ? (const char*)g.A + (size_t)nxt.pm * tstepA : cA; const char* nB = has_next ? (const char*)g.Bt + (size_t)nxt.pn * tstepB : cB;
        for (int t = 0; t < nt; t += 2) {
            const bool last = (t == nt - 2);
            const char* a1 = cA + (size_t)(t + 1) * kstep;
            const char* a2 = last ? nA : cA + (size_t)(t + 2) * kstep; const char* b2 = last ? nB : cB + (size_t)(t + 2) * kstep;
            const char* a3 = a2 + kstep; const char* b3 = b2 + kstep;
            if (last && has_next) S.a_ready(nxt);
            if constexpr (SP2) {
            PG8_LDB(B0, 0, 0); PG8_LDB(B1, 0, 1); PG8_SCHED; PG8_LDA(At, 0, 0); PG8_STAGE(PG8_SA(1, 1), a1 + hstepA, voffA);
            PG8_WAIT_V(8); PG8_WAIT_L(0); PG8_BAR; PG8_MMA(0, 0, At, B0); PG8_MMA(0, 1, At, B1); PG8_BAR; PG8_SCHED;
            PG8_LDA(At, 0, 1); PG8_STAGE(PG8_SB(0, 0), b2, voffB); PG8_STAGE(PG8_SB(0, 1), b2 + hstepB, voffB); PG8_STAGE(PG8_SA(0, 0), a2, voffA);
            PG8_WAIT_V(8); PG8_WAIT_L(0); PG8_BAR; PG8_MMA(1, 0, At, B0); PG8_MMA(1, 1, At, B1); PG8_BAR; PG8_SCHED;
            PG8_LDB(B0, 1, 0); PG8_LDB(B1, 1, 1); PG8_SCHED; PG8_LDA(At, 1, 0); PG8_STAGE(PG8_SA(0, 1), a2 + hstepA, voffA);
            PG8_WAIT_V(8); PG8_WAIT_L(0); PG8_BAR; PG8_MMA(0, 0, At, B0); PG8_MMA(0, 1, At, B1); PG8_BAR; PG8_SCHED;
            PG8_LDA(At, 1, 1); PG8_STAGE(PG8_SB(1, 0), b3, voffB); PG8_STAGE(PG8_SB(1, 1), b3 + hstepB, voffB); PG8_STAGE(PG8_SA(1, 0), a3, voffA);
            PG8_WAIT_V(8); PG8_WAIT_L(0); PG8_BAR; PG8_MMA(1, 0, At, B0); PG8_MMA(1, 1, At, B1); PG8_BAR; PG8_SCHED;
            } else {
            PG8_LDB(B0, 0, 0); PG8_SCHED; PG8_LDA(At, 0, 0); PG8_STAGE(PG8_SA(1, 1), a1 + hstepA, voffA);
            PG8_WAIT_L(8); PG8_BAR; PG8_WAIT_L(0); PG8_MMA(0, 0, At, B0); PG8_BAR; PG8_SCHED;
            PG8_LDB(B1, 0, 1); PG8_STAGE(PG8_SB(0, 0), b2, voffB);
            PG8_BAR; PG8_WAIT_L(0); PG8_MMA(0, 1, At, B1); PG8_BAR;
            PG8_LDA(At, 0, 1); PG8_STAGE(PG8_SA(0, 0), a2, voffA);
            PG8_BAR; PG8_WAIT_L(0); PG8_MMA(1, 0, At, B0); PG8_BAR; PG8_SCHED;
            PG8_STAGE(PG8_SB(0, 1), b2 + hstepB, voffB);
            PG8_WAIT_V(6); PG8_BAR; PG8_MMA(1, 1, At, B1); PG8_BAR;
            PG8_LDB(B0, 1, 0); PG8_SCHED; PG8_LDA(At, 1, 0); PG8_STAGE(PG8_SA(0, 1), a2 + hstepA, voffA);
            PG8_WAIT_L(8); PG8_BAR; PG8_WAIT_L(0); PG8_MMA(0, 0, At, B0); PG8_BAR; PG8_SCHED;
            PG8_LDB(B1, 1, 1); PG8_STAGE(PG8_SB(1, 0), b3, voffB);
            PG8_BAR; PG8_WAIT_L(0); PG8_MMA(0, 1, At, B1); PG8_BAR;
            PG8_LDA(At, 1, 1); PG8_STAGE(PG8_SA(1, 0), a3, voffA);
            PG8_BAR; PG8_WAIT_L(0); PG8_MMA(1, 0, At, B0); PG8_BAR; PG8_SCHED;
            PG8_STAGE(PG8_SB(1, 1), b3 + hstepB, voffB);
            PG8_WAIT_V(6); PG8_BAR; PG8_MMA(1, 1, At, B1); PG8_BAR;
            }
        }
        if constexpr (ALIGN_EPI) { if (wr == 0) PG8_BAR; }
        if constexpr (FP8) asm volatile("s_nop 15\n\ts_nop 15" ::: "memory");
        if constexpr (!Epi::AFTER_DRAIN) { E(acc, cur, wr, wc, fr, fq); S.done(cur); }
        if (!has_next) break;
#pragma unroll
        for (int a = 0; a < 2; ++a)
#pragma unroll
            for (int b = 0; b < 2; ++b)
#pragma unroll
                for (int m = 0; m < 4; ++m)
#pragma unroll
                    for (int n = 0; n < 2; ++n) acc[a][b][m][n] = (f32x4){0.f, 0.f, 0.f, 0.f};
        cur = nxt; cA = nA; cB = nB; ++ui;
        if constexpr (ALIGN_EPI) { if (wr == 1) PG8_BAR; }
    }
    PG8_WAIT_V(0);
    if constexpr (!ALIGN_EPI) { if (wr == 0) PG8_BAR; }
    PG8_BAR;
    if constexpr (Epi::AFTER_DRAIN) { E.fused(acc, cur, wr, wc, fr, fq, lds, wid, lane); S.done(cur); }
#undef PG8_SA
#undef PG8_SB
#undef PG8_STAGE
#undef PG8_LDA
#undef PG8_LDB
#undef PG8_MMA
#undef PG8_WAIT_V
#undef PG8_WAIT_L
#undef PG8_BAR
#undef PG8_SCHED
}
}

namespace att {
typedef unsigned short bf16_t;
using bf16x8 = __attribute__((ext_vector_type(8))) short;
using s16x4  = __attribute__((ext_vector_type(4))) short;
using f32x16 = __attribute__((ext_vector_type(16))) float;
using u32x4  = __attribute__((ext_vector_type(4))) unsigned;
constexpr int NW = 8, QBLK = 32, KVBLK = 64;
constexpr int SHM_V = 16384, SHM_KN = 16384, SHM_KP = 8192;
constexpr int OFF_V = 0, OFF_KN = 2 * SHM_V, OFF_KP = OFF_KN + 2 * SHM_KN, OFF_WS = OFF_KP + 2 * SHM_KP, OFF_BIAS = OFF_WS + NW * 64 * 4, OFF_QPE = OFF_BIAS + 1024, ATT_LDS = OFF_QPE + NW * 4096, M_QPE = 3 * 40960 + 2048;
#define KSWZ(row, colB) ((row) * 256 + ((colB) ^ (((row) & 15) << 4)))
#define KPSWZ(row, colB) ((row) * 128 + ((colB) ^ ((((row) >> 1) & 7) << 4)))
#define SBAR() __builtin_amdgcn_sched_barrier(0)
__device__ __forceinline__ int crow(int r, int hi) { return (r & 3) + 8 * (r >> 2) + 4 * hi; }
typedef float f32x2_t __attribute__((ext_vector_type(2))); typedef __bf16 bf16x2_t __attribute__((ext_vector_type(2)));
__device__ __forceinline__ unsigned cvtpk(float lo, float hi) { f32x2_t v = {lo, hi}; bf16x2_t b = __builtin_convertvector(v, bf16x2_t); return __builtin_bit_cast(unsigned, b); }
__device__ __forceinline__ bf16x8 ld8(const bf16_t* p) { return *reinterpret_cast<const bf16x8*>(p); }

template <int THR2>
__device__ __forceinline__ void partialSM(f32x16& p0, f32x16& p1, float& m_reg, float& alpha, const float C = 1.f) {
  float pmax = p0[0];
#pragma unroll
  for (int r = 1; r < 16; ++r) pmax = fmaxf(pmax, p0[r]);
#pragma unroll
  for (int r = 0; r < 16; ++r) pmax = fmaxf(pmax, p1[r]);
  { auto rr = __builtin_amdgcn_permlane32_swap(__float_as_uint(pmax), __float_as_uint(pmax), false, false);
    pmax = fmaxf(__uint_as_float(rr[0]), __uint_as_float(rr[1])) * C; }
  float mn;
  if (THR2 > 0 && __builtin_expect(__all(pmax - m_reg <= (float)THR2), 1)) { mn = m_reg; alpha = 1.f; }
  else { mn = fmaxf(m_reg, pmax); alpha = __builtin_amdgcn_exp2f(m_reg - mn); m_reg = mn; }
#pragma unroll
  for (int r = 0; r < 16; ++r) p0[r] = fmaf(p0[r], C, -mn);
#pragma unroll
  for (int r = 0; r < 16; ++r) p1[r] = fmaf(p1[r], C, -mn);
#pragma unroll
  for (int r = 0; r < 16; ++r) p0[r] = __builtin_amdgcn_exp2f(p0[r]);
}
__device__ __forceinline__ void finishSM(f32x16& p0, f32x16& p1, float alpha, float& l_reg, bf16x8& pa0, bf16x8& pa1, bf16x8& pa2, bf16x8& pa3) {
#pragma unroll
  for (int r = 0; r < 16; ++r) p1[r] = __builtin_amdgcn_exp2f(p1[r]);
  float ps = 0;
#pragma unroll
  for (int r = 0; r < 16; ++r) ps += p0[r];
#pragma unroll
  for (int r = 0; r < 16; ++r) ps += p1[r];
  { auto rr = __builtin_amdgcn_permlane32_swap(__float_as_uint(ps), __float_as_uint(ps), false, false);
    ps = __uint_as_float(rr[0]) + __uint_as_float(rr[1]); }
  l_reg = l_reg * alpha + ps;
#define PK4(P, BASE, OUT) do { unsigned a0 = cvtpk(P[BASE + 0], P[BASE + 1]), a1 = cvtpk(P[BASE + 2], P[BASE + 3]);   \
    unsigned b0 = cvtpk(P[BASE + 4], P[BASE + 5]), b1 = cvtpk(P[BASE + 6], P[BASE + 7]);                              \
    auto r0 = __builtin_amdgcn_permlane32_swap(a0, b0, false, false); auto r1 = __builtin_amdgcn_permlane32_swap(a1, b1, false, false); \
    u32x4 w = {r0[0], r1[0], r0[1], r1[1]}; OUT = *reinterpret_cast<bf16x8*>(&w); } while (0)
  PK4(p0, 0, pa0); PK4(p0, 8, pa1); PK4(p1, 0, pa2); PK4(p1, 8, pa3);
#undef PK4
}
template <int NPE>
__device__ __forceinline__ void qkt(f32x16& p0, f32x16& p1, const char* Kn, const char* Kp, const bf16x8* qr, const char* qpe, int r32, int hi) {
  p0 = f32x16{}; p1 = f32x16{};
#pragma unroll
  for (int d0 = 0; d0 < 8; ++d0) { const int cb = (d0 * 16 + hi * 8) * 2;
    bf16x8 b0 = *reinterpret_cast<const bf16x8*>(Kn + KSWZ(r32, cb));
    bf16x8 b1 = *reinterpret_cast<const bf16x8*>(Kn + KSWZ(32 + r32, cb));
    p0 = __builtin_amdgcn_mfma_f32_32x32x16_bf16(b0, qr[d0], p0, 0, 0, 0);
    p1 = __builtin_amdgcn_mfma_f32_32x32x16_bf16(b1, qr[d0], p1, 0, 0, 0); }
#pragma unroll
  for (int d0 = 0; d0 < NPE; ++d0) { const int cb = (d0 * 16 + hi * 8) * 2;
    bf16x8 b0 = *reinterpret_cast<const bf16x8*>(Kp + KPSWZ(r32, cb));
    bf16x8 b1 = *reinterpret_cast<const bf16x8*>(Kp + KPSWZ(32 + r32, cb));
    p0 = __builtin_amdgcn_mfma_f32_32x32x16_bf16(b0, qr[8 + d0], p0, 0, 0, 0);
    p1 = __builtin_amdgcn_mfma_f32_32x32x16_bf16(b1, qr[8 + d0], p1, 0, 0, 0); }
}
typedef int i32x8 __attribute__((ext_vector_type(8))); typedef int i32x4 __attribute__((ext_vector_type(4)));
__device__ __forceinline__ void qkt8(f32x16& p0, f32x16& p1, const char* K8t, const i32x8* q8, int r32, int hi) {
  p0 = f32x16{}; p1 = f32x16{};
#pragma unroll
  for (int s = 0; s < 3; ++s) { const int cb = 64 * s + 32 * hi;
    const i32x4 a0 = *reinterpret_cast<const i32x4*>(K8t + KSWZ(r32, cb)), a1 = *reinterpret_cast<const i32x4*>(K8t + KSWZ(r32, cb + 16));
    const i32x4 c0 = *reinterpret_cast<const i32x4*>(K8t + KSWZ(32 + r32, cb)), c1 = *reinterpret_cast<const i32x4*>(K8t + KSWZ(32 + r32, cb + 16));
    p0 = __builtin_amdgcn_mfma_scale_f32_32x32x64_f8f6f4(__builtin_shufflevector(a0, a1, 0, 1, 2, 3, 4, 5, 6, 7), q8[s], p0, 0, 0, 0, 0, 0, 0);
    p1 = __builtin_amdgcn_mfma_scale_f32_32x32x64_f8f6f4(__builtin_shufflevector(c0, c1, 0, 1, 2, 3, 4, 5, 6, 7), q8[s], p1, 0, 0, 0, 0, 0, 0); }
}
__device__ __forceinline__ int cvt4nc(float a, float b, float c, float d) { const int r = __builtin_amdgcn_cvt_pk_fp8_f32(a, b, 0, false); return __builtin_amdgcn_cvt_pk_fp8_f32(c, d, r, true); }
__device__ __forceinline__ void finishSM8(f32x16& p0, f32x16& p1, float alpha, float& l_reg, i32x8& pa) {
#pragma unroll
  for (int r = 0; r < 16; ++r) p1[r] = __builtin_amdgcn_exp2f(p1[r]);
  float ps = 0;
#pragma unroll
  for (int r = 0; r < 16; ++r) ps += p0[r];
#pragma unroll
  for (int r = 0; r < 16; ++r) ps += p1[r];
  { auto rr = __builtin_amdgcn_permlane32_swap(__float_as_uint(ps), __float_as_uint(ps), false, false);
    ps = __uint_as_float(rr[0]) + __uint_as_float(rr[1]); }
  l_reg = l_reg * alpha + ps;
#pragma unroll
  for (int i = 0; i < 4; ++i) { pa[i] = cvt4nc(p0[4 * i], p0[4 * i + 1], p0[4 * i + 2], p0[4 * i + 3]); pa[4 + i] = cvt4nc(p1[4 * i], p1[4 * i + 1], p1[4 * i + 2], p1[4 * i + 3]); }
}
__device__ __forceinline__ void pv8(f32x16* o, const char* VT, const i32x8 pa, int r32, int hi) {
  const int f = (r32 >> 2) & 3; const char* b = VT + r32 * 64; const int c0 = ((2 * hi) ^ f) * 16, c1 = ((2 * hi + 1) ^ f) * 16;
#pragma unroll
  for (int d0 = 0; d0 < 4; ++d0) { const i32x4 x = *reinterpret_cast<const i32x4*>(b + d0 * 2048 + c0), y = *reinterpret_cast<const i32x4*>(b + d0 * 2048 + c1);
    o[d0] = __builtin_amdgcn_mfma_scale_f32_32x32x64_f8f6f4(pa, __builtin_shufflevector(x, y, 0, 1, 2, 3, 4, 5, 6, 7), o[d0], 0, 0, 0, 0, 0, 0); }
}
__device__ __forceinline__ int v_st(int k, int c) { const int kk = (k & ~0xC) | ((k & 4) << 1) | ((k & 8) >> 1); return ((kk >> 3) * 4 + (c >> 5)) * 512 + ((kk & 7) * 32 + (c & 31)) * 2; }
__device__ __forceinline__ int v_rd_base(int lane) { return ((lane & 3) << 3) | (((lane >> 2) & 3) << 6) | (((lane >> 4) & 1) << 5) | (((lane >> 5) & 1) << 8); }
constexpr int v_rd_off(int d0, int ks, int half) { return d0 * 512 + ks * 4096 + half * 2048; }
template <int OFF> __device__ __forceinline__ s16x4 tr_read(int vb) {
  s16x4 r; asm volatile("ds_read_b64_tr_b16 %0, %1 offset:%2" : "=&v"(r) : "v"(vb), "i"(OFF) : "memory"); return r;
}
template <int D0> __device__ __forceinline__ void pv_one(f32x16& od, int vb, bf16x8 pa0, bf16x8 pa1, bf16x8 pa2, bf16x8 pa3) {
  const s16x4 l0 = tr_read<v_rd_off(D0, 0, 0)>(vb), h0 = tr_read<v_rd_off(D0, 0, 1)>(vb), l1 = tr_read<v_rd_off(D0, 1, 0)>(vb), h1 = tr_read<v_rd_off(D0, 1, 1)>(vb);
  const s16x4 l2 = tr_read<v_rd_off(D0, 2, 0)>(vb), h2 = tr_read<v_rd_off(D0, 2, 1)>(vb), l3 = tr_read<v_rd_off(D0, 3, 0)>(vb), h3 = tr_read<v_rd_off(D0, 3, 1)>(vb);
  asm volatile("s_waitcnt lgkmcnt(0)" ::: "memory"); SBAR();
#define PK(L, H) (bf16x8){L[0], L[1], L[2], L[3], H[0], H[1], H[2], H[3]}
  od = __builtin_amdgcn_mfma_f32_32x32x16_bf16(pa0, PK(l0, h0), od, 0, 0, 0);
  od = __builtin_amdgcn_mfma_f32_32x32x16_bf16(pa1, PK(l1, h1), od, 0, 0, 0);
  od = __builtin_amdgcn_mfma_f32_32x32x16_bf16(pa2, PK(l2, h2), od, 0, 0, 0);
  od = __builtin_amdgcn_mfma_f32_32x32x16_bf16(pa3, PK(l3, h3), od, 0, 0, 0);
#undef PK
}
__device__ __forceinline__ void pv_d0(f32x16* o, int vb, bf16x8 pa0, bf16x8 pa1, bf16x8 pa2, bf16x8 pa3) {
  pv_one<0>(o[0], vb, pa0, pa1, pa2, pa3); pv_one<1>(o[1], vb, pa0, pa1, pa2, pa3); pv_one<2>(o[2], vb, pa0, pa1, pa2, pa3); pv_one<3>(o[3], vb, pa0, pa1, pa2, pa3);
}
#define RESC(a) do { if (__any((a) < 1.f)) { if (hi == 0) al_l[r32] = (a); asm volatile("s_waitcnt lgkmcnt(0)" ::: "memory"); \
    _Pragma("unroll") for (int d = 0; d < 4; ++d) _Pragma("unroll") for (int r = 0; r < 16; ++r) o[d][r] *= al_l[crow(r, hi)]; } } while (0)

#define LAS3 __attribute__((address_space(3)))
__device__ __forceinline__ void mla_unit(const bf16_t* __restrict__ Qb, const bf16_t* __restrict__ Kh, const bf16_t* __restrict__ Vh, const bf16_t* __restrict__ Kpe,
                                         const bf16_t* __restrict__ Gb, bf16_t* __restrict__ Ob, char* lds, LAS3 unsigned char* ldsl) {
  constexpr int LDQ = 3072, LDK = 4096, LDO = 2048, NT = SEQ / KVBLK; constexpr float QKC = 1.f / (Q8_SC * K8_SC);
  constexpr int STG = 24576, O_V = 0, O_KN = 8192, M_WS = 3 * STG;
  const int tid = opaque_tid(), wid = __builtin_amdgcn_readfirstlane(tid >> 6), lane = tid & 63, r32 = lane & 31, hi = lane >> 5;
  float* ws = (float*)(lds + M_WS) + wid * 64; float* li_l = ws; float* al_l = ws + 32;
  float m_reg = -1e30f, l_reg = 0; f32x16 o[4] = {}; i32x8 q8[3];
  { const unsigned char* Qw = (const unsigned char*)Qb + (long)(wid * QBLK + r32) * LDQ + hi * 32;
#pragma unroll
    for (int s = 0; s < 3; ++s) { const i32x4 a = *reinterpret_cast<const i32x4*>(Qw + 64 * s), b = *reinterpret_cast<const i32x4*>(Qw + 64 * s + 16); q8[s] = __builtin_shufflevector(a, b, 0, 1, 2, 3, 4, 5, 6, 7); } }
  asm volatile("s_waitcnt vmcnt(0)" ::: "memory"); SBAR();
  int vsrc, ksrc[2];
#pragma unroll
  for (int i = 0; i < 2; ++i) { const int c = wid + 8 * i;
    { const int row = c * 4 + (lane >> 4), colB = ((lane & 15) * 16) ^ ((row & 15) << 4); ksrc[i] = row * 256 + colB; } }
  { const int row = wid * 16 + (lane >> 2), ch = (lane & 3) ^ ((row >> 2) & 3); vsrc = row * SEQ + ch * 16; }
#define DMA16(gptr, ldsoff) __builtin_amdgcn_global_load_lds((const unsigned*)(gptr), (LAS3 unsigned*)(ldsl + (ldsoff)), 16, 0, 0)
#define ISSUE_K(t, s) do { const unsigned char* kb_ = (const unsigned char*)Kh + (long)(t) * (KVBLK * 256); DMA16(kb_ + ksrc[0], (s) * STG + O_KN + wid * 1024); DMA16(kb_ + ksrc[1], (s) * STG + O_KN + (wid + 8) * 1024); } while (0)
#define ISSUE_V(t, s) do { DMA16((const unsigned char*)Vh + (long)(t) * KVBLK + vsrc, (s) * STG + O_V + wid * 1024); } while (0)
#define WAITBAR(N) do { asm volatile("s_waitcnt vmcnt(" #N ") lgkmcnt(0)" ::: "memory"); __builtin_amdgcn_s_barrier(); asm volatile("" ::: "memory"); } while (0)
  f32x16 pA0, pA1, pB0, pB1; float alA, alB; i32x8 pa;
  int s0 = 0, s1 = 1, s2 = 2;
#define ROT() do { const int t_ = s0; s0 = s1; s1 = s2; s2 = t_; } while (0)
  ISSUE_K(0, 0); ISSUE_V(0, 0); ISSUE_K(1, 1);
  WAITBAR(2);
  ISSUE_K(2, s2); ISSUE_V(1, s1);
  qkt8(pA0, pA1, lds + s0 * STG + O_KN, q8, r32, hi); partialSM<8>(pA0, pA1, m_reg, alA, QKC);
  WAITBAR(3); ROT();
#define STEP(PX0, PX1, ALX, PY0, PY1, ALY, j_) do { const bool ik_ = (j_) + 2 < NT, iv_ = (j_) + 1 < NT; \
    if (ik_) ISSUE_K((j_) + 2, s2); if (iv_) ISSUE_V((j_) + 1, s1); \
    SBAR(); qkt8(PX0, PX1, lds + s0 * STG + O_KN, q8, r32, hi); \
    finishSM8(PY0, PY1, ALY, l_reg, pa); SBAR(); \
    pv8(o, lds + s2 * STG + O_V, pa, r32, hi); partialSM<8>(PX0, PX1, m_reg, ALX, QKC); \
    RESC(ALX); \
    if (ik_) WAITBAR(3); else WAITBAR(0); ROT(); } while (0)
  for (int j = 1; j + 1 < NT; j += 2) {
    STEP(pB0, pB1, alB, pA0, pA1, alA, j);
    STEP(pA0, pA1, alA, pB0, pB1, alB, j + 1);
  }
  STEP(pB0, pB1, alB, pA0, pA1, alA, NT - 1);
  finishSM8(pB0, pB1, alB, l_reg, pa); SBAR();
  pv8(o, lds + s2 * STG + O_V, pa, r32, hi);
  if (hi == 0) li_l[r32] = l_reg; asm volatile("s_waitcnt lgkmcnt(0)" ::: "memory");
  float rli[16];
#pragma unroll
  for (int r = 0; r < 16; ++r) rli[r] = __builtin_amdgcn_rcpf(li_l[crow(r, hi)]) * (1.f / V8_SC);
  __syncthreads();
  const bf16_t* Gw = Gb + (long)(wid * QBLK) * LDP;
  { bf16_t* stg = (bf16_t*)(lds + wid * 8704);
#pragma unroll
    for (int r = 0; r < 16; ++r) { const int orow = crow(r, hi);
#pragma unroll
      for (int d0 = 0; d0 < 4; ++d0) { const float ov = o[d0][r] * rli[r]; stg[orow * 136 + d0 * 32 + r32] = (bf16_t)(cvtpk(ov, ov) & 0xffffu); } }
    asm volatile("s_waitcnt lgkmcnt(0)" ::: "memory");
    int lz = lane; asm volatile("" : "+v"(lz));
#pragma unroll
    for (int i = 0; i < 8; ++i) { const int id = i * 64 + lz, row = id >> 4, c = (id & 15) * 8;
      const u32x4 ov = *(const u32x4*)(stg + row * 136 + c); const u32x4 gv = *(const u32x4*)(Gw + (long)row * LDP + c);
#define PLO(k) (__uint_as_float(ov[k] << 16) * __uint_as_float(gv[k] << 16) * A_SC)
#define PHI(k) (__uint_as_float(ov[k] & 0xffff0000u) * __uint_as_float(gv[k] & 0xffff0000u) * A_SC)
      typedef int i32x2 __attribute__((ext_vector_type(2)));
      *(i32x2*)((unsigned char*)Ob + (long)(wid * QBLK + row) * LDO + c) = (i32x2){pg8::cvt4_fp8(PLO(0), PHI(0), PLO(1), PHI(1)), pg8::cvt4_fp8(PLO(2), PHI(2), PLO(3), PHI(3))}; } }
#undef PLO
#undef PHI
  __syncthreads();
#undef DMA16
#undef ISSUE_K
#undef ISSUE_V
#undef WAITBAR
#undef ROT
#undef STEP
}

__device__ __forceinline__ void dswa_unit(int H, int rs, int qb, const bf16_t* __restrict__ proj, const float* __restrict__ bias2, bf16_t* __restrict__ Od, float* __restrict__ lse, char* lds) {
  const int g = H >> 3, dil = 1 << (2 * g), L = SEQ / dil, Q0 = qb * 256, T0 = Q0 - 64;
  const int tid = opaque_tid(), wid = tid >> 6, lane = tid & 63, r32 = lane & 31, hi = lane >> 5;
  char* V_lds = lds + OFF_V; char* Kn_lds = lds + OFF_KN;
  float* ws = (float*)(lds + OFF_WS) + wid * 64; float* li_l = ws; float* al_l = ws + 32;
  float* bl = (float*)(lds + OFF_BIAS);
  const bf16_t* Qp = proj + C_DQ + H * 128; const bf16_t* Kp = proj + C_DK + H * 128; const bf16_t* Vp = proj + C_DV + H * 128;
  if (tid < 352) { const int dj = tid - 176; bl[tid] = (dj >= -64 && dj <= 64) ? bias2[(g * 8 + (H & 7)) * 129 + dj + 64] : -1e30f; }
  const int qa = Q0 + wid * QBLK, qi = qa + r32;
  bf16x8 qr[8];
  { const bf16_t* Qw = Qp + (size_t)(qi * dil + rs) * LDP + hi * 8;
#pragma unroll
    for (int d0 = 0; d0 < 8; ++d0) qr[d0] = ld8(Qw + d0 * 16); }
  const int sr = tid >> 4, sc = (tid & 15) * 8, vst0 = v_st(sr, sc), vst1 = v_st(32 + sr, sc);
  const int vb0 = (int)(uintptr_t)V_lds + v_rd_base(lane);
  float m_reg = -1e29f, l_reg = 0.f; f32x16 o[4] = {};
  const int tlo = (Q0 == 0) ? 1 : 0, thi = (Q0 + 256 >= L) ? 5 : 6;
  bf16x8 vs0, vs1, ks0, ks1;
#define DLOAD(t_) do { const int k0_ = T0 + 64 * (t_); int i0 = k0_ + sr, i1 = k0_ + 32 + sr; i0 = i0 < 0 ? 0 : (i0 >= L ? L - 1 : i0); i1 = i1 < 0 ? 0 : (i1 >= L ? L - 1 : i1); \
    const size_t o0 = (size_t)(i0 * dil + rs) * LDP + sc, o1 = (size_t)(i1 * dil + rs) * LDP + sc; vs0 = ld8(Vp + o0); vs1 = ld8(Vp + o1); ks0 = ld8(Kp + o0); ks1 = ld8(Kp + o1); } while (0)
  DLOAD(tlo);
  for (int t = tlo; t < thi; ++t) {
    const int k0 = T0 + 64 * t;
    __syncthreads();
    *(bf16x8*)(V_lds + vst0) = vs0; *(bf16x8*)(V_lds + vst1) = vs1;
    *(bf16x8*)(Kn_lds + KSWZ(sr, sc * 2)) = ks0; *(bf16x8*)(Kn_lds + KSWZ(32 + sr, sc * 2)) = ks1;
    __syncthreads();
    if (t + 1 < thi) DLOAD(t + 1);
    if (k0 > qa + 31 + 64 || k0 + 63 < qa - 64) continue;
    f32x16 p0, p1; qkt<0>(p0, p1, Kn_lds, Kn_lds, qr, Kn_lds, r32, hi);
    if (k0 >= 0 && k0 + 63 < L) {
      const float* bp = bl + (k0 - qi + 4 * hi + 176);
#pragma unroll
      for (int r = 0; r < 16; ++r) { p0[r] += bp[(r & 3) + 8 * (r >> 2)]; p1[r] += bp[32 + (r & 3) + 8 * (r >> 2)]; }
    } else {
#pragma unroll
      for (int r = 0; r < 16; ++r) { const int kj = k0 + crow(r, hi), dj = kj - qi, kj1 = kj + 32, dj1 = dj + 32;
        const bool ok0 = (kj >= 0) && (kj < L), ok1 = (kj1 >= 0) && (kj1 < L);
        p0[r] = ok0 ? p0[r] + bl[dj + 176] : -1e30f; p1[r] = ok1 ? p1[r] + bl[dj1 + 176] : -1e30f; }
    }
    float al; partialSM<0>(p0, p1, m_reg, al);
    bf16x8 pa0, pa1, pa2, pa3; finishSM(p0, p1, al, l_reg, pa0, pa1, pa2, pa3);
    RESC(al);
    SBAR(); pv_d0(o, vb0, pa0, pa1, pa2, pa3);
  }
#undef DLOAD
  if (hi == 0) li_l[r32] = l_reg; asm volatile("s_waitcnt lgkmcnt(0)" ::: "memory");
  float rli[16];
#pragma unroll
  for (int r = 0; r < 16; ++r) rli[r] = __builtin_amdgcn_rcpf(li_l[crow(r, hi)]);
  const int hh = H & 7;
  bf16_t* Og = Od + (size_t)g * SEQ * 1024 + hh * 128;
#pragma unroll
  for (int r = 0; r < 16; ++r) { const size_t pos = (size_t)(qa + crow(r, hi)) * dil + rs;
#pragma unroll
    for (int d0 = 0; d0 < 4; ++d0) { const float ov = o[d0][r] * rli[r]; Og[pos * 1024 + d0 * 32 + r32] = (bf16_t)(cvtpk(ov, ov) & 0xffffu); } }
  if (hi == 0) lse[((size_t)g * SEQ + (size_t)qi * dil + rs) * 8 + hh] = m_reg + __builtin_amdgcn_logf(l_reg);
  __syncthreads();
}
#undef RESC
#undef KSWZ
#undef KPSWZ
#undef SBAR
}

#define LAS __attribute__((address_space(3)))
typedef unsigned short bf16;
typedef unsigned v4u __attribute__((ext_vector_type(4)));
typedef float f32x4 __attribute__((ext_vector_type(4)));
constexpr int NWAVES = 8;
constexpr size_t MiB = 1u << 20;
constexpr size_t WS_RSSQ = 0, WS_RSSKV = 32768, WS_STATS = 65536, WS_BIAS2 = 131072, WS_LSE = 262144;
constexpr size_t WS_ROPE = 2 * MiB;
constexpr size_t WS_WIN = 4 * MiB, WS_WQB = 178 * MiB, WS_WKVB = 184 * MiB, WS_WOMLA = 188 * MiB, WS_WODSWA = 204 * MiB, WS_WOUT = 212 * MiB;
constexpr size_t WS_H = 244 * MiB, WS_PROJ = 308 * MiB, WS_QMLA = 656 * MiB, WS_KVMLA = 704 * MiB, WS_KPE = 768 * MiB, WS_AMLA = 770 * MiB;
constexpr size_t WS_ODSWA = 802 * MiB, WS_BDSWA = 850 * MiB, WS_T = 866 * MiB, WS_K8 = 930 * MiB, WS_END = 962 * MiB;
static_assert(WS_WIN + (size_t)LDP * 4096 * 2 <= WS_WQB && WS_PROJ + (size_t)SEQ * LDP * 2 <= WS_QMLA && WS_LSE + 3 * SEQ * 8 * 4 <= WS_ROPE, "d_ws map");
constexpr int LDS_BYTES = 163840; constexpr int LDS_XB = 163840 - 64;
constexpr size_t WS_XBAR = 1 * MiB;

__device__ __forceinline__ unsigned f2bf(float f) { unsigned u = __builtin_bit_cast(unsigned, f); return (u + 0x7fffu + ((u >> 16) & 1u)) >> 16; }
__device__ __forceinline__ unsigned pk2(float lo, float hi) { return f2bf(lo) | (f2bf(hi) << 16); }
__device__ __forceinline__ float wave_sum(float v) {
#pragma unroll
    for (int o = 1; o < 64; o <<= 1) v += __shfl_xor(v, o);
    return v;
}
__device__ __forceinline__ void transpose_item(const float* __restrict__ W, int K, int N, bf16* __restrict__ WT, int k0, int n0, int dbase, int dstride, const float* __restrict__ kscale, LAS float* scr, int lane) {
    float wv[32];
#pragma unroll
    for (int i = 0; i < 32; ++i) { const int kk = 2 * i + (lane >> 5); wv[i] = __builtin_nontemporal_load(W + (size_t)(k0 + kk) * N + n0 + (lane & 31)); }
#pragma unroll
    for (int i = 0; i < 32; ++i) { const int kk = 2 * i + (lane >> 5); float w = wv[i]; if (kscale) w *= kscale[k0 + kk]; scr[kk * 33 + (lane & 31)] = w; }
    asm volatile("s_waitcnt lgkmcnt(0)" ::: "memory");
    const int c = lane & 7;
#pragma unroll
    for (int j = 0; j < 4; ++j) { const int n = (lane >> 3) + 8 * j; const LAS float* s = scr + (8 * c) * 33 + n;
        v4u o; o.x = pk2(s[0 * 33], s[1 * 33]); o.y = pk2(s[2 * 33], s[3 * 33]); o.z = pk2(s[4 * 33], s[5 * 33]); o.w = pk2(s[6 * 33], s[7 * 33]);
        *(v4u*)(WT + (size_t)(dbase + dstride * n) * K + k0 + 8 * c) = o; }
    asm volatile("s_waitcnt lgkmcnt(0)" ::: "memory");
}

#define XB_TMO      128
#define XB_XCNT(j)  (256  + 64 * (j))
#define XB_XSUB(j)  (1280 + 64 * (j))
#define XB_XGEN(j)  (2304 + 64 * (j))
#define XB_TOP      3328
#define XB_TOPGEN   3392
#define XCD_BAR_WORDS 3456
#define XB_SPIN_CAP (1u << 18)

__device__ __forceinline__ unsigned xb_ld(unsigned* p)              { return __hip_atomic_load(p, __ATOMIC_RELAXED, __HIP_MEMORY_SCOPE_AGENT); }
__device__ __forceinline__ unsigned xb_add(unsigned* p, unsigned v) { return __hip_atomic_fetch_add(p, v, __ATOMIC_RELAXED, __HIP_MEMORY_SCOPE_AGENT); }
__device__ __forceinline__ unsigned xb_xcc_id() { return (unsigned)__builtin_amdgcn_s_getreg((3 << 11) | 20) & 0xFu; }
#define XB_SPIN(cond, bar) do { unsigned _sp = 0; while (cond) { __builtin_amdgcn_s_sleep(1); \
    if ((++_sp & 255u) == 0u) { if (xb_ld(&(bar)[XB_TMO])) break; if (_sp > XB_SPIN_CAP) { atomicAdd(&(bar)[XB_TMO], 1u); break; } } } } while (0)

struct XcdBarrier {
    unsigned* bar; unsigned x;
    volatile LAS unsigned* st;
};

__device__ __forceinline__ XcdBarrier xcd_barrier_post(unsigned* bar, volatile LAS unsigned* st) {
    XcdBarrier b; b.bar = bar; b.x = xb_xcc_id(); b.st = st;
    if (threadIdx.x == 0) (void)xb_add(&bar[XB_XCNT(b.x)], 1u);
    return b;
}
__device__ __forceinline__ void xcd_barrier_complete(unsigned* bar, unsigned x, unsigned& nloc, unsigned& nx) {
    const unsigned G = gridDim.x * gridDim.y * gridDim.z;
    unsigned sum, cnt, mine, sp = 0u;
    for (;;) {
        sum = 0u; cnt = 0u; mine = 0u;
#pragma unroll
        for (unsigned j = 0; j < 16; ++j) { const unsigned c = xb_ld(&bar[XB_XCNT(j)]); sum += c; cnt += (c > 0u) ? 1u : 0u; mine = (j == x) ? c : mine; }
        if (sum == G) break;
        __builtin_amdgcn_s_sleep(1);
        if ((++sp & 255u) == 0u) { if (xb_ld(&bar[XB_TMO])) break; if (sp > XB_SPIN_CAP) { atomicAdd(&bar[XB_TMO], 1u); break; } }
    }
    nloc = mine > 0u ? mine : 1u; nx = cnt > 0u ? cnt : 1u;
}

__device__ __forceinline__ void xcd_barrier(const XcdBarrier& b) {
    asm volatile("s_waitcnt vmcnt(0)" ::: "memory");
    __syncthreads();
    if (threadIdx.x == 0) {
        unsigned* bar = b.bar;
        __builtin_amdgcn_s_waitcnt(0);
        unsigned nloc = b.st[0], nx = b.st[1];
        if (nloc == 0u) { xcd_barrier_complete(bar, b.x, nloc, nx); b.st[0] = nloc; b.st[1] = nx; }
        const unsigned old = xb_add(&bar[XB_XSUB(b.x)], 1u);
        const unsigned gen = old / nloc;
        if (old + 1u == (gen + 1u) * nloc) {
            __builtin_amdgcn_fence(__ATOMIC_RELEASE, "agent");
            asm volatile("s_waitcnt vmcnt(0)" ::: "memory");
            const unsigned og = xb_add(&bar[XB_TOP], 1u);
            const unsigned tg = og / nx;
            if (og + 1u == (tg + 1u) * nx) xb_add(&bar[XB_TOPGEN], 1u);
            else XB_SPIN(xb_ld(&bar[XB_TOPGEN]) == tg, bar);
            __builtin_amdgcn_fence(__ATOMIC_ACQUIRE, "agent");
            xb_add(&bar[XB_XGEN(b.x)], 1u);
            asm volatile("s_waitcnt vmcnt(0)" ::: "memory");
        } else {
            XB_SPIN(xb_ld(&bar[XB_XGEN(b.x)]) == gen, bar);
            __builtin_amdgcn_fence(__ATOMIC_ACQUIRE, "agent");
            asm volatile("s_waitcnt vmcnt(0)" ::: "memory");
        }
    }
    __syncthreads();
}

#define REP0 1
#define REP1 1
#define REP2 1
#define REP3 1
#define REP4 1
#define REP5 1
__device__ __forceinline__ void transpose_item8(const float* __restrict__ W, int K, int N, unsigned char* __restrict__ WT, int k0, int n0, int dbase, int dstride, float wsc, const float* __restrict__ kscale, LAS float* scr, int lane) {
    float wv[32];
#pragma unroll
    for (int i = 0; i < 32; ++i) { const int kk = 2 * i + (lane >> 5); wv[i] = __builtin_nontemporal_load(W + (size_t)(k0 + kk) * N + n0 + (lane & 31)); }
#pragma unroll
    for (int i = 0; i < 32; ++i) { const int kk = 2 * i + (lane >> 5); scr[kk * 33 + (lane & 31)] = wv[i] * (kscale ? wsc * kscale[k0 + kk] : wsc); }
    asm volatile("s_waitcnt lgkmcnt(0)" ::: "memory");
    const int c = lane & 7;
#pragma unroll
    for (int j = 0; j < 4; ++j) { const int n = (lane >> 3) + 8 * j; const LAS float* s = scr + (8 * c) * 33 + n;
        int d0 = __builtin_amdgcn_cvt_pk_fp8_f32(s[0 * 33], s[1 * 33], 0, false); d0 = __builtin_amdgcn_cvt_pk_fp8_f32(s[2 * 33], s[3 * 33], d0, true);
        int d1 = __builtin_amdgcn_cvt_pk_fp8_f32(s[4 * 33], s[5 * 33], 0, false); d1 = __builtin_amdgcn_cvt_pk_fp8_f32(s[6 * 33], s[7 * 33], d1, true);
        typedef int i32x2 __attribute__((ext_vector_type(2)));
        *(i32x2*)(WT + (size_t)(dbase + dstride * n) * K + k0 + 8 * c) = (i32x2){d0, d1}; }
    asm volatile("s_waitcnt lgkmcnt(0)" ::: "memory");
}
struct Args { const float* in[14]; float* out; unsigned char* ws; };

__global__ void __launch_bounds__(NWAVES * 64, 2) fwd_mega(Args a) {
    extern __shared__ __attribute__((aligned(16))) unsigned char lds[];
    cg::grid_group grid = cg::this_grid();
    const int G = gridDim.x, bx = blockIdx.x, vcu = (G % 8 == 0) ? (bx % 8) * (G / 8) + bx / 8 : bx;
    LAS unsigned char* ldsl = (LAS unsigned char*)lds;
    unsigned char* ws = a.ws;
    const float* x = a.in[0]; const float* emb_g = a.in[1]; const float* emb_b = a.in[2]; const float* rel_bias = a.in[3]; const float* w_in = a.in[4];
    const float* qa_g = a.in[5]; const float* w_qb = a.in[6]; const float* kva_g = a.in[7]; const float* w_kvb = a.in[8]; const float* w_omla = a.in[9];
    const float* w_odswa = a.in[10]; const float* w_out = a.in[11]; const float* ln_g = a.in[12]; const float* ln_b = a.in[13];
    float* rss_q = (float*)(ws + WS_RSSQ); float* rss_kv = (float*)(ws + WS_RSSKV); float* stats = (float*)(ws + WS_STATS); float* bias2 = (float*)(ws + WS_BIAS2);
    float* lse = (float*)(ws + WS_LSE); float* rope = (float*)(ws + WS_ROPE);
    bf16* Win_t = (bf16*)(ws + WS_WIN); bf16* Wqb_t = (bf16*)(ws + WS_WQB); bf16* Wkvb_t = (bf16*)(ws + WS_WKVB); bf16* Womla_t = (bf16*)(ws + WS_WOMLA);
    bf16* Wodswa_t = (bf16*)(ws + WS_WODSWA); bf16* Wout_t = (bf16*)(ws + WS_WOUT);
    bf16* Hb = (bf16*)(ws + WS_H); bf16* proj = (bf16*)(ws + WS_PROJ); bf16* Qmla = (bf16*)(ws + WS_QMLA); bf16* KVmla = (bf16*)(ws + WS_KVMLA); bf16* Kpe = (bf16*)(ws + WS_K8);
    bf16* Amla = (bf16*)(ws + WS_AMLA); bf16* Odswa = (bf16*)(ws + WS_ODSWA); bf16* Bdswa = (bf16*)(ws + WS_BDSWA); bf16* Tm = (bf16*)(ws + WS_T); unsigned char* T8 = ws + WS_H + 32 * MiB;
    const int NGW = G * NWAVES, NGT = G * NWAVES * 64;
    volatile LAS unsigned* xb_st = (volatile LAS unsigned*)(ldsl + LDS_XB);
    if (threadIdx.x < 2) xb_st[threadIdx.x] = 0u;
    __syncthreads();
    const XcdBarrier xbar = xcd_barrier_post((unsigned*)(ws + WS_XBAR), xb_st);
    if (a.out == nullptr) grid.sync();
#define PHASE_IDS() const int tid = opaque_tid(), lane = tid & 63, wave = __builtin_amdgcn_readfirstlane(tid >> 6), gw = vcu * NWAVES + wave, gt = bx * (NWAVES * 64) + tid; (void)lane; (void)gw; (void)gt

    for (int rep = 0; rep < REP0; ++rep) {
        PHASE_IDS();
        LAS float* scr = (LAS float*)(ldsl + wave * 16384);
        constexpr int I_IN = 64 * 690, I_QB = 16 * 96, I_KVB = 8 * 128, I_OM = 32 * 128, I_OD = 16 * 128, I_OUT = 64 * 128;
        constexpr int NITEMS = I_IN + I_QB + I_KVB + I_OM + I_OD + I_OUT;
        for (int it = gw; it < NITEMS; it += NGW) {
            int r = it;
            if (r < I_IN) { const int kb = r / 690, nb = r % 690; int db, ds; if (nb < 48) { db = nb * 32; ds = 1; } else if (nb == 48) { db = C_KPE; ds = 2; } else if (nb == 49) { db = C_KPE + 1; ds = 2; } else { db = nb * 32 - 64; ds = 1; }
                transpose_item8(w_in, 4096, IN_W, (unsigned char*)Win_t, kb * 64, nb * 32, db, ds, W_SC, nullptr, scr, lane); continue; } r -= I_IN;
            if (r < I_QB) { const int kb = r / 96, nb = r % 96, hq = nb / 6, bi = nb % 6; int db, ds; if (bi < 4) { db = hq * 192 + bi * 32; ds = 1; } else { db = hq * 192 + 128 + (bi - 4); ds = 2; }
                transpose_item8(w_qb, 1024, 3072, (unsigned char*)Wqb_t, kb * 64, nb * 32, db, ds, WQ_SC, qa_g, scr, lane); continue; } r -= I_QB;
            if (r < I_KVB) { const int kb = r / 128, nb = r % 128; transpose_item8(w_kvb, 512, 4096, (unsigned char*)Wkvb_t, kb * 64, nb * 32, nb * 32, 1, WKV_SC, kva_g, scr, lane); continue; } r -= I_KVB;
            if (r < I_OM) { const int kb = r / 128, nb = r % 128; transpose_item8(w_omla, 2048, 4096, (unsigned char*)Womla_t, kb * 64, nb * 32, nb * 32, 1, W_OM_SC, nullptr, scr, lane); continue; } r -= I_OM;
            if (r < I_OD) { const int kb = r / 128, nb = r % 128; transpose_item8(w_odswa, 1024, 4096, (unsigned char*)Wodswa_t, kb * 64, nb * 32, nb * 32, 1, W_OD_SC, nullptr, scr, lane); continue; } r -= I_OD;
            { const int kb = r / 128, nb = r % 128; transpose_item8(w_out, 4096, 4096, (unsigned char*)Wout_t, kb * 64, nb * 32, nb * 32, 1, W_OUT_SC, nullptr, scr, lane); }
        }
        for (int m = gw; m < SEQ; m += NGW) {
            const f32x4* xr = (const f32x4*)(x + (size_t)m * DM) + lane;
            f32x4 v[16]; float s = 0.f;
#pragma unroll
            for (int j = 0; j < 16; ++j) { v[j] = xr[64 * j]; s += (v[j].x + v[j].y) + (v[j].z + v[j].w); }
            const float mean = wave_sum(s) * (1.f / DM); float s2 = 0.f;
#pragma unroll
            for (int j = 0; j < 16; ++j) { v[j] = v[j] - mean; s2 += (v[j].x * v[j].x + v[j].y * v[j].y) + (v[j].z * v[j].z + v[j].w * v[j].w); }
            const float rstd = 1.f / sqrtf(wave_sum(s2) * (1.f / DM) + LN_EPS);
            if (lane == 0) { stats[2 * m] = mean; stats[2 * m + 1] = rstd; }
            int* o4 = (int*)((unsigned char*)Hb + (size_t)m * DM) + lane;
#pragma unroll
            for (int j = 0; j < 16; ++j) { const f32x4 gv = ((const f32x4*)emb_g)[64 * j + lane], bv = ((const f32x4*)emb_b)[64 * j + lane]; const f32x4 y = (v[j] * rstd * gv + bv) * H_SC;
                int d = __builtin_amdgcn_cvt_pk_fp8_f32(y.x, y.y, 0, false); d = __builtin_amdgcn_cvt_pk_fp8_f32(y.z, y.w, d, true); o4[64 * j] = d; }
        }
        for (int e = gt; e < SEQ * 32; e += NGT) { const int pos = e >> 5, i = e & 31; const float invf = 1.0f / powf(10000.0f, (float)(2 * i) / 64.0f); const float ang = (float)pos * invf;
            double t = (double)ang * 0.15915494309189535; t -= __builtin_floor(t); const float tf = (float)t;
            rope[2 * e] = __builtin_amdgcn_cosf(tf); rope[2 * e + 1] = __builtin_amdgcn_sinf(tf); }
        for (int e = gt; e < 3 * 8 * 129; e += NGT) { const int j = e % 129 - 64, hh = (e / 129) % 8, g = e / (129 * 8), dil = 1 << (2 * g); const int rel = j * dil, n = rel < 0 ? -rel : rel;
            int bk; if (n < 8) bk = n; else { const float nf = (float)n; int lg = 8 + (int)(logf(nf / 8.f) / 4.852030263919617f * 8.f); bk = lg < 15 ? lg : 15; }
            if (rel > 0) bk += 16;
            bias2[e] = rel_bias[bk * 24 + g * 8 + hh] * LOG2E; }
        for (int e = gt; e < 2 * SEQ; e += NGT) rss_q[e] = 0.f;
    }
    xcd_barrier(xbar);

    for (int rep = 0; rep < REP1; ++rep) {
        pg8::Gemm g{Hb, Win_t, SEQ, LDP, 2048, 2048, 2048}; pg8::StaticOrder S; S.init(SEQ, LDP, G, bx);
        pg8::EpiProj E{proj, Kpe, rep ? nullptr : rss_q, rep ? nullptr : rss_kv, rope, (unsigned char*)Qmla + 24 * MiB};
        pg8::gemm_phase<pg8::EpiProj, pg8::StaticOrder, true, true, true>(ldsl, g, S, E);
    }
    xcd_barrier(xbar);

    for (int rep = 0; rep < REP2; ++rep) {
        { pg8::Gemm g{(const bf16*)((const unsigned char*)Qmla + 24 * MiB), Wqb_t, SEQ, 3072, 512, 768, 512}; pg8::StaticOrder S; S.init(SEQ, 3072, G, bx);
          pg8::EpiQ E{Qmla, rss_q, rope}; pg8::gemm_phase<pg8::EpiQ, pg8::StaticOrder, true, true, true>(ldsl, g, S, E); }
        { pg8::Gemm g{(const bf16*)((const unsigned char*)Qmla + 24 * MiB + 1024), Wkvb_t, SEQ, 4096, 256, 768, 256}; pg8::StaticOrder S; S.init(SEQ, 4096, G, bx);
          pg8::EpiKV E{(unsigned char*)KVmla  , rss_kv, (unsigned char*)Kpe}; pg8::gemm_phase<pg8::EpiKV, pg8::StaticOrder, true, true, true>(ldsl, g, S, E); }
        __syncthreads();
        for (int u = vcu; u < 768; u += G) { const int H = u >> 5, rem = u & 31, g = H >> 3, nqb = 32 >> (2 * g); att::dswa_unit(H, rem / nqb, rem % nqb, proj, bias2, Odswa, lse, (char*)lds); }
    }
    xcd_barrier(xbar);

    for (int rep = 0; rep < REP3; ++rep) {
        for (int u = vcu; u < 512; u += G) { const int h = u >> 5, qb = u & 31; const size_t r0 = (size_t)qb * 256;
            att::mla_unit((const bf16*)((const unsigned char*)Qmla + r0 * 3072 + h * 192), (const bf16*)((const unsigned char*)Kpe + (size_t)h * SEQ * 256), (const bf16*)((const unsigned char*)KVmla + (size_t)h * 128 * SEQ), Kpe, proj + r0 * LDP + C_GMLA + h * 128, (bf16*)((unsigned char*)Amla + r0 * 2048 + h * 128), (char*)lds, ldsl); }
        PHASE_IDS();
        for (int it = gt; it < SEQ * 128; it += NGT) { const int pos = it >> 7, c8 = it & 127, hh = c8 >> 4, col = c8 * 8;
            const float l0 = lse[((size_t)0 * SEQ + pos) * 8 + hh], l1 = lse[((size_t)1 * SEQ + pos) * 8 + hh], l2 = lse[((size_t)2 * SEQ + pos) * 8 + hh];
            const float mx = fmaxf(l0, fmaxf(l1, l2)); float e0 = __builtin_amdgcn_exp2f(l0 - mx), e1 = __builtin_amdgcn_exp2f(l1 - mx), e2 = __builtin_amdgcn_exp2f(l2 - mx);
            const float inv = 1.f / (e0 + e1 + e2); e0 *= inv; e1 *= inv; e2 *= inv;
            const v4u a0 = *(const v4u*)(Odswa + ((size_t)0 * SEQ + pos) * 1024 + col), a1 = *(const v4u*)(Odswa + ((size_t)1 * SEQ + pos) * 1024 + col), a2 = *(const v4u*)(Odswa + ((size_t)2 * SEQ + pos) * 1024 + col);
            const v4u gg = *(const v4u*)(proj + (size_t)pos * LDP + C_GDSWA + col);
#define MLO(k) ((pg8::bflo(a0[k]) * e0 + pg8::bflo(a1[k]) * e1 + pg8::bflo(a2[k]) * e2) * pg8::bflo(gg[k]) * B_SC)
#define MHI(k) ((pg8::bfhi(a0[k]) * e0 + pg8::bfhi(a1[k]) * e1 + pg8::bfhi(a2[k]) * e2) * pg8::bfhi(gg[k]) * B_SC)
            *(pg8::i32x2*)((unsigned char*)Bdswa + (size_t)pos * 1024 + col) = (pg8::i32x2){pg8::cvt4_fp8(MLO(0), MHI(0), MLO(1), MHI(1)), pg8::cvt4_fp8(MLO(2), MHI(2), MLO(3), MHI(3))}; }
#undef MLO
#undef MHI
    }
    xcd_barrier(xbar);

    for (int rep = 0; rep < REP4; ++rep) {
        { pg8::Gemm g{Amla, Womla_t, SEQ, 4096, 1024, 1024, 1024}; pg8::StaticOrder S; S.init(SEQ, 4096, G, bx);
          pg8::EpiY<0> E{Tm, proj + C_RMLA, T8}; pg8::gemm_phase<pg8::EpiY<0>, pg8::StaticOrder, true, true, true>(ldsl, g, S, E); }
        { pg8::Gemm g{Bdswa, Wodswa_t, SEQ, 4096, 512, 512, 512}; pg8::StaticOrder S; S.init(SEQ, 4096, G, bx);
          pg8::EpiY<1> E{Tm, proj + C_RDSWA, T8}; pg8::gemm_phase<pg8::EpiY<1>, pg8::StaticOrder, true, true, true>(ldsl, g, S, E); }
    }
    xcd_barrier(xbar);

    for (int rep = 0; rep < REP5; ++rep) {
        pg8::Gemm g{(const bf16*)T8, Wout_t, SEQ, 4096, 2048, 2048, 2048}; pg8::StaticOrder S; S.init(SEQ, 4096, G, bx);
        pg8::EpiOut E{x, stats, emb_g, emb_b, a.out, 1.f / (T_SC * W_OUT_SC)}; pg8::gemm_phase<pg8::EpiOut, pg8::StaticOrder, true, true, true>(ldsl, g, S, E);
    }
    xcd_barrier(xbar);

    { PHASE_IDS();
    for (int m = gw; m < SEQ; m += NGW) {
        f32x4* xr = (f32x4*)(a.out + (size_t)m * DM) + lane;
        f32x4 v[16]; float s = 0.f;
#pragma unroll
        for (int j = 0; j < 16; ++j) { v[j] = xr[64 * j]; s += (v[j].x + v[j].y) + (v[j].z + v[j].w); }
        const float mean = wave_sum(s) * (1.f / DM); float s2 = 0.f;
#pragma unroll
        for (int j = 0; j < 16; ++j) { v[j] = v[j] - mean; s2 += (v[j].x * v[j].x + v[j].y * v[j].y) + (v[j].z * v[j].z + v[j].w * v[j].w); }
        const float rstd = 1.f / sqrtf(wave_sum(s2) * (1.f / DM) + LN_EPS);
#pragma unroll
        for (int j = 0; j < 16; ++j) { const f32x4 gv = ((const f32x4*)ln_g)[64 * j + lane], bv = ((const f32x4*)ln_b)[64 * j + lane]; xr[64 * j] = v[j] * rstd * gv + bv; }
    } }
}

extern "C" void kernel_launch(void* const* d_in, const int* in_sizes, int n_in, void* d_out, int out_size, void* d_ws, size_t ws_size, hipStream_t stream) {
    static int grid = 0;
    if (grid == 0) {
        if (n_in != 14 || in_sizes[0] != SEQ * DM || out_size != SEQ * DM || ws_size < WS_END) { fprintf(stderr, "kernel_launch: unexpected shapes (n_in %d, in0 %d, out %d, ws %zu < %zu)\n", n_in, n_in > 0 ? in_sizes[0] : -1, out_size, ws_size, (size_t)WS_END); grid = -1; return; }
        int dev = 0, cus = 0, per_cu = 0;
        if (hipGetDevice(&dev) != hipSuccess || hipDeviceGetAttribute(&cus, hipDeviceAttributeMultiprocessorCount, dev) != hipSuccess) { grid = -1; return; }
        if (hipFuncSetAttribute((const void*)fwd_mega, hipFuncAttributeMaxDynamicSharedMemorySize, LDS_BYTES) != hipSuccess) { fprintf(stderr, "kernel_launch: hipFuncSetAttribute failed\n"); grid = -1; return; }
        if (hipOccupancyMaxActiveBlocksPerMultiprocessor(&per_cu, (const void*)fwd_mega, NWAVES * 64, LDS_BYTES) != hipSuccess || per_cu < 1) { fprintf(stderr, "kernel_launch: occupancy query says %d blocks per CU\n", per_cu); per_cu = 1; }
        (void)hipGetLastError();
        grid = cus;
    }
    if (grid < 0) return;
    Args a{};
    for (int i = 0; i < 14; ++i) a.in[i] = (const float*)d_in[i];
    a.out = (float*)d_out; a.ws = (unsigned char*)d_ws;
    if (hipMemsetAsync((char*)d_ws + WS_XBAR, 0, 16384, stream) != hipSuccess) { fprintf(stderr, "kernel_launch: hipMemsetAsync of the barrier words failed\n"); return; }
    void* args[] = {&a};
    hipError_t e = hipLaunchCooperativeKernel((const void*)fwd_mega, dim3(grid), dim3(NWAVES * 64), args, LDS_BYTES, stream);
    if (e != hipSuccess) fprintf(stderr, "kernel_launch: cooperative launch failed: %s (grid %d)\n", hipGetErrorString(e), grid);
}
```

```cpp
#include <hip/hip_runtime.h>
#include <hip/hip_cooperative_groups.h>
#include <cstdio>
#include <cstdint>
#include <cmath>
namespace cg = cooperative_groups;

constexpr int SEQ = 8192, DM = 4096;
constexpr int LDP = 22272;
constexpr int C_QA = 0, C_CKV = 1024, C_DQ = 1536, C_DK = 4608, C_DV = 7680, C_GMLA = 10752, C_GDSWA = 12800, C_RMLA = 13824, C_RDSWA = 17920, C_KPE = 22016;
constexpr int IN_W = 22080;
constexpr float LOG2E = 1.4426950408889634f;
constexpr float QS_D = 0.08838834764831845f * LOG2E;
constexpr float QS_M = 0.07216878364870323f * LOG2E;
constexpr float ALPHA = 1.189207115002721f;
constexpr float LN_EPS = 1e-5f, RMS_EPS = 1e-6f;
constexpr float H_SC = 16.f, W_SC = 1024.f;
constexpr float QA_SC = 16.f, WQ_SC = 512.f, WKV_SC = 512.f;
constexpr float Q8_SC = 64.f, K8_SC = 16.f, V8_SC = 64.f;
constexpr float A_SC = 256.f, B_SC = 128.f, T_SC = 512.f, W_OM_SC = 1024.f, W_OD_SC = 1024.f, W_OUT_SC = 2048.f;

__device__ __forceinline__ int opaque_tid() { int t = threadIdx.x; asm volatile("" : "+v"(t)); return t; }

namespace pg8 {
#define PG8_LAS __attribute__((address_space(3)))
typedef unsigned short bf16_t;
typedef short bf16x8 __attribute__((ext_vector_type(8)));
typedef float f32x4 __attribute__((ext_vector_type(4)));
typedef unsigned u32x4 __attribute__((ext_vector_type(4)));
constexpr int BM = 256, BK = 64, HALF = 128, HTB = HALF * BK * 2  , STAGE_BYTES = 8 * HTB, NXCD = 8, WGM = 8;

__host__ __device__ __forceinline__ int lds_byte(int r, int c) { const int st = (r >> 4) * 2 + (c >> 5), rr = r & 15, cc = c & 31, ob = rr * 64 + cc * 2; return st * 1024 + (ob ^ (((ob >> 9) & 1) << 5)); }
__host__ __device__ __forceinline__ void stage_rc(int b, int& R, int& C) { const int st = b / 1024, sb = b % 1024, swz = sb ^ (((sb >> 9) & 1) << 5); R = (st >> 1) * 16 + swz / 64; C = (st & 1) * 32 + (swz % 64) / 2; }
__host__ __device__ __forceinline__ int perm32(int rho) { const int n = rho >> 4, i = rho & 15; return 8 * (i >> 2) + 4 * n + (i & 3); }

struct Unit { int pm, pn; };
struct Gemm { const bf16_t* A; const bf16_t* Bt; int M, N, K, lda, ldb; };

struct StaticOrder {
    int nM, nN, nwg, G, c;
    __host__ __device__ void init(int M, int N, int G_, int c_) { nM = M / BM; nN = N / BM; nwg = nM * nN; G = G_; c = c_; }
    __host__ __device__ bool next(int i, Unit& u) const {
        const long L = (long)i * G + c; if (L >= nwg) return false;
        int wgid = (int)L; { const int q = nwg / NXCD, r = nwg % NXCD, xcd = wgid % NXCD, off = wgid / NXCD; wgid = (xcd < r ? xcd * (q + 1) : r * (q + 1) + (xcd - r) * q) + off; }
        const int nig = WGM * nN, gid = wgid / nig, fm = gid * WGM, gsz = (nM - fm) < WGM ? (nM - fm) : WGM;
        u.pm = fm + ((wgid % nig) % gsz); u.pn = (wgid % nig) / gsz; return true;
    }
    __device__ __forceinline__ void a_ready(const Unit&) const {}
    __device__ __forceinline__ void done(const Unit&) const {}
};


typedef float f32x2 __attribute__((ext_vector_type(2))); typedef __bf16 bf16x2_t __attribute__((ext_vector_type(2)));
typedef int i32x4 __attribute__((ext_vector_type(4))); typedef int i32x8 __attribute__((ext_vector_type(8)));
__device__ __forceinline__ i32x8 cat8(bf16x8 a, bf16x8 b) { return __builtin_shufflevector(__builtin_bit_cast(i32x4, a), __builtin_bit_cast(i32x4, b), 0, 1, 2, 3, 4, 5, 6, 7); }
__device__ __forceinline__ unsigned cvt_pk_bf16(float lo, float hi) { f32x2 v = {lo, hi}; bf16x2_t b = __builtin_convertvector(v, bf16x2_t); return __builtin_bit_cast(unsigned, b); }
typedef int i32x2 __attribute__((ext_vector_type(2)));
__device__ __forceinline__ int cvt4_fp8(float a, float b, float c, float d) { a = __builtin_amdgcn_fmed3f(a, -440.f, 440.f); b = __builtin_amdgcn_fmed3f(b, -440.f, 440.f); c = __builtin_amdgcn_fmed3f(c, -440.f, 440.f); d = __builtin_amdgcn_fmed3f(d, -440.f, 440.f);
    int r = __builtin_amdgcn_cvt_pk_fp8_f32(a, b, 0, false); return __builtin_amdgcn_cvt_pk_fp8_f32(c, d, r, true); }
__device__ __forceinline__ float bflo(unsigned w) { return __uint_as_float(w << 16); }
__device__ __forceinline__ float bfhi(unsigned w) { return __uint_as_float(w & 0xffff0000u); }
__device__ __forceinline__ float sigm(float x) { return __builtin_amdgcn_rcpf(1.f + __builtin_amdgcn_exp2f(-x * 1.4426950408889634f)); }
__device__ __forceinline__ u32x4 pack8(const f32x4 v0, const f32x4 v1) { u32x4 w; w.x = cvt_pk_bf16(v0[0], v0[1]); w.y = cvt_pk_bf16(v0[2], v0[3]); w.z = cvt_pk_bf16(v1[0], v1[1]); w.w = cvt_pk_bf16(v1[2], v1[3]); return w; }
__device__ __forceinline__ void rope8(f32x4& v0, f32x4& v1, const f32x4 cs0, const f32x4 cs1) {
    const float a0 = v0[0] * cs0[0] - v0[1] * cs0[1], b0 = v0[1] * cs0[0] + v0[0] * cs0[1];
    const float a1 = v0[2] * cs0[2] - v0[3] * cs0[3], b1 = v0[3] * cs0[2] + v0[2] * cs0[3];
    const float a2 = v1[0] * cs1[0] - v1[1] * cs1[1], b2 = v1[1] * cs1[0] + v1[0] * cs1[1];
    const float a3 = v1[2] * cs1[2] - v1[3] * cs1[3], b3 = v1[3] * cs1[2] + v1[2] * cs1[3];
    v0 = (f32x4){a0, b0, a1, b1}; v1 = (f32x4){a2, b2, a3, b3};
}

struct EpiProj {
    static constexpr bool PERM = true, AFTER_DRAIN = false;
    bf16_t* proj; bf16_t* kpe; float* rss_q; float* rss_kv; const float* rope; unsigned char* qa8; static constexpr float osc = 1.f / (H_SC * W_SC);
    template <int ACT> __device__ __forceinline__ void body(const f32x4 (&acc)[2][2][4][2], const Unit& u, int wr, int wc, int fr, int fq, float sc, float* rss) const {
        const int row0 = u.pm * BM + wr * 64 + fr, col0 = u.pn * BM + wc * 32 + 8 * fq;
#pragma unroll
        for (int ai = 0; ai < 2; ++ai)
#pragma unroll
            for (int m = 0; m < 4; ++m) { const int row = row0 + ai * HALF + m * 16; bf16_t* rowp = proj + (size_t)row * LDP + col0; float ss = 0.f;
#pragma unroll
                for (int bj = 0; bj < 2; ++bj) { f32x4 v0 = acc[ai][bj][m][0] * sc, v1 = acc[ai][bj][m][1] * sc;
                    if (ACT == 1) {
#pragma unroll
                        for (int e = 0; e < 4; ++e) { v0[e] = v0[e] * sigm(v0[e]); v1[e] = v1[e] * sigm(v1[e]); } }
                    if (ACT == 2) {
#pragma unroll
                        for (int e = 0; e < 4; ++e) { v0[e] = sigm(v0[e]); v1[e] = sigm(v1[e]); } }
                    if (ACT == 3) { ss += (v0[0] * v0[0] + v0[1] * v0[1]) + (v0[2] * v0[2] + v0[3] * v0[3]) + (v1[0] * v1[0] + v1[1] * v1[1]) + (v1[2] * v1[2] + v1[3] * v1[3]); }
                    if (ACT == 3) { const f32x4 a0 = v0 * QA_SC, a1 = v1 * QA_SC; *(i32x2*)(qa8 + (size_t)row * 1536 + col0 + bj * HALF) = (i32x2){cvt4_fp8(a0[0], a0[1], a0[2], a0[3]), cvt4_fp8(a1[0], a1[1], a1[2], a1[3])}; }
                    else *(u32x4*)(rowp + bj * HALF) = pack8(v0, v1); }
                if (ACT == 3) { ss += __shfl_xor(ss, 16); ss += __shfl_xor(ss, 32); if (fq == 0 && rss) atomicAdd(rss + row, ss); } }
    }
    __device__ __forceinline__ void operator()(const f32x4 (&acc)[2][2][4][2], const Unit& u, int wr, int wc, int fr, int fq) const {
        const int pn = u.pn;
        if (pn < 4) body<3>(acc, u, wr, wc, fr, fq, osc, rss_q);
        else if (pn < 6) body<3>(acc, u, wr, wc, fr, fq, osc, rss_kv);
        else if (pn < 42) body<0>(acc, u, wr, wc, fr, fq, pn < 18 ? QS_D * osc : osc, nullptr);
        else if (pn < 54) body<1>(acc, u, wr, wc, fr, fq, osc, nullptr);
        else if (pn < 86) body<2>(acc, u, wr, wc, fr, fq, osc, nullptr);
        else if (wc < 2) {
            const int row0 = u.pm * BM + wr * 64 + fr, c0 = wc * 32 + 8 * fq;
#pragma unroll
            for (int ai = 0; ai < 2; ++ai)
#pragma unroll
                for (int m = 0; m < 4; ++m) { const int row = row0 + ai * HALF + m * 16; f32x4 v0 = acc[ai][0][m][0] * osc, v1 = acc[ai][0][m][1] * osc;
                    const f32x4* cs = (const f32x4*)(rope + (size_t)row * 64 + c0); rope8(v0, v1, cs[0], cs[1]);
                    v0 = v0 * K8_SC; v1 = v1 * K8_SC; const i32x2 w8 = {cvt4_fp8(v0[0], v0[1], v0[2], v0[3]), cvt4_fp8(v1[0], v1[1], v1[2], v1[3])};
#pragma unroll
                    for (int hh = 0; hh < 16; ++hh) *(i32x2*)((unsigned char*)kpe + ((size_t)hh * SEQ + row) * 256 + 128 + c0) = w8; }
        }
    }
};
struct EpiQ {
    static constexpr bool PERM = true, AFTER_DRAIN = false;
    bf16_t* q; const float* rss; const float* rope;
    __device__ __forceinline__ void operator()(const f32x4 (&acc)[2][2][4][2], const Unit& u, int wr, int wc, int fr, int fq) const {
        const int row0 = u.pm * BM + wr * 64 + fr, col0 = u.pn * BM + wc * 32 + 8 * fq;
        const int cw0 = col0 % 192, cw1 = (col0 + HALF) % 192;
#pragma unroll
        for (int ai = 0; ai < 2; ++ai)
#pragma unroll
            for (int m = 0; m < 4; ++m) { const int row = row0 + ai * HALF + m * 16; const float sc = (QS_M / (QA_SC * WQ_SC)) / sqrtf(rss[row] * (1.f / 1024.f) + RMS_EPS);
#pragma unroll
                for (int bj = 0; bj < 2; ++bj) { f32x4 v0 = acc[ai][bj][m][0] * sc, v1 = acc[ai][bj][m][1] * sc; const int cw = bj ? cw1 : cw0;
                    if (cw >= 128) { const f32x4* cs = (const f32x4*)(rope + (size_t)row * 64 + (cw - 128)); rope8(v0, v1, cs[0], cs[1]); }
                    v0 = v0 * Q8_SC; v1 = v1 * Q8_SC; *(i32x2*)((unsigned char*)q + (size_t)row * 3072 + col0 + bj * HALF) = (i32x2){cvt4_fp8(v0[0], v0[1], v0[2], v0[3]), cvt4_fp8(v1[0], v1[1], v1[2], v1[3])}; } }
    }
};
struct EpiKV {
    static constexpr bool PERM = true, AFTER_DRAIN = false;
    unsigned char* vt8; const float* rss; unsigned char* k8;
    __device__ __forceinline__ void operator()(const f32x4 (&acc)[2][2][4][2], const Unit& u, int wr, int wc, int fr, int fq) const {
        const int row0 = u.pm * BM + wr * 64 + fr, dl = wc * 32 + 8 * fq;
#pragma unroll
        for (int ai = 0; ai < 2; ++ai)
#pragma unroll
            for (int m = 0; m < 4; ++m) { const int row = row0 + ai * HALF + m * 16; const float sc = (1.f / (QA_SC * WKV_SC)) / sqrtf(rss[row] * (1.f / 512.f) + RMS_EPS);
                { const f32x4 k0v = acc[ai][0][m][0] * (sc * K8_SC), k1v = acc[ai][0][m][1] * (sc * K8_SC);
                  *(i32x2*)(k8 + ((size_t)u.pn * SEQ + row) * 256 + dl) = (i32x2){cvt4_fp8(k0v[0], k0v[1], k0v[2], k0v[3]), cvt4_fp8(k1v[0], k1v[1], k1v[2], k1v[3])}; }
                const f32x4 v0 = acc[ai][1][m][0] * (sc * V8_SC), v1 = acc[ai][1][m][1] * (sc * V8_SC);
                const unsigned w0 = (unsigned)cvt4_fp8(v0[0], v0[1], v0[2], v0[3]), w1 = (unsigned)cvt4_fp8(v1[0], v1[1], v1[2], v1[3]);
                const int kt = m * 16 + fr, kk = kt & 31, pi = ((kk >> 2) & 1) * 32 + (kk & 3) + 4 * (kk >> 3) + 16 * (kt >> 5);
                unsigned char* vp = vt8 + ((size_t)u.pn * 128 + dl) * SEQ + (row & ~63) + pi;
#pragma unroll
                for (int e2 = 0; e2 < 4; ++e2) { vp[(size_t)e2 * SEQ] = (unsigned char)(w0 >> (8 * e2)); vp[(size_t)(4 + e2) * SEQ] = (unsigned char)(w1 >> (8 * e2)); } }
    }
};
template <int PASS> struct EpiY {
    static constexpr bool PERM = true, AFTER_DRAIN = false;
    bf16_t* T; const bf16_t* gate; unsigned char* T8;
    __device__ __forceinline__ void operator()(const f32x4 (&acc)[2][2][4][2], const Unit& u, int wr, int wc, int fr, int fq) const {
        const int row0 = u.pm * BM + wr * 64 + fr, col0 = u.pn * BM + wc * 32 + 8 * fq;
        constexpr float osc = PASS == 0 ? 1.f / (A_SC * W_OM_SC) : 1.f / (B_SC * W_OD_SC), tsc = T_SC;
#pragma unroll
        for (int ai = 0; ai < 2; ++ai)
#pragma unroll
            for (int m = 0; m < 4; ++m) { const int row = row0 + ai * HALF + m * 16;
#pragma unroll
                for (int bj = 0; bj < 2; ++bj) { const u32x4 gw = *(const u32x4*)(gate + (size_t)row * LDP + col0 + bj * HALF); bf16_t* tp = T + (size_t)row * 4096 + col0 + bj * HALF;
                    f32x4 v0 = acc[ai][bj][m][0] * osc, v1 = acc[ai][bj][m][1] * osc;
                    v0 = v0 * (f32x4){bflo(gw.x), bfhi(gw.x), bflo(gw.y), bfhi(gw.y)}; v1 = v1 * (f32x4){bflo(gw.z), bfhi(gw.z), bflo(gw.w), bfhi(gw.w)};
                    if (PASS == 0) { *(u32x4*)tp = pack8(v0, v1); }
                    else { const u32x4 tw = *(const u32x4*)tp; v0 = (v0 + (f32x4){bflo(tw.x), bfhi(tw.x), bflo(tw.y), bfhi(tw.y)}) * tsc; v1 = (v1 + (f32x4){bflo(tw.z), bfhi(tw.z), bflo(tw.w), bfhi(tw.w)}) * tsc;
                        *(i32x2*)(T8 + (size_t)row * 4096 + col0 + bj * HALF) = (i32x2){cvt4_fp8(v0[0], v0[1], v0[2], v0[3]), cvt4_fp8(v1[0], v1[1], v1[2], v1[3])}; } } }
    }
};
struct EpiOut {
    static constexpr bool PERM = false, AFTER_DRAIN = false;
    const float* x; const float* stats; const float* g; const float* b; float* out; float osc;
    __device__ __forceinline__ void operator()(const f32x4 (&acc)[2][2][4][2], const Unit& u, int wr, int wc, int fr, int fq) const {
        const int row0 = u.pm * BM + wr * 64 + fr, col0 = u.pn * BM + wc * 32 + 4 * fq;
#pragma unroll
        for (int bj = 0; bj < 2; ++bj)
#pragma unroll
            for (int n = 0; n < 2; ++n) { const int col = col0 + bj * HALF + n * 16; const f32x4 gv = *(const f32x4*)(g + col) * ALPHA, bv = *(const f32x4*)(b + col) * ALPHA;
#pragma unroll
                for (int ai = 0; ai < 2; ++ai)
#pragma unroll
                    for (int m = 0; m < 4; ++m) { const int row = row0 + ai * HALF + m * 16; const f32x2 st = *(const f32x2*)(stats + 2 * row);
                        const size_t off = (size_t)row * 4096 + col; const f32x4 xv = *(const f32x4*)(x + off);
                        *(f32x4*)(out + off) = ((xv - st.x) * st.y) * gv + bv + acc[ai][bj][m][n] * osc; } }
    }
};

template <class Epi, class Sched, bool ALIGN_EPI = false, bool SP2 = false, bool FP8 = false>
__device__ __forceinline__ void gemm_phase(PG8_LAS unsigned char* lds, const Gemm g, const Sched S, const Epi E) {
    const int tid = opaque_tid(), wid = __builtin_amdgcn_readfirstlane(tid >> 6), lane = tid & 63, wr = wid >> 2, wc = wid & 3, fr = lane & 15, fq = lane >> 4;
    const int K = g.K, nt = K / BK;
    unsigned voffA[2], voffB[2];
#pragma unroll
    for (int i = 0; i < 2; ++i) { int R, C; stage_rc(tid * 16 + i * 8192, R, C); const int Rb = Epi::PERM ? ((R & ~31) + perm32(R & 31)) : R;
        voffA[i] = (unsigned)(R * g.lda + C) * 2u; voffB[i] = (unsigned)(Rb * g.ldb + C) * 2u; }
    const size_t kstep = (size_t)(BK * 2);
    const size_t hstepA = (size_t)HALF * g.lda * 2, hstepB = (size_t)HALF * g.ldb * 2;
    const size_t tstepA = 2 * hstepA, tstepB = 2 * hstepB;
    const unsigned ldsw = (unsigned)wid * 1024u;
    const int aoff = lds_byte(wr * 64 + fr, fq * 8), boff = lds_byte(wc * 32 + fr, fq * 8);
#define PG8_SA(b, h) (((b) * 2 + (h)) * HTB)
#define PG8_SB(b, h) ((4 + (b) * 2 + (h)) * HTB)
#define PG8_STAGE(bufoff, gbase, voff) do { _Pragma("unroll") for (int _i = 0; _i < 2; ++_i) \
        __builtin_amdgcn_global_load_lds((const unsigned*)((const char*)(gbase) + (voff)[_i]), (PG8_LAS unsigned*)(lds + (bufoff) + ldsw + _i * 8192), 16, 0, 0); } while (0)
#define PG8_LDA(dst, b, h) do { if constexpr (FP8) { _Pragma("unroll") for (int m = 0; m < 4; ++m) dst##8[m] = cat8(*(const PG8_LAS bf16x8*)(lds + PG8_SA(b, h) + aoff + m * 2048), *(const PG8_LAS bf16x8*)(lds + PG8_SA(b, h) + aoff + m * 2048 + 1024)); } \
    else { _Pragma("unroll") for (int m = 0; m < 4; ++m) _Pragma("unroll") for (int k = 0; k < 2; ++k) dst[m][k] = *(const PG8_LAS bf16x8*)(lds + PG8_SA(b, h) + aoff + m * 2048 + k * 1024); } } while (0)
#define PG8_LDB(dst, b, h) do { if constexpr (FP8) { _Pragma("unroll") for (int n = 0; n < 2; ++n) dst##8[n] = cat8(*(const PG8_LAS bf16x8*)(lds + PG8_SB(b, h) + boff + n * 2048), *(const PG8_LAS bf16x8*)(lds + PG8_SB(b, h) + boff + n * 2048 + 1024)); } \
    else { _Pragma("unroll") for (int n = 0; n < 2; ++n) _Pragma("unroll") for (int k = 0; k < 2; ++k) dst[n][k] = *(const PG8_LAS bf16x8*)(lds + PG8_SB(b, h) + boff + n * 2048 + k * 1024); } } while (0)
#define PG8_MMA(ai, bj, At, Bt) do { __builtin_amdgcn_s_setprio(1); if constexpr (FP8) { _Pragma("unroll") for (int m = 0; m < 4; ++m) _Pragma("unroll") for (int n = 0; n < 2; ++n) \
        asm volatile("v_mfma_f32_16x16x128_f8f6f4 %0, %1, %2, %0" : "+v"(acc[ai][bj][m][n]) : "v"(Bt##8[n]), "v"(At##8[m])); } else { \
        _Pragma("unroll") for (int m = 0; m < 4; ++m) _Pragma("unroll") for (int n = 0; n < 2; ++n) _Pragma("unroll") for (int k = 0; k < 2; ++k) \
        acc[ai][bj][m][n] = __builtin_amdgcn_mfma_f32_16x16x32_bf16(Bt[n][k], At[m][k], acc[ai][bj][m][n], 0, 0, 0); } __builtin_amdgcn_s_setprio(0); } while (0)
#define PG8_WAIT_V(n) asm volatile("s_waitcnt vmcnt(" #n ")" ::: "memory")
#define PG8_WAIT_L(n) asm volatile("s_waitcnt lgkmcnt(" #n ")" ::: "memory")
#define PG8_BAR __builtin_amdgcn_s_barrier()
#define PG8_SCHED __builtin_amdgcn_sched_barrier(0)
    Unit cur, nxt; int ui = 0;
    if (!S.next(0, cur)) return;
    f32x4 acc[2][2][4][2];
#pragma unroll
    for (int a = 0; a < 2; ++a)
#pragma unroll
        for (int b = 0; b < 2; ++b)
#pragma unroll
            for (int m = 0; m < 4; ++m)
#pragma unroll
                for (int n = 0; n < 2; ++n) acc[a][b][m][n] = (f32x4){0.f, 0.f, 0.f, 0.f};
    bf16x8 At[4][2], B0[2][2], B1[2][2]; i32x8 At8[4], B08[2], B18[2];
    const char* cA = (const char*)g.A + (size_t)cur.pm * tstepA; const char* cB = (const char*)g.Bt + (size_t)cur.pn * tstepB;
    S.a_ready(cur);
    if constexpr (SP2) {
        PG8_STAGE(PG8_SB(0, 0), cB, voffB); PG8_STAGE(PG8_SB(0, 1), cB + hstepB, voffB); PG8_STAGE(PG8_SA(0, 0), cA, voffA); PG8_STAGE(PG8_SA(0, 1), cA + hstepA, voffA);
        if (wr == 1) PG8_BAR;
        PG8_WAIT_V(2); PG8_BAR;
        PG8_STAGE(PG8_SB(1, 0), cB + kstep, voffB); PG8_STAGE(PG8_SA(1, 0), cA + kstep, voffA); PG8_STAGE(PG8_SB(1, 1), cB + hstepB + kstep, voffB);
        PG8_WAIT_V(6); PG8_BAR;
    } else {
        PG8_STAGE(PG8_SB(0, 0), cB, voffB); PG8_STAGE(PG8_SA(0, 0), cA, voffA); PG8_STAGE(PG8_SB(0, 1), cB + hstepB, voffB); PG8_STAGE(PG8_SA(0, 1), cA + hstepA, voffA);
        if (wr == 1) PG8_BAR;
        PG8_WAIT_V(4); PG8_BAR;
        PG8_STAGE(PG8_SB(1, 0), cB + kstep, voffB); PG8_STAGE(PG8_SA(1, 0), cA + kstep, voffA); PG8_STAGE(PG8_SB(1, 1), cB + hstepB + kstep, voffB);
        PG8_WAIT_V(6); PG8_BAR;
    }
    for (;;) {
        const bool has_next = S.next(ui + 1, nxt);
        const char* nA = has_next ? (const char*)g.A + (size_t)nxt.pm * tstepA : cA; const char* nB = has_next ? (const char*)g.Bt + (size_t)nxt.pn * tstepB : cB;
        for (int t = 0; t < nt; t += 2) {
            const bool last = (t == nt - 2);
            const char* a1 = cA + (size_t)(t + 1) * kstep;
            const char* a2 = last ? nA : cA + (size_t)(t + 2) * kstep; const char* b2 = last ? nB : cB + (size_t)(t + 2) * kstep;
            const char* a3 = a2 + kstep; const char* b3 = b2 + kstep;
            if (last && has_next) S.a_ready(nxt);
            if constexpr (SP2) {
            PG8_LDB(B0, 0, 0); PG8_LDB(B1, 0, 1); PG8_SCHED; PG8_LDA(At, 0, 0); PG8_STAGE(PG8_SA(1, 1), a1 + hstepA, voffA);
            PG8_WAIT_V(8); PG8_WAIT_L(0); PG8_BAR; PG8_MMA(0, 0, At, B0); PG8_MMA(0, 1, At, B1); PG8_BAR; PG8_SCHED;
            PG8_LDA(At, 0, 1); PG8_STAGE(PG8_SB(0, 0), b2, voffB); PG8_STAGE(PG8_SB(0, 1), b2 + hstepB, voffB); PG8_STAGE(PG8_SA(0, 0), a2, voffA);
            PG8_WAIT_V(8); PG8_WAIT_L(0); PG8_BAR; PG8_MMA(1, 0, At, B0); PG8_MMA(1, 1, At, B1); PG8_BAR; PG8_SCHED;
            PG8_LDB(B0, 1, 0); PG8_LDB(B1, 1, 1); PG8_SCHED; PG8_LDA(At, 1, 0); PG8_STAGE(PG8_SA(0, 1), a2 + hstepA, voffA);
            PG8_WAIT_V(8); PG8_WAIT_L(0); PG8_BAR; PG8_MMA(0, 0, At, B0); PG8_MMA(0, 1, At, B1); PG8_BAR; PG8_SCHED;
            PG8_LDA(At, 1, 1); PG8_STAGE(PG8_SB(1, 0), b3, voffB); PG8_STAGE(PG8_SB(1, 1), b3 + hstepB, voffB); PG8_STAGE(PG8_SA(1, 0), a3, voffA);
            PG8_WAIT_V(8); PG8_WAIT_L(0); PG8_BAR; PG8_MMA(1, 0, At, B0); PG8_MMA(1, 1, At, B1); PG8_BAR; PG8_SCHED;
            } else {
            PG8_LDB(B0, 0, 0); PG8_SCHED; PG8_LDA(At, 0, 0); PG8_STAGE(PG8_SA(1, 1), a1 + hstepA, voffA);
            PG8_WAIT_L(8); PG8_BAR; PG8_WAIT_L(0); PG8_MMA(0, 0, At, B0); PG8_BAR; PG8_SCHED;
            PG8_LDB(B1, 0, 1); PG8_STAGE(PG8_SB(0, 0), b2, voffB);
            PG8_BAR; PG8_WAIT_L(0); PG8_MMA(0, 1, At, B1); PG8_BAR;
            PG8_LDA(At, 0, 1); PG8_STAGE(PG8_SA(0, 0), a2, voffA);
            PG8_BAR; PG8_WAIT_L(0); PG8_MMA(1, 0, At, B0); PG8_BAR; PG8_SCHED;
            PG8_STAGE(PG8_SB(0, 1), b2 + hstepB, voffB);
            PG8_WAIT_V(6); PG8_BAR; PG8_MMA(1, 1, At, B1); PG8_BAR;
            PG8_LDB(B0, 1, 0); PG8_SCHED; PG8_LDA(At, 1, 0); PG8_STAGE(PG8_SA(0, 1), a2 + hstepA, voffA);
            PG8_WAIT_L(8); PG8_BAR; PG8_WAIT_L(0); PG8_MMA(0, 0, At, B0); PG8_BAR; PG8_SCHED;
            PG8_LDB(B1, 1, 1); PG8_STAGE(PG8_SB(1, 0), b3, voffB);
            PG8_BAR; PG8_WAIT_L(0); PG8_MMA(0, 1, At, B1); PG8_BAR;
            PG8_LDA(At, 1, 1); PG8_STAGE(PG8_SA(1, 0), a3, voffA);
            PG8_BAR; PG8_WAIT_L(0); PG8_MMA(1, 0, At, B0); PG8_BAR; PG8_SCHED;
            PG8_STAGE(PG8_SB(1, 1), b3 + hstepB, voffB);
            PG8_WAIT_V(6); PG8_BAR; PG8_MMA(1, 1, At, B1); PG8_BAR;
            }
        }
        if constexpr (ALIGN_EPI) { if (wr == 0) PG8_BAR; }
        if constexpr (FP8) asm volatile("s_nop 15\n\ts_nop 15" ::: "memory");
        if constexpr (!Epi::AFTER_DRAIN) { E(acc, cur, wr, wc, fr, fq); S.done(cur); }
        if (!has_next) break;
#pragma unroll
        for (int a = 0; a < 2; ++a)
#pragma unroll
            for (int b = 0; b < 2; ++b)
#pragma unroll
                for (int m = 0; m < 4; ++m)
#pragma unroll
                    for (int n = 0; n < 2; ++n) acc[a][b][m][n] = (f32x4){0.f, 0.f, 0.f, 0.f};
        cur = nxt; cA = nA; cB = nB; ++ui;
        if constexpr (ALIGN_EPI) { if (wr == 1) PG8_BAR; }
    }
    PG8_WAIT_V(0);
    if constexpr (!ALIGN_EPI) { if (wr == 0) PG8_BAR; }
    PG8_BAR;
    if constexpr (Epi::AFTER_DRAIN) { E.fused(acc, cur, wr, wc, fr, fq, lds, wid, lane); S.done(cur); }
#undef PG8_SA
#undef PG8_SB
#undef PG8_STAGE
#undef PG8_LDA
#undef PG8_LDB
#undef PG8_MMA
#undef PG8_WAIT_V
#undef PG8_WAIT_L
#undef PG8_BAR
#undef PG8_SCHED
}
}

namespace att {
typedef unsigned short bf16_t;
using bf16x8 = __attribute__((ext_vector_type(8))) short;
using s16x4  = __attribute__((ext_vector_type(4))) short;
using f32x16 = __attribute__((ext_vector_type(16))) float;
using u32x4  = __attribute__((ext_vector_type(4))) unsigned;
constexpr int NW = 8, QBLK = 32, KVBLK = 64;
constexpr int SHM_V = 16384, SHM_KN = 16384, SHM_KP = 8192;
constexpr int OFF_V = 0, OFF_KN = 2 * SHM_V, OFF_KP = OFF_KN + 2 * SHM_KN, OFF_WS = OFF_KP + 2 * SHM_KP, OFF_BIAS = OFF_WS + NW * 64 * 4, OFF_QPE = OFF_BIAS + 1024, ATT_LDS = OFF_QPE + NW * 4096, M_QPE = 3 * 40960 + 2048;
#define KSWZ(row, colB) ((row) * 256 + ((colB) ^ (((row) & 15) << 4)))
#define KPSWZ(row, colB) ((row) * 128 + ((colB) ^ ((((row) >> 1) & 7) << 4)))
#define SBAR() __builtin_amdgcn_sched_barrier(0)
__device__ __forceinline__ int crow(int r, int hi) { return (r & 3) + 8 * (r >> 2) + 4 * hi; }
typedef float f32x2_t __attribute__((ext_vector_type(2))); typedef __bf16 bf16x2_t __attribute__((ext_vector_type(2)));
__device__ __forceinline__ unsigned cvtpk(float lo, float hi) { f32x2_t v = {lo, hi}; bf16x2_t b = __builtin_convertvector(v, bf16x2_t); return __builtin_bit_cast(unsigned, b); }
__device__ __forceinline__ bf16x8 ld8(const bf16_t* p) { return *reinterpret_cast<const bf16x8*>(p); }

template <int THR2>
__device__ __forceinline__ void partialSM(f32x16& p0, f32x16& p1, float& m_reg, float& alpha, const float C = 1.f) {
  float pmax = p0[0];
#pragma unroll
  for (int r = 1; r < 16; ++r) pmax = fmaxf(pmax, p0[r]);
#pragma unroll
  for (int r = 0; r < 16; ++r) pmax = fmaxf(pmax, p1[r]);
  { auto rr = __builtin_amdgcn_permlane32_swap(__float_as_uint(pmax), __float_as_uint(pmax), false, false);
    pmax = fmaxf(__uint_as_float(rr[0]), __uint_as_float(rr[1])) * C; }
  float mn;
  if (THR2 > 0 && __builtin_expect(__all(pmax - m_reg <= (float)THR2), 1)) { mn = m_reg; alpha = 1.f; }
  else { mn = fmaxf(m_reg, pmax); alpha = __builtin_amdgcn_exp2f(m_reg - mn); m_reg = mn; }
#pragma unroll
  for (int r = 0; r < 16; ++r) p0[r] = fmaf(p0[r], C, -mn);
#pragma unroll
  for (int r = 0; r < 16; ++r) p1[r] = fmaf(p1[r], C, -mn);
#pragma unroll
  for (int r = 0; r < 16; ++r) p0[r] = __builtin_amdgcn_exp2f(p0[r]);
}
__device__ __forceinline__ void finishSM(f32x16& p0, f32x16& p1, float alpha, float& l_reg, bf16x8& pa0, bf16x8& pa1, bf16x8& pa2, bf16x8& pa3) {
#pragma unroll
  for (int r = 0; r < 16; ++r) p1[r] = __builtin_amdgcn_exp2f(p1[r]);
  float ps = 0;
#pragma unroll
  for (int r = 0; r < 16; ++r) ps += p0[r];
#pragma unroll
  for (int r = 0; r < 16; ++r) ps += p1[r];
  { auto rr = __builtin_amdgcn_permlane32_swap(__float_as_uint(ps), __float_as_uint(ps), false, false);
    ps = __uint_as_float(rr[0]) + __uint_as_float(rr[1]); }
  l_reg = l_reg * alpha + ps;
#define PK4(P, BASE, OUT) do { unsigned a0 = cvtpk(P[BASE + 0], P[BASE + 1]), a1 = cvtpk(P[BASE + 2], P[BASE + 3]);   \
    unsigned b0 = cvtpk(P[BASE + 4], P[BASE + 5]), b1 = cvtpk(P[BASE + 6], P[BASE + 7]);                              \
    auto r0 = __builtin_amdgcn_permlane32_swap(a0, b0, false, false); auto r1 = __builtin_amdgcn_permlane32_swap(a1, b1, false, false); \
    u32x4 w = {r0[0], r1[0], r0[1], r1[1]}; OUT = *reinterpret_cast<bf16x8*>(&w); } while (0)
  PK4(p0, 0, pa0); PK4(p0, 8, pa1); PK4(p1, 0, pa2); PK4(p1, 8, pa3);
#undef PK4
}
template <int NPE>
__device__ __forceinline__ void qkt(f32x16& p0, f32x16& p1, const char* Kn, const char* Kp, const bf16x8* qr, const char* qpe, int r32, int hi) {
  p0 = f32x16{}; p1 = f32x16{};
#pragma unroll
  for (int d0 = 0; d0 < 8; ++d0) { const int cb = (d0 * 16 + hi * 8) * 2;
    bf16x8 b0 = *reinterpret_cast<const bf16x8*>(Kn + KSWZ(r32, cb));
    bf16x8 b1 = *reinterpret_cast<const bf16x8*>(Kn + KSWZ(32 + r32, cb));
    p0 = __builtin_amdgcn_mfma_f32_32x32x16_bf16(b0, qr[d0], p0, 0, 0, 0);
    p1 = __builtin_amdgcn_mfma_f32_32x32x16_bf16(b1, qr[d0], p1, 0, 0, 0); }
#pragma unroll
  for (int d0 = 0; d0 < NPE; ++d0) { const int cb = (d0 * 16 + hi * 8) * 2;
    bf16x8 b0 = *reinterpret_cast<const bf16x8*>(Kp + KPSWZ(r32, cb));
    bf16x8 b1 = *reinterpret_cast<const bf16x8*>(Kp + KPSWZ(32 + r32, cb));
    p0 = __builtin_amdgcn_mfma_f32_32x32x16_bf16(b0, qr[8 + d0], p0, 0, 0, 0);
    p1 = __builtin_amdgcn_mfma_f32_32x32x16_bf16(b1, qr[8 + d0], p1, 0, 0, 0); }
}
typedef int i32x8 __attribute__((ext_vector_type(8))); typedef int i32x4 __attribute__((ext_vector_type(4)));
__device__ __forceinline__ void qkt8(f32x16& p0, f32x16& p1, const char* K8t, const i32x8* q8, int r32, int hi) {
  p0 = f32x16{}; p1 = f32x16{};
#pragma unroll
  for (int s = 0; s < 3; ++s) { const int cb = 64 * s + 32 * hi;
    const i32x4 a0 = *reinterpret_cast<const i32x4*>(K8t + KSWZ(r32, cb)), a1 = *reinterpret_cast<const i32x4*>(K8t + KSWZ(r32, cb + 16));
    const i32x4 c0 = *reinterpret_cast<const i32x4*>(K8t + KSWZ(32 + r32, cb)), c1 = *reinterpret_cast<const i32x4*>(K8t + KSWZ(32 + r32, cb + 16));
    p0 = __builtin_amdgcn_mfma_scale_f32_32x32x64_f8f6f4(__builtin_shufflevector(a0, a1, 0, 1, 2, 3, 4, 5, 6, 7), q8[s], p0, 0, 0, 0, 0, 0, 0);
    p1 = __builtin_amdgcn_mfma_scale_f32_32x32x64_f8f6f4(__builtin_shufflevector(c0, c1, 0, 1, 2, 3, 4, 5, 6, 7), q8[s], p1, 0, 0, 0, 0, 0, 0); }
}
__device__ __forceinline__ int cvt4nc(float a, float b, float c, float d) { const int r = __builtin_amdgcn_cvt_pk_fp8_f32(a, b, 0, false); return __builtin_amdgcn_cvt_pk_fp8_f32(c, d, r, true); }
__device__ __forceinline__ void finishSM8(f32x16& p0, f32x16& p1, float alpha, float& l_reg, i32x8& pa) {
#pragma unroll
  for (int r = 0; r < 16; ++r) p1[r] = __builtin_amdgcn_exp2f(p1[r]);
  float ps = 0;
#pragma unroll
  for (int r = 0; r < 16; ++r) ps += p0[r];
#pragma unroll
  for (int r = 0; r < 16; ++r) ps += p1[r];
  { auto rr = __builtin_amdgcn_permlane32_swap(__float_as_uint(ps), __float_as_uint(ps), false, false);
    ps = __uint_as_float(rr[0]) + __uint_as_float(rr[1]); }
  l_reg = l_reg * alpha + ps;
#pragma unroll
  for (int i = 0; i < 4; ++i) { pa[i] = cvt4nc(p0[4 * i], p0[4 * i + 1], p0[4 * i + 2], p0[4 * i + 3]); pa[4 + i] = cvt4nc(p1[4 * i], p1[4 * i + 1], p1[4 * i + 2], p1[4 * i + 3]); }
}
__device__ __forceinline__ void pv8(f32x16* o, const char* VT, const i32x8 pa, int r32, int hi) {
  const int f = (r32 >> 2) & 3; const char* b = VT + r32 * 64; const int c0 = ((2 * hi) ^ f) * 16, c1 = ((2 * hi + 1) ^ f) * 16;
#pragma unroll
  for (int d0 = 0; d0 < 4; ++d0) { const i32x4 x = *reinterpret_cast<const i32x4*>(b + d0 * 2048 + c0), y = *reinterpret_cast<const i32x4*>(b + d0 * 2048 + c1);
    o[d0] = __builtin_amdgcn_mfma_scale_f32_32x32x64_f8f6f4(pa, __builtin_shufflevector(x, y, 0, 1, 2, 3, 4, 5, 6, 7), o[d0], 0, 0, 0, 0, 0, 0); }
}
__device__ __forceinline__ int v_st(int k, int c) { const int kk = (k & ~0xC) | ((k & 4) << 1) | ((k & 8) >> 1); return ((kk >> 3) * 4 + (c >> 5)) * 512 + ((kk & 7) * 32 + (c & 31)) * 2; }
__device__ __forceinline__ int v_rd_base(int lane) { return ((lane & 3) << 3) | (((lane >> 2) & 3) << 6) | (((lane >> 4) & 1) << 5) | (((lane >> 5) & 1) << 8); }
constexpr int v_rd_off(int d0, int ks, int half) { return d0 * 512 + ks * 4096 + half * 2048; }
template <int OFF> __device__ __forceinline__ s16x4 tr_read(int vb) {
  s16x4 r; asm volatile("ds_read_b64_tr_b16 %0, %1 offset:%2" : "=&v"(r) : "v"(vb), "i"(OFF) : "memory"); return r;
}
template <int D0> __device__ __forceinline__ void pv_one(f32x16& od, int vb, bf16x8 pa0, bf16x8 pa1, bf16x8 pa2, bf16x8 pa3) {
  const s16x4 l0 = tr_read<v_rd_off(D0, 0, 0)>(vb), h0 = tr_read<v_rd_off(D0, 0, 1)>(vb), l1 = tr_read<v_rd_off(D0, 1, 0)>(vb), h1 = tr_read<v_rd_off(D0, 1, 1)>(vb);
  const s16x4 l2 = tr_read<v_rd_off(D0, 2, 0)>(vb), h2 = tr_read<v_rd_off(D0, 2, 1)>(vb), l3 = tr_read<v_rd_off(D0, 3, 0)>(vb), h3 = tr_read<v_rd_off(D0, 3, 1)>(vb);
  asm volatile("s_waitcnt lgkmcnt(0)" ::: "memory"); SBAR();
#define PK(L, H) (bf16x8){L[0], L[1], L[2], L[3], H[0], H[1], H[2], H[3]}
  od = __builtin_amdgcn_mfma_f32_32x32x16_bf16(pa0, PK(l0, h0), od, 0, 0, 0);
  od = __builtin_amdgcn_mfma_f32_32x32x16_bf16(pa1, PK(l1, h1), od, 0, 0, 0);
  od = __builtin_amdgcn_mfma_f32_32x32x16_bf16(pa2, PK(l2, h2), od, 0, 0, 0);
  od = __builtin_amdgcn_mfma_f32_32x32x16_bf16(pa3, PK(l3, h3), od, 0, 0, 0);
#undef PK
}
__device__ __forceinline__ void pv_d0(f32x16* o, int vb, bf16x8 pa0, bf16x8 pa1, bf16x8 pa2, bf16x8 pa3) {
  pv_one<0>(o[0], vb, pa0, pa1, pa2, pa3); pv_one<1>(o[1], vb, pa0, pa1, pa2, pa3); pv_one<2>(o[2], vb, pa0, pa1, pa2, pa3); pv_one<3>(o[3], vb, pa0, pa1, pa2, pa3);
}
#define RESC(a) do { if (__any((a) < 1.f)) { if (hi == 0) al_l[r32] = (a); asm volatile("s_waitcnt lgkmcnt(0)" ::: "memory"); \
    _Pragma("unroll") for (int d = 0; d < 4; ++d) _Pragma("unroll") for (int r = 0; r < 16; ++r) o[d][r] *= al_l[crow(r, hi)]; } } while (0)

#define LAS3 __attribute__((address_space(3)))
__device__ __forceinline__ void mla_unit(const bf16_t* __restrict__ Qb, const bf16_t* __restrict__ Kh, const bf16_t* __restrict__ Vh, const bf16_t* __restrict__ Kpe,
                                         const bf16_t* __restrict__ Gb, bf16_t* __restrict__ Ob, char* lds, LAS3 unsigned char* ldsl) {
  constexpr int LDQ = 3072, LDK = 4096, LDO = 2048, NT = SEQ / KVBLK; constexpr float QKC = 1.f / (Q8_SC * K8_SC);
  constexpr int STG = 24576, O_V = 0, O_KN = 8192, M_WS = 3 * STG;
  const int tid = opaque_tid(), wid = __builtin_amdgcn_readfirstlane(tid >> 6), lane = tid & 63, r32 = lane & 31, hi = lane >> 5;
  float* ws = (float*)(lds + M_WS) + wid * 64; float* li_l = ws; float* al_l = ws + 32;
  float m_reg = -1e30f, l_reg = 0; f32x16 o[4] = {}; i32x8 q8[3];
  { const unsigned char* Qw = (const unsigned char*)Qb + (long)(wid * QBLK + r32) * LDQ + hi * 32;
#pragma unroll
    for (int s = 0; s < 3; ++s) { const i32x4 a = *reinterpret_cast<const i32x4*>(Qw + 64 * s), b = *reinterpret_cast<const i32x4*>(Qw + 64 * s + 16); q8[s] = __builtin_shufflevector(a, b, 0, 1, 2, 3, 4, 5, 6, 7); } }
  asm volatile("s_waitcnt vmcnt(0)" ::: "memory"); SBAR();
  int vsrc, ksrc[2];
#pragma unroll
  for (int i = 0; i < 2; ++i) { const int c = wid + 8 * i;
    { const int row = c * 4 + (lane >> 4), colB = ((lane & 15) * 16) ^ ((row & 15) << 4); ksrc[i] = row * 256 + colB; } }
  { const int row = wid * 16 + (lane >> 2), ch = (lane & 3) ^ ((row >> 2) & 3); vsrc = row * SEQ + ch * 16; }
#define DMA16(gptr, ldsoff) __builtin_amdgcn_global_load_lds((const unsigned*)(gptr), (LAS3 unsigned*)(ldsl + (ldsoff)), 16, 0, 0)
#define ISSUE_K(t, s) do { const unsigned char* kb_ = (const unsigned char*)Kh + (long)(t) * (KVBLK * 256); DMA16(kb_ + ksrc[0], (s) * STG + O_KN + wid * 1024); DMA16(kb_ + ksrc[1], (s) * STG + O_KN + (wid + 8) * 1024); } while (0)
#define ISSUE_V(t, s) do { DMA16((const unsigned char*)Vh + (long)(t) * KVBLK + vsrc, (s) * STG + O_V + wid * 1024); } while (0)
#define WAITBAR(N) do { asm volatile("s_waitcnt vmcnt(" #N ") lgkmcnt(0)" ::: "memory"); __builtin_amdgcn_s_barrier(); asm volatile("" ::: "memory"); } while (0)
  f32x16 pA0, pA1, pB0, pB1; float alA, alB; i32x8 pa;
  int s0 = 0, s1 = 1, s2 = 2;
#define ROT() do { const int t_ = s0; s0 = s1; s1 = s2; s2 = t_; } while (0)
  ISSUE_K(0, 0); ISSUE_V(0, 0); ISSUE_K(1, 1);
  WAITBAR(2);
  ISSUE_K(2, s2); ISSUE_V(1, s1);
  qkt8(pA0, pA1, lds + s0 * STG + O_KN, q8, r32, hi); partialSM<8>(pA0, pA1, m_reg, alA, QKC);
  WAITBAR(3); ROT();
#define STEP(PX0, PX1, ALX, PY0, PY1, ALY, j_) do { const bool ik_ = (j_) + 2 < NT, iv_ = (j_) + 1 < NT; \
    if (ik_) ISSUE_K((j_) + 2, s2); if (iv_) ISSUE_V((j_) + 1, s1); \
    SBAR(); qkt8(PX0, PX1, lds + s0 * STG + O_KN, q8, r32, hi); \
    finishSM8(PY0, PY1, ALY, l_reg, pa); SBAR(); \
    pv8(o, lds + s2 * STG + O_V, pa, r32, hi); partialSM<8>(PX0, PX1, m_reg, ALX, QKC); \
    RESC(ALX); \
    if (ik_) WAITBAR(3); else WAITBAR(0); ROT(); } while (0)
  for (int j = 1; j + 1 < NT; j += 2) {
    STEP(pB0, pB1, alB, pA0, pA1, alA, j);
    STEP(pA0, pA1, alA, pB0, pB1, alB, j + 1);
  }
  STEP(pB0, pB1, alB, pA0, pA1, alA, NT - 1);
  finishSM8(pB0, pB1, alB, l_reg, pa); SBAR();
  pv8(o, lds + s2 * STG + O_V, pa, r32, hi);
  if (hi == 0) li_l[r32] = l_reg; asm volatile("s_waitcnt lgkmcnt(0)" ::: "memory");
  float rli[16];
#pragma unroll
  for (int r = 0; r < 16; ++r) rli[r] = __builtin_amdgcn_rcpf(li_l[crow(r, hi)]) * (1.f / V8_SC);
  __syncthreads();
  const bf16_t* Gw = Gb + (long)(wid * QBLK) * LDP;
  { bf16_t* stg = (bf16_t*)(lds + wid * 8704);
#pragma unroll
    for (int r = 0; r < 16; ++r) { const int orow = crow(r, hi);
#pragma unroll
      for (int d0 = 0; d0 < 4; ++d0) { const float ov = o[d0][r] * rli[r]; stg[orow * 136 + d0 * 32 + r32] = (bf16_t)(cvtpk(ov, ov) & 0xffffu); } }
    asm volatile("s_waitcnt lgkmcnt(0)" ::: "memory");
    int lz = lane; asm volatile("" : "+v"(lz));
#pragma unroll
    for (int i = 0; i < 8; ++i) { const int id = i * 64 + lz, row = id >> 4, c = (id & 15) * 8;
      const u32x4 ov = *(const u32x4*)(stg + row * 136 + c); const u32x4 gv = *(const u32x4*)(Gw + (long)row * LDP + c);
#define PLO(k) (__uint_as_float(ov[k] << 16) * __uint_as_float(gv[k] << 16) * A_SC)
#define PHI(k) (__uint_as_float(ov[k] & 0xffff0000u) * __uint_as_float(gv[k] & 0xffff0000u) * A_SC)
      typedef int i32x2 __attribute__((ext_vector_type(2)));
      *(i32x2*)((unsigned char*)Ob + (long)(wid * QBLK + row) * LDO + c) = (i32x2){pg8::cvt4_fp8(PLO(0), PHI(0), PLO(1), PHI(1)), pg8::cvt4_fp8(PLO(2), PHI(2), PLO(3), PHI(3))}; } }
#undef PLO
#undef PHI
  __syncthreads();
#undef DMA16
#undef ISSUE_K
#undef ISSUE_V
#undef WAITBAR
#undef ROT
#undef STEP
}

__device__ __forceinline__ void dswa_unit(int H, int rs, int qb, const bf16_t* __restrict__ proj, const float* __restrict__ bias2, bf16_t* __restrict__ Od, float* __restrict__ lse, char* lds) {
  const int g = H >> 3, dil = 1 << (2 * g), L = SEQ / dil, Q0 = qb * 256, T0 = Q0 - 64;
  const int tid = opaque_tid(), wid = tid >> 6, lane = tid & 63, r32 = lane & 31, hi = lane >> 5;
  char* V_lds = lds + OFF_V; char* Kn_lds = lds + OFF_KN;
  float* ws = (float*)(lds + OFF_WS) + wid * 64; float* li_l = ws; float* al_l = ws + 32;
  float* bl = (float*)(lds + OFF_BIAS);
  const bf16_t* Qp = proj + C_DQ + H * 128; const bf16_t* Kp = proj + C_DK + H * 128; const bf16_t* Vp = proj + C_DV + H * 128;
  if (tid < 352) { const int dj = tid - 176; bl[tid] = (dj >= -64 && dj <= 64) ? bias2[(g * 8 + (H & 7)) * 129 + dj + 64] : -1e30f; }
  const int qa = Q0 + wid * QBLK, qi = qa + r32;
  bf16x8 qr[8];
  { const bf16_t* Qw = Qp + (size_t)(qi * dil + rs) * LDP + hi * 8;
#pragma unroll
    for (int d0 = 0; d0 < 8; ++d0) qr[d0] = ld8(Qw + d0 * 16); }
  const int sr = tid >> 4, sc = (tid & 15) * 8, vst0 = v_st(sr, sc), vst1 = v_st(32 + sr, sc);
  const int vb0 = (int)(uintptr_t)V_lds + v_rd_base(lane);
  float m_reg = -1e29f, l_reg = 0.f; f32x16 o[4] = {};
  const int tlo = (Q0 == 0) ? 1 : 0, thi = (Q0 + 256 >= L) ? 5 : 6;
  bf16x8 vs0, vs1, ks0, ks1;
#define DLOAD(t_) do { const int k0_ = T0 + 64 * (t_); int i0 = k0_ + sr, i1 = k0_ + 32 + sr; i0 = i0 < 0 ? 0 : (i0 >= L ? L - 1 : i0); i1 = i1 < 0 ? 0 : (i1 >= L ? L - 1 : i1); \
    const size_t o0 = (size_t)(i0 * dil + rs) * LDP + sc, o1 = (size_t)(i1 * dil + rs) * LDP + sc; vs0 = ld8(Vp + o0); vs1 = ld8(Vp + o1); ks0 = ld8(Kp + o0); ks1 = ld8(Kp + o1); } while (0)
  DLOAD(tlo);
  for (int t = tlo; t < thi; ++t) {
    const int k0 = T0 + 64 * t;
    __syncthreads();
    *(bf16x8*)(V_lds + vst0) = vs0; *(bf16x8*)(V_lds + vst1) = vs1;
    *(bf16x8*)(Kn_lds + KSWZ(sr, sc * 2)) = ks0; *(bf16x8*)(Kn_lds + KSWZ(32 + sr, sc * 2)) = ks1;
    __syncthreads();
    if (t + 1 < thi) DLOAD(t + 1);
    if (k0 > qa + 31 + 64 || k0 + 63 < qa - 64) continue;
    f32x16 p0, p1; qkt<0>(p0, p1, Kn_lds, Kn_lds, qr, Kn_lds, r32, hi);
    if (k0 >= 0 && k0 + 63 < L) {
      const float* bp = bl + (k0 - qi + 4 * hi + 176);
#pragma unroll
      for (int r = 0; r < 16; ++r) { p0[r] += bp[(r & 3) + 8 * (r >> 2)]; p1[r] += bp[32 + (r & 3) + 8 * (r >> 2)]; }
    } else {
#pragma unroll
      for (int r = 0; r < 16; ++r) { const int kj = k0 + crow(r, hi), dj = kj - qi, kj1 = kj + 32, dj1 = dj + 32;
        const bool ok0 = (kj >= 0) && (kj < L), ok1 = (kj1 >= 0) && (kj1 < L);
        p0[r] = ok0 ? p0[r] + bl[dj + 176] : -1e30f; p1[r] = ok1 ? p1[r] + bl[dj1 + 176] : -1e30f; }
    }
    float al; partialSM<0>(p0, p1, m_reg, al);
    bf16x8 pa0, pa1, pa2, pa3; finishSM(p0, p1, al, l_reg, pa0, pa1, pa2, pa3);
    RESC(al);
    SBAR(); pv_d0(o, vb0, pa0, pa1, pa2, pa3);
  }
#undef DLOAD
  if (hi == 0) li_l[r32] = l_reg; asm volatile("s_waitcnt lgkmcnt(0)" ::: "memory");
  float rli[16];
#pragma unroll
  for (int r = 0; r < 16; ++r) rli[r] = __builtin_amdgcn_rcpf(li_l[crow(r, hi)]);
  const int hh = H & 7;
  bf16_t* Og = Od + (size_t)g * SEQ * 1024 + hh * 128;
#pragma unroll
  for (int r = 0; r < 16; ++r) { const size_t pos = (size_t)(qa + crow(r, hi)) * dil + rs;
#pragma unroll
    for (int d0 = 0; d0 < 4; ++d0) { const float ov = o[d0][r] * rli[r]; Og[pos * 1024 + d0 * 32 + r32] = (bf16_t)(cvtpk(ov, ov) & 0xffffu); } }
  if (hi == 0) lse[((size_t)g * SEQ + (size_t)qi * dil + rs) * 8 + hh] = m_reg + __builtin_amdgcn_logf(l_reg);
  __syncthreads();
}
#undef RESC
#undef KSWZ
#undef KPSWZ
#undef SBAR
}

#define LAS __attribute__((address_space(3)))
typedef unsigned short bf16;
typedef unsigned v4u __attribute__((ext_vector_type(4)));
typedef float f32x4 __attribute__((ext_vector_type(4)));
constexpr int NWAVES = 8;
constexpr size_t MiB = 1u << 20;
constexpr size_t WS_RSSQ = 0, WS_RSSKV = 32768, WS_STATS = 65536, WS_BIAS2 = 131072, WS_LSE = 262144;
constexpr size_t WS_ROPE = 2 * MiB;
constexpr size_t WS_WIN = 4 * MiB, WS_WQB = 178 * MiB, WS_WKVB = 184 * MiB, WS_WOMLA = 188 * MiB, WS_WODSWA = 204 * MiB, WS_WOUT = 212 * MiB;
constexpr size_t WS_H = 244 * MiB, WS_PROJ = 308 * MiB, WS_QMLA = 656 * MiB, WS_KVMLA = 704 * MiB, WS_KPE = 768 * MiB, WS_AMLA = 770 * MiB;
constexpr size_t WS_ODSWA = 802 * MiB, WS_BDSWA = 850 * MiB, WS_T = 866 * MiB, WS_K8 = 930 * MiB, WS_END = 962 * MiB;
static_assert(WS_WIN + (size_t)LDP * 4096 * 2 <= WS_WQB && WS_PROJ + (size_t)SEQ * LDP * 2 <= WS_QMLA && WS_LSE + 3 * SEQ * 8 * 4 <= WS_ROPE, "d_ws map");
constexpr int LDS_BYTES = 163840; constexpr int LDS_XB = 163840 - 64;
constexpr size_t WS_XBAR = 1 * MiB;

__device__ __forceinline__ unsigned f2bf(float f) { unsigned u = __builtin_bit_cast(unsigned, f); return (u + 0x7fffu + ((u >> 16) & 1u)) >> 16; }
__device__ __forceinline__ unsigned pk2(float lo, float hi) { return f2bf(lo) | (f2bf(hi) << 16); }
__device__ __forceinline__ float wave_sum(float v) {
#pragma unroll
    for (int o = 1; o < 64; o <<= 1) v += __shfl_xor(v, o);
    return v;
}
__device__ __forceinline__ void transpose_item(const float* __restrict__ W, int K, int N, bf16* __restrict__ WT, int k0, int n0, int dbase, int dstride, const float* __restrict__ kscale, LAS float* scr, int lane) {
    float wv[32];
#pragma unroll
    for (int i = 0; i < 32; ++i) { const int kk = 2 * i + (lane >> 5); wv[i] = __builtin_nontemporal_load(W + (size_t)(k0 + kk) * N + n0 + (lane & 31)); }
#pragma unroll
    for (int i = 0; i < 32; ++i) { const int kk = 2 * i + (lane >> 5); float w = wv[i]; if (kscale) w *= kscale[k0 + kk]; scr[kk * 33 + (lane & 31)] = w; }
    asm volatile("s_waitcnt lgkmcnt(0)" ::: "memory");
    const int c = lane & 7;
#pragma unroll
    for (int j = 0; j < 4; ++j) { const int n = (lane >> 3) + 8 * j; const LAS float* s = scr + (8 * c) * 33 + n;
        v4u o; o.x = pk2(s[0 * 33], s[1 * 33]); o.y = pk2(s[2 * 33], s[3 * 33]); o.z = pk2(s[4 * 33], s[5 * 33]); o.w = pk2(s[6 * 33], s[7 * 33]);
        *(v4u*)(WT + (size_t)(dbase + dstride * n) * K + k0 + 8 * c) = o; }
    asm volatile("s_waitcnt lgkmcnt(0)" ::: "memory");
}

#define XB_TMO      128
#define XB_XCNT(j)  (256  + 64 * (j))
#define XB_XSUB(j)  (1280 + 64 * (j))
#define XB_XGEN(j)  (2304 + 64 * (j))
#define XB_TOP      3328
#define XB_TOPGEN   3392
#define XCD_BAR_WORDS 3456
#define XB_SPIN_CAP (1u << 18)

__device__ __forceinline__ unsigned xb_ld(unsigned* p)              { return __hip_atomic_load(p, __ATOMIC_RELAXED, __HIP_MEMORY_SCOPE_AGENT); }
__device__ __forceinline__ unsigned xb_add(unsigned* p, unsigned v) { return __hip_atomic_fetch_add(p, v, __ATOMIC_RELAXED, __HIP_MEMORY_SCOPE_AGENT); }
__device__ __forceinline__ unsigned xb_xcc_id() { return (unsigned)__builtin_amdgcn_s_getreg((3 << 11) | 20) & 0xFu; }
#define XB_SPIN(cond, bar) do { unsigned _sp = 0; while (cond) { __builtin_amdgcn_s_sleep(1); \
    if ((++_sp & 255u) == 0u) { if (xb_ld(&(bar)[XB_TMO])) break; if (_sp > XB_SPIN_CAP) { atomicAdd(&(bar)[XB_TMO], 1u); break; } } } } while (0)

struct XcdBarrier {
    unsigned* bar; unsigned x;
    volatile LAS unsigned* st;
};

__device__ __forceinline__ XcdBarrier xcd_barrier_post(unsigned* bar, volatile LAS unsigned* st) {
    XcdBarrier b; b.bar = bar; b.x = xb_xcc_id(); b.st = st;
    if (threadIdx.x == 0) (void)xb_add(&bar[XB_XCNT(b.x)], 1u);
    return b;
}
__device__ __forceinline__ void xcd_barrier_complete(unsigned* bar, unsigned x, unsigned& nloc, unsigned& nx) {
    const unsigned G = gridDim.x * gridDim.y * gridDim.z;
    unsigned sum, cnt, mine, sp = 0u;
    for (;;) {
        sum = 0u; cnt = 0u; mine = 0u;
#pragma unroll
        for (unsigned j = 0; j < 16; ++j) { const unsigned c = xb_ld(&bar[XB_XCNT(j)]); sum += c; cnt += (c > 0u) ? 1u : 0u; mine = (j == x) ? c : mine; }
        if (sum == G) break;
        __builtin_amdgcn_s_sleep(1);
        if ((++sp & 255u) == 0u) { if (xb_ld(&bar[XB_TMO])) break; if (sp > XB_SPIN_CAP) { atomicAdd(&bar[XB_TMO], 1u); break; } }
    }
    nloc = mine > 0u ? mine : 1u; nx = cnt > 0u ? cnt : 1u;
}

__device__ __forceinline__ void xcd_barrier(const XcdBarrier& b) {
    asm volatile("s_waitcnt vmcnt(0)" ::: "memory");
    __syncthreads();
    if (threadIdx.x == 0) {
        unsigned* bar = b.bar;
        __builtin_amdgcn_s_waitcnt(0);
        unsigned nloc = b.st[0], nx = b.st[1];
        if (nloc == 0u) { xcd_barrier_complete(bar, b.x, nloc, nx); b.st[0] = nloc; b.st[1] = nx; }
        const unsigned old = xb_add(&bar[XB_XSUB(b.x)], 1u);
        const unsigned gen = old / nloc;
        if (old + 1u == (gen + 1u) * nloc) {
            __builtin_amdgcn_fence(__ATOMIC_RELEASE, "agent");
            asm volatile("s_waitcnt vmcnt(0)" ::: "memory");
            const unsigned og = xb_add(&bar[XB_TOP], 1u);
            const unsigned tg = og / nx;
            if (og + 1u == (tg + 1u) * nx) xb_add(&bar[XB_TOPGEN], 1u);
            else XB_SPIN(xb_ld(&bar[XB_TOPGEN]) == tg, bar);
            __builtin_amdgcn_fence(__ATOMIC_ACQUIRE, "agent");
            xb_add(&bar[XB_XGEN(b.x)], 1u);
            asm volatile("s_waitcnt vmcnt(0)" ::: "memory");
        } else {
            XB_SPIN(xb_ld(&bar[XB_XGEN(b.x)]) == gen, bar);
            __builtin_amdgcn_fence(__ATOMIC_ACQUIRE, "agent");
            asm volatile("s_waitcnt vmcnt(0)" ::: "memory");
        }
    }
    __syncthreads();
}

#define REP0 1
#define REP1 1
#define REP2 1
#define REP3 1
#define REP4 1
#define REP5 1
__device__ __forceinline__ void transpose_item8(const float* __restrict__ W, int K, int N, unsigned char* __restrict__ WT, int k0, int n0, int dbase, int dstride, float wsc, const float* __restrict__ kscale, LAS float* scr, int lane) {
    float wv[32];
#pragma unroll
    for (int i = 0; i < 32; ++i) { const int kk = 2 * i + (lane >> 5); wv[i] = __builtin_nontemporal_load(W + (size_t)(k0 + kk) * N + n0 + (lane & 31)); }
#pragma unroll
    for (int i = 0; i < 32; ++i) { const int kk = 2 * i + (lane >> 5); scr[kk * 33 + (lane & 31)] = wv[i] * (kscale ? wsc * kscale[k0 + kk] : wsc); }
    asm volatile("s_waitcnt lgkmcnt(0)" ::: "memory");
    const int c = lane & 7;
#pragma unroll
    for (int j = 0; j < 4; ++j) { const int n = (lane >> 3) + 8 * j; const LAS float* s = scr + (8 * c) * 33 + n;
        int d0 = __builtin_amdgcn_cvt_pk_fp8_f32(s[0 * 33], s[1 * 33], 0, false); d0 = __builtin_amdgcn_cvt_pk_fp8_f32(s[2 * 33], s[3 * 33], d0, true);
        int d1 = __builtin_amdgcn_cvt_pk_fp8_f32(s[4 * 33], s[5 * 33], 0, false); d1 = __builtin_amdgcn_cvt_pk_fp8_f32(s[6 * 33], s[7 * 33], d1, true);
        typedef int i32x2 __attribute__((ext_vector_type(2)));
        *(i32x2*)(WT + (size_t)(dbase + dstride * n) * K + k0 + 8 * c) = (i32x2){d0, d1}; }
    asm volatile("s_waitcnt lgkmcnt(0)" ::: "memory");
}
__device__ __forceinline__ void transpose_item8t(const float* __restrict__ W, int K, int N, unsigned char* __restrict__ WT, int k0, int n0, int drow0, float wsc, LAS float* scr, int lane) {
#pragma unroll
    for (int b = 0; b < 2; ++b) { float wv[32];
#pragma unroll
        for (int i = 0; i < 32; ++i) { const int kk = 64 * b + 2 * i + (lane >> 5); wv[i] = __builtin_nontemporal_load(W + (size_t)(k0 + kk) * N + n0 + (lane & 31)); }
#pragma unroll
        for (int i = 0; i < 32; ++i) { const int kk = 64 * b + 2 * i + (lane >> 5); scr[kk * 33 + (lane & 31)] = wv[i] * wsc; } }
    asm volatile("s_waitcnt lgkmcnt(0)" ::: "memory");
    const int c = lane & 7;
#pragma unroll
    for (int j = 0; j < 4; ++j) { const int n = (lane >> 3) + 8 * j; const LAS float* s = scr + (16 * c) * 33 + n; typedef int i32x4v __attribute__((ext_vector_type(4))); i32x4v o;
#pragma unroll
        for (int q = 0; q < 4; ++q) { int d = __builtin_amdgcn_cvt_pk_fp8_f32(s[(4 * q) * 33], s[(4 * q + 1) * 33], 0, false); o[q] = __builtin_amdgcn_cvt_pk_fp8_f32(s[(4 * q + 2) * 33], s[(4 * q + 3) * 33], d, true); }
        *(i32x4v*)(WT + (size_t)(drow0 + n) * K + k0 + 16 * c) = o; }
    asm volatile("s_waitcnt lgkmcnt(0)" ::: "memory");
}
struct Args { const float* in[14]; float* out; unsigned char* ws; };

__global__ void __launch_bounds__(NWAVES * 64, 2) fwd_mega(Args a) {
    extern __shared__ __attribute__((aligned(16))) unsigned char lds[];
    cg::grid_group grid = cg::this_grid();
    const int G = gridDim.x, bx = blockIdx.x, vcu = (G % 8 == 0) ? (bx % 8) * (G / 8) + bx / 8 : bx;
    LAS unsigned char* ldsl = (LAS unsigned char*)lds;
    unsigned char* ws = a.ws;
    const float* x = a.in[0]; const float* emb_g = a.in[1]; const float* emb_b = a.in[2]; const float* rel_bias = a.in[3]; const float* w_in = a.in[4];
    const float* qa_g = a.in[5]; const float* w_qb = a.in[6]; const float* kva_g = a.in[7]; const float* w_kvb = a.in[8]; const float* w_omla = a.in[9];
    const float* w_odswa = a.in[10]; const float* w_out = a.in[11]; const float* ln_g = a.in[12]; const float* ln_b = a.in[13];
    float* rss_q = (float*)(ws + WS_RSSQ); float* rss_kv = (float*)(ws + WS_RSSKV); float* stats = (float*)(ws + WS_STATS); float* bias2 = (float*)(ws + WS_BIAS2);
    float* lse = (float*)(ws + WS_LSE); float* rope = (float*)(ws + WS_ROPE);
    bf16* Win_t = (bf16*)(ws + WS_WIN); bf16* Wqb_t = (bf16*)(ws + WS_WQB); bf16* Wkvb_t = (bf16*)(ws + WS_WKVB); bf16* Womla_t = (bf16*)(ws + WS_WOMLA);
    bf16* Wodswa_t = (bf16*)(ws + WS_WODSWA); bf16* Wout_t = (bf16*)(ws + WS_WOUT);
    bf16* Hb = (bf16*)(ws + WS_H); bf16* proj = (bf16*)(ws + WS_PROJ); bf16* Qmla = (bf16*)(ws + WS_QMLA); bf16* KVmla = (bf16*)(ws + WS_KVMLA); bf16* Kpe = (bf16*)(ws + WS_K8);
    bf16* Amla = (bf16*)(ws + WS_AMLA); bf16* Odswa = (bf16*)(ws + WS_ODSWA); bf16* Bdswa = (bf16*)(ws + WS_BDSWA); bf16* Tm = (bf16*)(ws + WS_T); unsigned char* T8 = ws + WS_H + 32 * MiB;
    const int NGW = G * NWAVES, NGT = G * NWAVES * 64;
    volatile LAS unsigned* xb_st = (volatile LAS unsigned*)(ldsl + LDS_XB);
    if (threadIdx.x < 2) xb_st[threadIdx.x] = 0u;
    __syncthreads();
    const XcdBarrier xbar = xcd_barrier_post((unsigned*)(ws + WS_XBAR), xb_st);
    if (a.out == nullptr) grid.sync();
#define PHASE_IDS() const int tid = opaque_tid(), lane = tid & 63, wave = __builtin_amdgcn_readfirstlane(tid >> 6), gw = vcu * NWAVES + wave, gt = bx * (NWAVES * 64) + tid; (void)lane; (void)gw; (void)gt

    for (int rep = 0; rep < REP0; ++rep) {
        PHASE_IDS();
        LAS float* scr = (LAS float*)(ldsl + wave * 18432);
        constexpr int I_IN = 32 * 690, I_QB = 16 * 96, I_KVB = 8 * 128, I_OM = 16 * 128, I_OD = 8 * 128, I_OUT = 32 * 128;
        constexpr int NITEMS = I_IN + I_QB + I_KVB + I_OM + I_OD + I_OUT;
        for (int it = gw; it < NITEMS; it += NGW) {
            int r = it;
            if (r < I_IN) { const int kb = r / 690, nb = r % 690;
                if (nb == 48 || nb == 49) { transpose_item8(w_in, 4096, IN_W, (unsigned char*)Win_t, kb * 128, nb * 32, C_KPE + (nb - 48), 2, W_SC, nullptr, scr, lane); transpose_item8(w_in, 4096, IN_W, (unsigned char*)Win_t, kb * 128 + 64, nb * 32, C_KPE + (nb - 48), 2, W_SC, nullptr, scr, lane); }
                else transpose_item8t(w_in, 4096, IN_W, (unsigned char*)Win_t, kb * 128, nb * 32, nb < 48 ? nb * 32 : nb * 32 - 64, W_SC, scr, lane);
                continue; } r -= I_IN;
            if (r < I_QB) { const int kb = r / 96, nb = r % 96, hq = nb / 6, bi = nb % 6; int db, ds; if (bi < 4) { db = hq * 192 + bi * 32; ds = 1; } else { db = hq * 192 + 128 + (bi - 4); ds = 2; }
                transpose_item8(w_qb, 1024, 3072, (unsigned char*)Wqb_t, kb * 64, nb * 32, db, ds, WQ_SC, qa_g, scr, lane); continue; } r -= I_QB;
            if (r < I_KVB) { const int kb = r / 128, nb = r % 128; transpose_item8(w_kvb, 512, 4096, (unsigned char*)Wkvb_t, kb * 64, nb * 32, nb * 32, 1, WKV_SC, kva_g, scr, lane); continue; } r -= I_KVB;
            if (r < I_OM) { const int kb = r / 128, nb = r % 128; transpose_item8t(w_omla, 2048, 4096, (unsigned char*)Womla_t, kb * 128, nb * 32, nb * 32, W_OM_SC, scr, lane); continue; } r -= I_OM;
            if (r < I_OD) { const int kb = r / 128, nb = r % 128; transpose_item8t(w_odswa, 1024, 4096, (unsigned char*)Wodswa_t, kb * 128, nb * 32, nb * 32, W_OD_SC, scr, lane); continue; } r -= I_OD;
            { const int kb = r / 128, nb = r % 128; transpose_item8t(w_out, 4096, 4096, (unsigned char*)Wout_t, kb * 128, nb * 32, nb * 32, W_OUT_SC, scr, lane); }
        }
        for (int m = gw; m < SEQ; m += NGW) {
            const f32x4* xr = (const f32x4*)(x + (size_t)m * DM) + lane;
            f32x4 v[16]; float s = 0.f;
#pragma unroll
            for (int j = 0; j < 16; ++j) { v[j] = xr[64 * j]; s += (v[j].x + v[j].y) + (v[j].z + v[j].w); }
            const float mean = wave_sum(s) * (1.f / DM); float s2 = 0.f;
#pragma unroll
            for (int j = 0; j < 16; ++j) { v[j] = v[j] - mean; s2 += (v[j].x * v[j].x + v[j].y * v[j].y) + (v[j].z * v[j].z + v[j].w * v[j].w); }
            const float rstd = 1.f / sqrtf(wave_sum(s2) * (1.f / DM) + LN_EPS);
            if (lane == 0) { stats[2 * m] = mean; stats[2 * m + 1] = rstd; }
            int* o4 = (int*)((unsigned char*)Hb + (size_t)m * DM) + lane;
#pragma unroll
            for (int j = 0; j < 16; ++j) { const f32x4 gv = ((const f32x4*)emb_g)[64 * j + lane], bv = ((const f32x4*)emb_b)[64 * j + lane]; const f32x4 y = (v[j] * rstd * gv + bv) * H_SC;
                int d = __builtin_amdgcn_cvt_pk_fp8_f32(y.x, y.y, 0, false); d = __builtin_amdgcn_cvt_pk_fp8_f32(y.z, y.w, d, true); o4[64 * j] = d; }
        }
        for (int e = gt; e < SEQ * 32; e += NGT) { const int pos = e >> 5, i = e & 31; const float invf = 1.0f / powf(10000.0f, (float)(2 * i) / 64.0f); const float ang = (float)pos * invf;
            double t = (double)ang * 0.15915494309189535; t -= __builtin_floor(t); const float tf = (float)t;
            rope[2 * e] = __builtin_amdgcn_cosf(tf); rope[2 * e + 1] = __builtin_amdgcn_sinf(tf); }
        for (int e = gt; e < 3 * 8 * 129; e += NGT) { const int j = e % 129 - 64, hh = (e / 129) % 8, g = e / (129 * 8), dil = 1 << (2 * g); const int rel = j * dil, n = rel < 0 ? -rel : rel;
            int bk; if (n < 8) bk = n; else { const float nf = (float)n; int lg = 8 + (int)(logf(nf / 8.f) / 4.852030263919617f * 8.f); bk = lg < 15 ? lg : 15; }
            if (rel > 0) bk += 16;
            bias2[e] = rel_bias[bk * 24 + g * 8 + hh] * LOG2E; }
        for (int e = gt; e < 2 * SEQ; e += NGT) rss_q[e] = 0.f;
    }
    xcd_barrier(xbar);

    for (int rep = 0; rep < REP1; ++rep) {
        pg8::Gemm g{Hb, Win_t, SEQ, LDP, 2048, 2048, 2048}; pg8::StaticOrder S; S.init(SEQ, LDP, G, bx);
        pg8::EpiProj E{proj, Kpe, rep ? nullptr : rss_q, rep ? nullptr : rss_kv, rope, (unsigned char*)Qmla + 24 * MiB};
        pg8::gemm_phase<pg8::EpiProj, pg8::StaticOrder, true, true, true>(ldsl, g, S, E);
    }
    xcd_barrier(xbar);

    for (int rep = 0; rep < REP2; ++rep) {
        { pg8::Gemm g{(const bf16*)((const unsigned char*)Qmla + 24 * MiB), Wqb_t, SEQ, 3072, 512, 768, 512}; pg8::StaticOrder S; S.init(SEQ, 3072, G, bx);
          pg8::EpiQ E{Qmla, rss_q, rope}; pg8::gemm_phase<pg8::EpiQ, pg8::StaticOrder, true, true, true>(ldsl, g, S, E); }
        { pg8::Gemm g{(const bf16*)((const unsigned char*)Qmla + 24 * MiB + 1024), Wkvb_t, SEQ, 4096, 256, 768, 256}; pg8::StaticOrder S; S.init(SEQ, 4096, G, bx);
          pg8::EpiKV E{(unsigned char*)KVmla  , rss_kv, (unsigned char*)Kpe}; pg8::gemm_phase<pg8::EpiKV, pg8::StaticOrder, true, true, true>(ldsl, g, S, E); }
        __syncthreads();
        for (int u = vcu; u < 768; u += G) { const int H = u >> 5, rem = u & 31, g = H >> 3, nqb = 32 >> (2 * g); att::dswa_unit(H, rem / nqb, rem % nqb, proj, bias2, Odswa, lse, (char*)lds); }
    }
    xcd_barrier(xbar);

    for (int rep = 0; rep < REP3; ++rep) {
        for (int u = vcu; u < 512; u += G) { const int h = u >> 5, qb = u & 31; const size_t r0 = (size_t)qb * 256;
            att::mla_unit((const bf16*)((const unsigned char*)Qmla + r0 * 3072 + h * 192), (const bf16*)((const unsigned char*)Kpe + (size_t)h * SEQ * 256), (const bf16*)((const unsigned char*)KVmla + (size_t)h * 128 * SEQ), Kpe, proj + r0 * LDP + C_GMLA + h * 128, (bf16*)((unsigned char*)Amla + r0 * 2048 + h * 128), (char*)lds, ldsl); }
        PHASE_IDS();
        for (int it = gt; it < SEQ * 128; it += NGT) { const int pos = it >> 7, c8 = it & 127, hh = c8 >> 4, col = c8 * 8;
            const float l0 = lse[((size_t)0 * SEQ + pos) * 8 + hh], l1 = lse[((size_t)1 * SEQ + pos) * 8 + hh], l2 = lse[((size_t)2 * SEQ + pos) * 8 + hh];
            const float mx = fmaxf(l0, fmaxf(l1, l2)); float e0 = __builtin_amdgcn_exp2f(l0 - mx), e1 = __builtin_amdgcn_exp2f(l1 - mx), e2 = __builtin_amdgcn_exp2f(l2 - mx);
            const float inv = 1.f / (e0 + e1 + e2); e0 *= inv; e1 *= inv; e2 *= inv;
            const v4u a0 = *(const v4u*)(Odswa + ((size_t)0 * SEQ + pos) * 1024 + col), a1 = *(const v4u*)(Odswa + ((size_t)1 * SEQ + pos) * 1024 + col), a2 = *(const v4u*)(Odswa + ((size_t)2 * SEQ + pos) * 1024 + col);
            const v4u gg = *(const v4u*)(proj + (size_t)pos * LDP + C_GDSWA + col);
#define MLO(k) ((pg8::bflo(a0[k]) * e0 + pg8::bflo(a1[k]) * e1 + pg8::bflo(a2[k]) * e2) * pg8::bflo(gg[k]) * B_SC)
#define MHI(k) ((pg8::bfhi(a0[k]) * e0 + pg8::bfhi(a1[k]) * e1 + pg8::bfhi(a2[k]) * e2) * pg8::bfhi(gg[k]) * B_SC)
            *(pg8::i32x2*)((unsigned char*)Bdswa + (size_t)pos * 1024 + col) = (pg8::i32x2){pg8::cvt4_fp8(MLO(0), MHI(0), MLO(1), MHI(1)), pg8::cvt4_fp8(MLO(2), MHI(2), MLO(3), MHI(3))}; }
#undef MLO
#undef MHI
    }
    xcd_barrier(xbar);

    for (int rep = 0; rep < REP4; ++rep) {
        { pg8::Gemm g{Amla, Womla_t, SEQ, 4096, 1024, 1024, 1024}; pg8::StaticOrder S; S.init(SEQ, 4096, G, bx);
          pg8::EpiY<0> E{Tm, proj + C_RMLA, T8}; pg8::gemm_phase<pg8::EpiY<0>, pg8::StaticOrder, true, true, true>(ldsl, g, S, E); }
        { pg8::Gemm g{Bdswa, Wodswa_t, SEQ, 4096, 512, 512, 512}; pg8::StaticOrder S; S.init(SEQ, 4096, G, bx);
          pg8::EpiY<1> E{Tm, proj + C_RDSWA, T8}; pg8::gemm_phase<pg8::EpiY<1>, pg8::StaticOrder, true, true, true>(ldsl, g, S, E); }
    }
    xcd_barrier(xbar);

    for (int rep = 0; rep < REP5; ++rep) {
        pg8::Gemm g{(const bf16*)T8, Wout_t, SEQ, 4096, 2048, 2048, 2048}; pg8::StaticOrder S; S.init(SEQ, 4096, G, bx);
        pg8::EpiOut E{x, stats, emb_g, emb_b, a.out, 1.f / (T_SC * W_OUT_SC)}; pg8::gemm_phase<pg8::EpiOut, pg8::StaticOrder, true, true, true>(ldsl, g, S, E);
    }
    xcd_barrier(xbar);

    { PHASE_IDS();
    for (int m = gw; m < SEQ; m += NGW) {
        f32x4* xr = (f32x4*)(a.out + (size_t)m * DM) + lane;
        f32x4 v[16]; float s = 0.f;
#pragma unroll
        for (int j = 0; j < 16; ++j) { v[j] = xr[64 * j]; s += (v[j].x + v[j].y) + (v[j].z + v[j].w); }
        const float mean = wave_sum(s) * (1.f / DM); float s2 = 0.f;
#pragma unroll
        for (int j = 0; j < 16; ++j) { v[j] = v[j] - mean; s2 += (v[j].x * v[j].x + v[j].y * v[j].y) + (v[j].z * v[j].z + v[j].w * v[j].w); }
        const float rstd = 1.f / sqrtf(wave_sum(s2) * (1.f / DM) + LN_EPS);
#pragma unroll
        for (int j = 0; j < 16; ++j) { const f32x4 gv = ((const f32x4*)ln_g)[64 * j + lane], bv = ((const f32x4*)ln_b)[64 * j + lane]; xr[64 * j] = v[j] * rstd * gv + bv; }
    } }
}

extern "C" void kernel_launch(void* const* d_in, const int* in_sizes, int n_in, void* d_out, int out_size, void* d_ws, size_t ws_size, hipStream_t stream) {
    static int grid = 0;
    if (grid == 0) {
        if (n_in != 14 || in_sizes[0] != SEQ * DM || out_size != SEQ * DM || ws_size < WS_END) { fprintf(stderr, "kernel_launch: unexpected shapes (n_in %d, in0 %d, out %d, ws %zu < %zu)\n", n_in, n_in > 0 ? in_sizes[0] : -1, out_size, ws_size, (size_t)WS_END); grid = -1; return; }
        int dev = 0, cus = 0, per_cu = 0;
        if (hipGetDevice(&dev) != hipSuccess || hipDeviceGetAttribute(&cus, hipDeviceAttributeMultiprocessorCount, dev) != hipSuccess) { grid = -1; return; }
        if (hipFuncSetAttribute((const void*)fwd_mega, hipFuncAttributeMaxDynamicSharedMemorySize, LDS_BYTES) != hipSuccess) { fprintf(stderr, "kernel_launch: hipFuncSetAttribute failed\n"); grid = -1; return; }
        if (hipOccupancyMaxActiveBlocksPerMultiprocessor(&per_cu, (const void*)fwd_mega, NWAVES * 64, LDS_BYTES) != hipSuccess || per_cu < 1) { fprintf(stderr, "kernel_launch: occupancy query says %d blocks per CU\n", per_cu); per_cu = 1; }
        (void)hipGetLastError();
        grid = cus;
    }
    if (grid < 0) return;
    Args a{};
    for (int i = 0; i < 14; ++i) a.in[i] = (const float*)d_in[i];
    a.out = (float*)d_out; a.ws = (unsigned char*)d_ws;
    if (hipMemsetAsync((char*)d_ws + WS_XBAR, 0, 16384, stream) != hipSuccess) { fprintf(stderr, "kernel_launch: hipMemsetAsync of the barrier words failed\n"); return; }
    void* args[] = {&a};
    hipError_t e = hipLaunchCooperativeKernel((const void*)fwd_mega, dim3(grid), dim3(NWAVES * 64), args, LDS_BYTES, stream);
    if (e != hipSuccess) fprintf(stderr, "kernel_launch: cooperative launch failed: %s (grid %d)\n", hipGetErrorString(e), grid);
}
```
